# Optimizing an MI355X kernel written in HIP

```python
import jax, jax.numpy as jnp
from jax import lax
import numpy as np

D_MODEL = 2048
BATCH = 16
SEQ = 2048
DEPTH = 4
DEC_BATCH = 1
DEC_SEQ = 8192
PAST_LEN = 128

A_WIDTH = D_MODEL // 2
A_HEAD_DIM = 64
N_A_HEADS = A_WIDTH // A_HEAD_DIM
B_WIDTH = D_MODEL - A_WIDTH
B_HEAD_DIM = 64
N_B_HEADS = B_WIDTH // B_HEAD_DIM
CHUNK = 128
AB_IN = A_WIDTH + 2 * B_WIDTH
CONV_WIDTH = 3
C_WIDTH = D_MODEL
D_FF = ((8 * D_MODEL // 3 + 255) // 256) * 256
PLE_DIM = 256
N_EVEN = (DEPTH + 1) // 2
N_ODD = DEPTH // 2
EPS = 1e-6

kernel_name = 'hybrid_fourier_sgu_shortconv_encoder'


def rmsnorm(x, g):
    xf = x.astype(jnp.float32)
    y = xf * lax.rsqrt(jnp.mean(xf * xf, axis=-1, keepdims=True) + EPS)
    return (y * g.astype(jnp.float32)).astype(x.dtype)


def swiglu(h, w_in, w_out):
    gate, up = jnp.split(h @ w_in, 2, axis=-1)
    return (jax.nn.silu(gate) * up) @ w_out


def fourier_sgu_mixer(h, w_in, g_v, w_s, b_s, w_out):
    bsz, s, _ = h.shape
    z = h @ w_in
    za = z[..., :A_WIDTH].reshape(bsz, s, N_A_HEADS, A_HEAD_DIM)
    ya = jnp.fft.fft2(za.astype(jnp.float32), axes=(1, 3), norm='ortho').real.astype(h.dtype)
    zb = jax.nn.gelu(z[..., A_WIDTH:])
    u = zb[..., :B_WIDTH].reshape(bsz, s, N_B_HEADS, B_HEAD_DIM)
    v = rmsnorm(zb[..., B_WIDTH:].reshape(bsz, s, N_B_HEADS, B_HEAD_DIM), g_v)
    vc = v.reshape(bsz, s // CHUNK, CHUNK, N_B_HEADS, B_HEAD_DIM)
    mixed = jnp.einsum('hts,bnshc->bnthc', w_s, vc) + b_s.T[None, None, :, :, None]
    yb = u * mixed.reshape(bsz, s, N_B_HEADS, B_HEAD_DIM)
    y = jnp.concatenate([ya.reshape(bsz, s, A_WIDTH), yb.reshape(bsz, s, B_WIDTH)], axis=-1)
    return y @ w_out


def short_conv_mixer(h, w_in, w_conv, b_conv, w_out):
    gb, gc, xin = jnp.split(h @ w_in, 3, axis=-1)
    z = gc * xin
    zp = jnp.pad(z, ((0, 0), (1, 1), (0, 0)))
    conv = zp[:, :-2] * w_conv[0] + zp[:, 1:-1] * w_conv[1] + zp[:, 2:] * w_conv[2] + b_conv
    return (gb * conv) @ w_out


def trunk(x, p, g_ffn1, w_ffn1_in, w_ffn1_out, g_mix, w_in_ab, g_v, w_s, b_s, w_out_ab,
          w_in_c, w_conv, b_conv, w_out_c, g_ffn2, w_ffn2_in, w_ffn2_out,
          g_ple, w_ple_gate, w_ple, g_final):
    for i in range(DEPTH):
        x = x + 0.5 * swiglu(rmsnorm(x, g_ffn1[i]), w_ffn1_in[i], w_ffn1_out[i])
        h = rmsnorm(x, g_mix[i])
        j = i // 2
        if i % 2 == 0:
            x = x + fourier_sgu_mixer(h, w_in_ab[j], g_v[j], w_s[j], b_s[j], w_out_ab[j])
        else:
            x = x + short_conv_mixer(h, w_in_c[j], w_conv[j], b_conv[j], w_out_c[j])
        x = x + 0.5 * swiglu(rmsnorm(x, g_ffn2[i]), w_ffn2_in[i], w_ffn2_out[i])
        gate = jax.nn.sigmoid(rmsnorm(x, g_ple[i]) @ w_ple_gate[i])
        x = x + gate * (p[i] @ w_ple[i])
    return rmsnorm(x, g_final)


def setup_inputs(seed: int = 0) -> dict:
    key = jax.random.key(seed)
    ks = jax.random.split(key, 24)

    def nrm(k, shape, scale):
        return jax.random.normal(k, shape, jnp.float32) * scale

    def gain(k, shape):
        return 1.0 + 0.02 * jax.random.normal(k, shape, jnp.float32)

    return {
        'x_prompt': nrm(ks[0], (BATCH, SEQ, D_MODEL), 1.0),
        'x_sample': nrm(ks[1], (DEC_BATCH, DEC_SEQ, D_MODEL), 1.0),
        'p_prompt': nrm(ks[2], (DEPTH, BATCH, SEQ, PLE_DIM), 1.0),
        'p_sample': nrm(ks[3], (DEPTH, DEC_BATCH, DEC_SEQ, PLE_DIM), 1.0),
        'g_ffn1': gain(ks[4], (DEPTH, D_MODEL)),
        'w_ffn1_in': nrm(ks[5], (DEPTH, D_MODEL, 2 * D_FF), D_MODEL ** -0.5),
        'w_ffn1_out': nrm(ks[6], (DEPTH, D_FF, D_MODEL), D_FF ** -0.5),
        'g_mix': gain(ks[7], (DEPTH, D_MODEL)),
        'w_in_ab': nrm(ks[8], (N_EVEN, D_MODEL, AB_IN), D_MODEL ** -0.5),
        'g_v': gain(ks[9], (N_EVEN, N_B_HEADS, B_HEAD_DIM)),
        'w_s': nrm(ks[10], (N_EVEN, N_B_HEADS, CHUNK, CHUNK), CHUNK ** -0.5),
        'b_s': 1.0 + 0.1 * jax.random.normal(ks[11], (N_EVEN, N_B_HEADS, CHUNK), jnp.float32),
        'w_out_ab': nrm(ks[12], (N_EVEN, A_WIDTH + B_WIDTH, D_MODEL), (A_WIDTH + B_WIDTH) ** -0.5),
        'w_in_c': nrm(ks[13], (N_ODD, D_MODEL, 3 * C_WIDTH), D_MODEL ** -0.5),
        'w_conv': nrm(ks[14], (N_ODD, CONV_WIDTH, C_WIDTH), CONV_WIDTH ** -0.5),
        'b_conv': nrm(ks[15], (N_ODD, C_WIDTH), 0.01),
        'w_out_c': nrm(ks[16], (N_ODD, C_WIDTH, D_MODEL), C_WIDTH ** -0.5),
        'g_ffn2': gain(ks[17], (DEPTH, D_MODEL)),
        'w_ffn2_in': nrm(ks[18], (DEPTH, D_MODEL, 2 * D_FF), D_MODEL ** -0.5),
        'w_ffn2_out': nrm(ks[19], (DEPTH, D_FF, D_MODEL), D_FF ** -0.5),
        'g_ple': gain(ks[20], (DEPTH, D_MODEL)),
        'w_ple_gate': nrm(ks[21], (DEPTH, D_MODEL, D_MODEL), D_MODEL ** -0.5),
        'w_ple': nrm(ks[22], (DEPTH, PLE_DIM, D_MODEL), PLE_DIM ** -0.5),
        'g_final': gain(ks[23], (D_MODEL,)),
    }


def reference(x_prompt, x_sample, p_prompt, p_sample, g_ffn1, w_ffn1_in, w_ffn1_out, g_mix,
              w_in_ab, g_v, w_s, b_s, w_out_ab, w_in_c, w_conv, b_conv, w_out_c,
              g_ffn2, w_ffn2_in, w_ffn2_out, g_ple, w_ple_gate, w_ple, g_final):
    weights = (g_ffn1, w_ffn1_in, w_ffn1_out, g_mix, w_in_ab, g_v, w_s, b_s, w_out_ab,
               w_in_c, w_conv, b_conv, w_out_c, g_ffn2, w_ffn2_in, w_ffn2_out,
               g_ple, w_ple_gate, w_ple, g_final)
    y_prompt = trunk(x_prompt, p_prompt, *weights)
    y_sample = trunk(x_sample, p_sample, *weights)
    return (y_prompt, y_sample)
```

```cpp
#include <hip/hip_runtime.h>
#include <cstdio>
#include <cstdint>
#ifndef MK_WGM
#define MK_WGM 4
#endif
#ifndef MK_SP2
#define MK_SP2 true
#endif
#ifndef MK_ALIGN
#define MK_ALIGN true
#endif
namespace pg8 {
#define PG8_LAS __attribute__((address_space(3)))
typedef unsigned short bf16_t;
typedef short bf16x8 __attribute__((ext_vector_type(8)));
typedef float f32x4 __attribute__((ext_vector_type(4)));
typedef unsigned u32x4 __attribute__((ext_vector_type(4)));
constexpr int BM = 256, BK = 64, HALF = 128, HTB = HALF * BK * 2  , STAGE_BYTES = 8 * HTB, NXCD = 8, WGM = MK_WGM;

__host__ __device__ __forceinline__ int lds_byte(int r, int c) { const int st = (r >> 4) * 2 + (c >> 5), rr = r & 15, cc = c & 31, ob = rr * 64 + cc * 2; return st * 1024 + (ob ^ (((ob >> 9) & 1) << 5)); }
__host__ __device__ __forceinline__ void stage_rc(int b, int& R, int& C) { const int st = b / 1024, sb = b % 1024, swz = sb ^ (((sb >> 9) & 1) << 5); R = (st >> 1) * 16 + swz / 64; C = (st & 1) * 32 + (swz % 64) / 2; }
__host__ __device__ __forceinline__ int perm32(int rho) { const int n = rho >> 4, i = rho & 15; return 8 * (i >> 2) + 4 * n + (i & 3); }

struct Unit { int pm, pn; };
struct Gemm { const bf16_t* A; const bf16_t* Bt; int M, N, K; };

struct StaticOrder {
    int nM, nN, nwg, G, c;
    __host__ __device__ void init(int M, int N, int G_, int c_) { nM = M / BM; nN = N / BM; nwg = nM * nN; G = G_; c = c_; }
    __host__ __device__ bool next(int i, Unit& u) const {
        const long L = (long)i * G + c; if (L >= nwg) return false;
        int wgid = (int)L; { const int q = nwg / NXCD, r = nwg % NXCD, xcd = wgid % NXCD, off = wgid / NXCD; wgid = (xcd < r ? xcd * (q + 1) : r * (q + 1) + (xcd - r) * q) + off; }
        const int nig = WGM * nN, gid = wgid / nig, fm = gid * WGM, gsz = (nM - fm) < WGM ? (nM - fm) : WGM;
        u.pm = fm + ((wgid % nig) % gsz); u.pn = (wgid % nig) / gsz; return true;
    }
    __device__ __forceinline__ void a_ready(const Unit&) const {}
    __device__ __forceinline__ void done(const Unit&) const {}
};

__device__ __forceinline__ unsigned cvt_pk_bf16(float lo, float hi) { unsigned r; asm volatile("v_cvt_pk_bf16_f32 %0, %1, %2" : "=v"(r) : "v"(lo), "v"(hi)); return r; }
typedef float f32x2 __attribute__((ext_vector_type(2)));
__device__ __forceinline__ f32x2 gelu_pk(f32x2 v) {
    const f32x2 av = __builtin_elementwise_abs(v), d = av * 0.2316418882f + 1.0f;
    f32x2 t; t.x = __builtin_amdgcn_rcpf(d.x); t.y = __builtin_amdgcn_rcpf(d.y);
    f32x2 q = t * 0.5307027145f + (-0.7265760135f); q = q * t + 0.7107068705f; q = q * t + (-0.142248368f); q = q * t + 0.127414796f; q = q * t;
    const f32x2 s = (v * v) * (-0.72134752044f);
    f32x2 e; e.x = __builtin_amdgcn_exp2f(s.x); e.y = __builtin_amdgcn_exp2f(s.y);
    const f32x2 m = v * (q * e), r = v - m;
    f32x2 o; o.x = v.x < 0.f ? m.x : r.x; o.y = v.y < 0.f ? m.y : r.y; return o;
}

template <class Epi, class Sched, bool ALIGN_EPI = false, bool SP2 = false>
__device__ __forceinline__ void gemm_phase(PG8_LAS unsigned char* lds, const Gemm g, const Sched& S, const Epi& E) {
    int tid_o = threadIdx.x; asm volatile("" : "+v"(tid_o));
    const int tid = tid_o, wid = __builtin_amdgcn_readfirstlane(tid >> 6), lane = tid & 63, wr = wid >> 2, wc = wid & 3, fr = lane & 15, fq = lane >> 4;
    const int K = g.K, nt = K / BK;
    unsigned voffA[2], voffB[2];
#pragma unroll
    for (int i = 0; i < 2; ++i) { int R, C; stage_rc(tid * 16 + i * 8192, R, C); const int Rb = Epi::PERM ? ((R & ~31) + perm32(R & 31)) : R;
        voffA[i] = (unsigned)(R * K + C) * 2u; voffB[i] = (unsigned)(Rb * K + C) * 2u; }
    const unsigned kstep = (unsigned)(BK * 2);
    const unsigned hstep = (unsigned)HALF * (unsigned)K * 2u;
    const unsigned tstep = 2u * hstep;
    const unsigned ldsw = (unsigned)wid * 1024u;
    const int aoff = lds_byte(wr * 64 + fr, fq * 8), boff = lds_byte(wc * 32 + fr, fq * 8);
#define PG8_SA(b, h) (((b) * 2 + (h)) * HTB)
#define PG8_SB(b, h) ((4 + (b) * 2 + (h)) * HTB)
    const __amdgpu_buffer_rsrc_t rs_voffA = __builtin_amdgcn_make_buffer_rsrc((void*)g.A, (short)0, -1, 0x00020000);
    const __amdgpu_buffer_rsrc_t rs_voffB = __builtin_amdgcn_make_buffer_rsrc((void*)g.Bt, (short)0, -1, 0x00020000);
#define PG8_STAGE(bufoff, gbase, voff) do { _Pragma("unroll") for (int _i = 0; _i < 2; ++_i) \
        __builtin_amdgcn_raw_ptr_buffer_load_lds(rs_##voff, (PG8_LAS void*)(lds + (bufoff) + ldsw + _i * 8192), 16, (int)(voff)[_i], (int)(gbase), 0, 0); } while (0)
#define PG8_LDA(dst, b, h) do { _Pragma("unroll") for (int m = 0; m < 4; ++m) _Pragma("unroll") for (int k = 0; k < 2; ++k) dst[m][k] = *(const PG8_LAS bf16x8*)(lds + PG8_SA(b, h) + aoff + m * 2048 + k * 1024); } while (0)
#define PG8_LDB(dst, b, h) do { _Pragma("unroll") for (int n = 0; n < 2; ++n) _Pragma("unroll") for (int k = 0; k < 2; ++k) dst[n][k] = *(const PG8_LAS bf16x8*)(lds + PG8_SB(b, h) + boff + n * 2048 + k * 1024); } while (0)
#define PG8_MMA(ai, bj, At, Bt) do { __builtin_amdgcn_s_setprio(1); _Pragma("unroll") for (int m = 0; m < 4; ++m) _Pragma("unroll") for (int n = 0; n < 2; ++n) _Pragma("unroll") for (int k = 0; k < 2; ++k) \
        acc[ai][bj][m][n] = __builtin_amdgcn_mfma_f32_16x16x32_bf16(Bt[n][k], At[m][k], acc[ai][bj][m][n], 0, 0, 0); __builtin_amdgcn_s_setprio(0); } while (0)
#define PG8_WAIT_V(n) asm volatile("s_waitcnt vmcnt(" #n ")" ::: "memory")
#define PG8_WAIT_L(n) asm volatile("s_waitcnt lgkmcnt(" #n ")" ::: "memory")
#define PG8_BAR __builtin_amdgcn_s_barrier()
#define PG8_SCHED __builtin_amdgcn_sched_barrier(0)
    Unit cur, nxt; int ui = 0;
    if (!S.next(0, cur)) return;
    f32x4 acc[2][2][4][2];
#pragma unroll
    for (int a = 0; a < 2; ++a)
#pragma unroll
        for (int b = 0; b < 2; ++b)
#pragma unroll
            for (int m = 0; m < 4; ++m)
#pragma unroll
                for (int n = 0; n < 2; ++n) acc[a][b][m][n] = (f32x4){0.f, 0.f, 0.f, 0.f};
    bf16x8 At[4][2], B0[2][2], B1[2][2];
    unsigned cA = (unsigned)cur.pm * tstep, cB = (unsigned)cur.pn * tstep;
    S.a_ready(cur);
    if constexpr (SP2) {
        PG8_STAGE(PG8_SB(0, 0), cB, voffB); PG8_STAGE(PG8_SB(0, 1), cB + hstep, voffB); PG8_STAGE(PG8_SA(0, 0), cA, voffA); PG8_STAGE(PG8_SA(0, 1), cA + hstep, voffA);
        if (wr == 1) PG8_BAR;
        PG8_WAIT_V(2); PG8_BAR;
        PG8_STAGE(PG8_SB(1, 0), cB + kstep, voffB); PG8_STAGE(PG8_SA(1, 0), cA + kstep, voffA); PG8_STAGE(PG8_SB(1, 1), cB + hstep + kstep, voffB);
        PG8_WAIT_V(6); PG8_BAR;
    } else {
        PG8_STAGE(PG8_SB(0, 0), cB, voffB); PG8_STAGE(PG8_SA(0, 0), cA, voffA); PG8_STAGE(PG8_SB(0, 1), cB + hstep, voffB); PG8_STAGE(PG8_SA(0, 1), cA + hstep, voffA);
        if (wr == 1) PG8_BAR;
        PG8_WAIT_V(4); PG8_BAR;
        PG8_STAGE(PG8_SB(1, 0), cB + kstep, voffB); PG8_STAGE(PG8_SA(1, 0), cA + kstep, voffA); PG8_STAGE(PG8_SB(1, 1), cB + hstep + kstep, voffB);
        PG8_WAIT_V(6); PG8_BAR;
    }
    for (;;) {
        bool has_next = false; unsigned nA = cA, nB = cB;
        for (int t = 0; t < nt; t += 2) {
            const bool last = (t == nt - 2);
            if (last) { has_next = S.next(ui + 1, nxt); if (has_next) { nA = (unsigned)nxt.pm * tstep; nB = (unsigned)nxt.pn * tstep; } }
            const unsigned a1 = cA + (unsigned)(t + 1) * kstep;
            const unsigned a2 = last ? nA : cA + (unsigned)(t + 2) * kstep, b2 = last ? nB : cB + (unsigned)(t + 2) * kstep;
            const unsigned a3 = a2 + kstep, b3 = b2 + kstep;
            if (last && has_next) S.a_ready(nxt);
            if constexpr (SP2) {
            PG8_LDB(B0, 0, 0); PG8_LDB(B1, 0, 1); PG8_SCHED; PG8_LDA(At, 0, 0); PG8_STAGE(PG8_SA(1, 1), a1 + hstep, voffA);
            PG8_WAIT_V(8); PG8_WAIT_L(0); PG8_BAR; PG8_MMA(0, 0, At, B0); PG8_MMA(0, 1, At, B1); PG8_BAR; PG8_SCHED;
            PG8_LDA(At, 0, 1); PG8_STAGE(PG8_SB(0, 0), b2, voffB); PG8_STAGE(PG8_SB(0, 1), b2 + hstep, voffB); PG8_STAGE(PG8_SA(0, 0), a2, voffA);
            PG8_WAIT_V(8); PG8_WAIT_L(0); PG8_BAR; PG8_MMA(1, 0, At, B0); PG8_MMA(1, 1, At, B1); PG8_BAR; PG8_SCHED;
            PG8_LDB(B0, 1, 0); PG8_LDB(B1, 1, 1); PG8_SCHED; PG8_LDA(At, 1, 0); PG8_STAGE(PG8_SA(0, 1), a2 + hstep, voffA);
            PG8_WAIT_V(8); PG8_WAIT_L(0); PG8_BAR; PG8_MMA(0, 0, At, B0); PG8_MMA(0, 1, At, B1); PG8_BAR; PG8_SCHED;
            PG8_LDA(At, 1, 1); PG8_STAGE(PG8_SB(1, 0), b3, voffB); PG8_STAGE(PG8_SB(1, 1), b3 + hstep, voffB); PG8_STAGE(PG8_SA(1, 0), a3, voffA);
            PG8_WAIT_V(8); PG8_WAIT_L(0); PG8_BAR; PG8_MMA(1, 0, At, B0); PG8_MMA(1, 1, At, B1); PG8_BAR; PG8_SCHED;
            } else {
            PG8_LDB(B0, 0, 0); PG8_SCHED; PG8_LDA(At, 0, 0); PG8_STAGE(PG8_SA(1, 1), a1 + hstep, voffA);
            PG8_WAIT_L(8); PG8_BAR; PG8_WAIT_L(0); PG8_MMA(0, 0, At, B0); PG8_BAR; PG8_SCHED;
            PG8_LDB(B1, 0, 1); PG8_STAGE(PG8_SB(0, 0), b2, voffB);
            PG8_BAR; PG8_WAIT_L(0); PG8_MMA(0, 1, At, B1); PG8_BAR;
            PG8_LDA(At, 0, 1); PG8_STAGE(PG8_SA(0, 0), a2, voffA);
            PG8_BAR; PG8_WAIT_L(0); PG8_MMA(1, 0, At, B0); PG8_BAR; PG8_SCHED;
            PG8_STAGE(PG8_SB(0, 1), b2 + hstep, voffB);
            PG8_WAIT_V(6); PG8_BAR; PG8_MMA(1, 1, At, B1); PG8_BAR;
            PG8_LDB(B0, 1, 0); PG8_SCHED; PG8_LDA(At, 1, 0); PG8_STAGE(PG8_SA(0, 1), a2 + hstep, voffA);
            PG8_WAIT_L(8); PG8_BAR; PG8_WAIT_L(0); PG8_MMA(0, 0, At, B0); PG8_BAR; PG8_SCHED;
            PG8_LDB(B1, 1, 1); PG8_STAGE(PG8_SB(1, 0), b3, voffB);
            PG8_BAR; PG8_WAIT_L(0); PG8_MMA(0, 1, At, B1); PG8_BAR;
            PG8_LDA(At, 1, 1); PG8_STAGE(PG8_SA(1, 0), a3, voffA);
            PG8_BAR; PG8_WAIT_L(0); PG8_MMA(1, 0, At, B0); PG8_BAR; PG8_SCHED;
            PG8_STAGE(PG8_SB(1, 1), b3 + hstep, voffB);
            PG8_WAIT_V(6); PG8_BAR; PG8_MMA(1, 1, At, B1); PG8_BAR;
            }
        }
        if constexpr (ALIGN_EPI) { if (wr == 0) PG8_BAR; }
        if constexpr (!Epi::AFTER_DRAIN) { E(acc, cur, wr, wc, fr, fq); S.done(cur); }
        if (!has_next) break;
#pragma unroll
        for (int a = 0; a < 2; ++a)
#pragma unroll
            for (int b = 0; b < 2; ++b)
#pragma unroll
                for (int m = 0; m < 4; ++m)
#pragma unroll
                    for (int n = 0; n < 2; ++n) acc[a][b][m][n] = (f32x4){0.f, 0.f, 0.f, 0.f};
        cur = nxt; cA = nA; cB = nB; ++ui;
        if constexpr (ALIGN_EPI) { if (wr == 1) PG8_BAR; }
    }
    PG8_WAIT_V(0);
    if constexpr (!ALIGN_EPI) { if (wr == 0) PG8_BAR; }
    PG8_BAR;
    if constexpr (Epi::AFTER_DRAIN) { E.fused(acc, cur, wr, wc, fr, fq, lds, wid, lane); S.done(cur); }
#undef PG8_SA
#undef PG8_SB
#undef PG8_STAGE
#undef PG8_LDA
#undef PG8_LDB
#undef PG8_MMA
#undef PG8_WAIT_V
#undef PG8_WAIT_L
#undef PG8_BAR
#undef PG8_SCHED
}
}
namespace pg8 {
constexpr float RMS_EPS = 1e-6f;
typedef unsigned long long stat_t;
typedef unsigned long long u64x2 __attribute__((ext_vector_type(2)));
constexpr float STAT_SCALE = 1048576.0f;
__device__ __forceinline__ stat_t stat_fix(float ss) { return (stat_t)(ss * STAT_SCALE + 0.5f); }
__device__ __forceinline__ float msq_from(stat_t q) { const float lo = (float)(unsigned)q * (1.0f / (2048.0f * STAT_SCALE)) + RMS_EPS; return (float)(unsigned)(q >> 32) * (4294967296.0f / (2048.0f * STAT_SCALE)) + lo; }
__device__ __forceinline__ float rinv_from(stat_t q) { return __builtin_amdgcn_rsqf(msq_from(q)); }
__device__ __forceinline__ float rinv_of(const stat_t* st, int row) { return rinv_from(st[row]); }
__device__ __forceinline__ float fast_sigmoid(float v) { return __builtin_amdgcn_rcpf(1.0f + __expf(-v)); }
__device__ __forceinline__ float gelu_tanh(float v) { const float y = 1.5957691216f * (v + 0.044715f * v * v * v); return v * fast_sigmoid(y); }
__device__ __forceinline__ u32x4 pack8(const f32x4 a, const f32x4 b) { u32x4 w; w.x = cvt_pk_bf16(a[0], a[1]); w.y = cvt_pk_bf16(a[2], a[3]); w.z = cvt_pk_bf16(b[0], b[1]); w.w = cvt_pk_bf16(b[2], b[3]); return w; }
__device__ __forceinline__ void unpack8(const u32x4 w, f32x4& a, f32x4& b) {
    a[0] = __uint_as_float(w.x << 16); a[1] = __uint_as_float(w.x & 0xffff0000u); a[2] = __uint_as_float(w.y << 16); a[3] = __uint_as_float(w.y & 0xffff0000u);
    b[0] = __uint_as_float(w.z << 16); b[1] = __uint_as_float(w.z & 0xffff0000u); b[2] = __uint_as_float(w.w << 16); b[3] = __uint_as_float(w.w & 0xffff0000u); }
__device__ __forceinline__ float sumsq8(const f32x4 a, const f32x4 b) { return (a[0] * a[0] + a[1] * a[1]) + (a[2] * a[2] + a[3] * a[3]) + (b[0] * b[0] + b[1] * b[1]) + (b[2] * b[2] + b[3] * b[3]); }

struct EpiSwiGLU {
    static constexpr bool PERM = true, AFTER_DRAIN = false;
    bf16_t* H; int ldh; const stat_t* st;
    __device__ __forceinline__ void operator()(const f32x4 (&acc)[2][2][4][2], const Unit& u, int wr, int wc, int fr, int fq) const {
        const int rowu = u.pm * BM + wr * 64; const unsigned lo = (unsigned)(fr * ldh + 8 * fq);
        stat_t q[8];
#pragma unroll
        for (int g = 0; g < 8; ++g) q[g] = (st + rowu + (g >> 2) * HALF + (g & 3) * 16)[fr];
        asm volatile("" ::: "memory");
#pragma unroll
        for (int ai = 0; ai < 2; ++ai)
#pragma unroll
            for (int m = 0; m < 4; ++m) { const int ru = rowu + ai * HALF + m * 16;
                const float v = msq_from(q[ai * 4 + m]), sn = __builtin_amdgcn_rsqf(v) * -1.4426950408889634f;
                f32x4 h[2];
#pragma unroll
                for (int n = 0; n < 2; ++n) { const f32x4 g = acc[ai][0][m][n], up = acc[ai][1][m][n];
#pragma unroll
                    for (int p = 0; p < 2; ++p) { const f32x2 g2 = (f32x2){g[2 * p], g[2 * p + 1]}, u2 = (f32x2){up[2 * p], up[2 * p + 1]}; const f32x2 a2 = g2 * sn;
                        f32x2 e2; e2.x = __builtin_amdgcn_exp2f(a2.x); e2.y = __builtin_amdgcn_exp2f(a2.y);
                        const f32x2 d2 = e2 * v + v; f32x2 r2; r2.x = __builtin_amdgcn_rcpf(d2.x); r2.y = __builtin_amdgcn_rcpf(d2.y);
                        const f32x2 h2 = (g2 * u2) * r2; h[n][2 * p] = h2.x; h[n][2 * p + 1] = h2.y; } }
                bf16_t* hp = H + (size_t)ru * ldh + u.pn * HALF + wc * 32;
                *(u32x4*)(hp + lo) = pack8(h[0], h[1]); }
    }
};
template <int MODE> struct EpiRmw {
    static constexpr bool PERM = true, AFTER_DRAIN = false;
    const bf16_t* XB; bf16_t* XN; const stat_t* st; stat_t* stn; float alpha;
    __device__ __forceinline__ void operator()(const f32x4 (&acc)[2][2][4][2], const Unit& u, int wr, int wc, int fr, int fq) const {
        const int rowu = u.pm * BM + wr * 64, colu = u.pn * BM + wc * 32; const unsigned lo = (unsigned)(fr * 2048 + 8 * fq);
        const bf16_t* const xbase = XB + (size_t)rowu * 2048 + colu; bf16_t* const nbase = XN + (size_t)rowu * 2048 + colu;
        u32x4 xv[2][2][2], pv[2][2][2];
        stat_t rq[2][2];
        float ss[8];
#define RMW_LOAD(k, b) do { _Pragma("unroll") for (int q = 0; q < 2; ++q) { const int g = 2 * (k) + q, ro = ((g >> 2) * HALF + (g & 3) * 16) * 2048; \
            if (MODE == 1) rq[b][q] = (st + rowu + (g >> 2) * HALF + (g & 3) * 16)[fr]; \
            _Pragma("unroll") for (int bj = 0; bj < 2; ++bj) { xv[b][q][bj] = *(const u32x4*)(xbase + ro + lo + bj * HALF); \
                if (MODE == 1) pv[b][q][bj] = *(const u32x4*)(nbase + ro + lo + bj * HALF); } } } while (0)
        RMW_LOAD(0, 0);
        asm volatile("" ::: "memory");
#pragma unroll
        for (int k = 0; k < 4; ++k) { const int b = k & 1; u32x4 ov[2][2];
#pragma unroll
            for (int q = 0; q < 2; ++q) { const int g = 2 * k + q, ai = g >> 2, m = g & 3; float s2 = 0.f; const float rsg = (MODE == 1) ? rinv_from(rq[b][q]) : 0.f;
#pragma unroll
                for (int bj = 0; bj < 2; ++bj) { f32x4 x0, x1; unpack8(xv[b][q][bj], x0, x1);
                    if (MODE == 0) { x0 += acc[ai][bj][m][0] * alpha; x1 += acc[ai][bj][m][1] * alpha; }
                    else { f32x4 p0, p1; unpack8(pv[b][q][bj], p0, p1);
#pragma unroll
                        for (int j = 0; j < 4; ++j) { x0[j] += alpha * fast_sigmoid(acc[ai][bj][m][0][j] * rsg) * p0[j]; x1[j] += alpha * fast_sigmoid(acc[ai][bj][m][1][j] * rsg) * p1[j]; } }
                    s2 += sumsq8(x0, x1); ov[q][bj] = pack8(x0, x1); }
                s2 += __shfl_xor(s2, 16); s2 += __shfl_xor(s2, 32); ss[g] = s2; }
            if (k < 3) { RMW_LOAD(k + 1, b ^ 1); }
            asm volatile("" ::: "memory");
#pragma unroll
            for (int q = 0; q < 2; ++q) { const int g = 2 * k + q, ro = ((g >> 2) * HALF + (g & 3) * 16) * 2048;
#pragma unroll
                for (int bj = 0; bj < 2; ++bj) if (MODE == 0 || alpha != 0.f) *(u32x4*)(nbase + ro + lo + bj * HALF) = ov[q][bj]; }
            asm volatile("" ::: "memory");
        }
#undef RMW_LOAD
        if (fq == 0) {
#pragma unroll
            for (int g = 0; g < 8; ++g) __hip_atomic_fetch_add(stn + rowu + (g >> 2) * HALF + (g & 3) * 16 + fr, stat_fix(ss[g]), __ATOMIC_RELAXED, __HIP_MEMORY_SCOPE_AGENT);
        }
    }
};
template <int MODE> struct EpiRowBf16 {
    static constexpr bool PERM = true, AFTER_DRAIN = false;
    bf16_t* O; int ldc; const stat_t* st;
    __device__ __forceinline__ void operator()(const f32x4 (&acc)[2][2][4][2], const Unit& u, int wr, int wc, int fr, int fq) const {
        const int rowu = u.pm * BM + wr * 64, colu = u.pn * BM + wc * 32; const unsigned lo = (unsigned)(fr * ldc + 8 * fq);
        stat_t q[8];
        if (MODE == 1) {
#pragma unroll
            for (int g = 0; g < 8; ++g) q[g] = (st + rowu + (g >> 2) * HALF + (g & 3) * 16)[fr];
            asm volatile("" ::: "memory"); }
#pragma unroll
        for (int ai = 0; ai < 2; ++ai)
#pragma unroll
            for (int m = 0; m < 4; ++m) { const int ru = rowu + ai * HALF + m * 16; float s = 1.0f; if (MODE == 1) s = rinv_from(q[ai * 4 + m]);
                bf16_t* op = O + (size_t)ru * ldc + colu;
#pragma unroll
                for (int bj = 0; bj < 2; ++bj) { f32x4 v0 = acc[ai][bj][m][0] * s, v1 = acc[ai][bj][m][1] * s;
                    if (MODE == 1) {
#pragma unroll
                        for (int j = 0; j < 4; ++j) { v0[j] = gelu_tanh(v0[j]); v1[j] = gelu_tanh(v1[j]); } }
                    *(u32x4*)(op + lo + bj * HALF) = pack8(v0, v1); } }
    }
};
struct EpiOddIn {
    static constexpr bool PERM = true, AFTER_DRAIN = false;
    bf16_t* Z; bf16_t* GB; const stat_t* st;
    __device__ __forceinline__ void operator()(const f32x4 (&acc)[2][2][4][2], const Unit& u, int wr, int wc, int fr, int fq) const {
        const int rowu = u.pm * BM + wr * 64; const unsigned lo = (unsigned)(fr * 2048 + 8 * fq);
        stat_t q[8];
#pragma unroll
        for (int g = 0; g < 8; ++g) q[g] = (st + rowu + (g >> 2) * HALF + (g & 3) * 16)[fr];
        asm volatile("" ::: "memory");
        if (u.pn < 16) { const int colu = u.pn * HALF + wc * 32;
#pragma unroll
            for (int ai = 0; ai < 2; ++ai)
#pragma unroll
                for (int m = 0; m < 4; ++m) { const int ru = rowu + ai * HALF + m * 16; const float s = rinv_from(q[ai * 4 + m]), s2 = s * s;
                    const f32x4 z0 = acc[ai][0][m][0] * acc[ai][1][m][0] * s2, z1 = acc[ai][0][m][1] * acc[ai][1][m][1] * s2;
                    bf16_t* zp = Z + (size_t)ru * 2048 + colu;
                    *(u32x4*)(zp + lo) = pack8(z0, z1); }
        } else { const int colu = (u.pn - 16) * BM + wc * 32;
#pragma unroll
            for (int ai = 0; ai < 2; ++ai)
#pragma unroll
                for (int m = 0; m < 4; ++m) { const int ru = rowu + ai * HALF + m * 16; const float s = rinv_from(q[ai * 4 + m]);
                    bf16_t* gp = GB + (size_t)ru * 2048 + colu;
#pragma unroll
                    for (int bj = 0; bj < 2; ++bj) *(u32x4*)(gp + lo + bj * HALF) = pack8(acc[ai][bj][m][0] * s, acc[ai][bj][m][1] * s); }
        }
    }
};
struct EpiMT {
    static constexpr bool PERM = true, AFTER_DRAIN = false;
    bf16_t* ZTP; bf16_t* ZTS; bf16_t* VT; const stat_t* st; const float* gv;
    __device__ __forceinline__ void operator()(const f32x4 (&acc)[2][2][4][2], const Unit& u, int wr, int wc, int fr, int fq) const {
        const int tu = u.pn * BM + wc * 32;
        f32x4 sc[2][2];
#pragma unroll
        for (int bj = 0; bj < 2; ++bj)
#pragma unroll
            for (int n = 0; n < 2; ++n) { const stat_t* sp = (st + tu + bj * HALF + 4 * n) + 8 * fq; const u64x2 a = *(const u64x2*)sp, b = *(const u64x2*)(sp + 2);
                sc[bj][n][0] = rinv_from(a[0]); sc[bj][n][1] = rinv_from(a[1]); sc[bj][n][2] = rinv_from(b[0]); sc[bj][n][3] = rinv_from(b[1]); }
        const int chu = u.pm * BM + wr * 64;
        if (u.pm < 4) {
            bf16_t* base; int S2;
            if (u.pn < 128) { const int tt = u.pn * BM; base = ZTP + (size_t)(tt >> 11) * (1024 * 2048) + (tt & 2047) + wc * 32; S2 = 2048; }
            else { base = ZTS + (u.pn - 128) * BM + wc * 32; S2 = 8192; }
            const unsigned lo = (unsigned)(fr * S2 + 8 * fq);
#pragma unroll
            for (int ai = 0; ai < 2; ++ai)
#pragma unroll
                for (int m = 0; m < 4; ++m) { bf16_t* rp = base + (size_t)(chu + ai * HALF + m * 16) * S2;
#pragma unroll
                    for (int bj = 0; bj < 2; ++bj) *(u32x4*)(rp + lo + bj * HALF) = pack8(acc[ai][bj][m][0] * sc[bj][0], acc[ai][bj][m][1] * sc[bj][1]); }
        } else {
            const unsigned lo = (unsigned)(fr * 40960 + 8 * fq);
#pragma unroll
            for (int ai = 0; ai < 2; ++ai) {
                f32x4 q[2][2];
#pragma unroll
                for (int bj = 0; bj < 2; ++bj)
#pragma unroll
                    for (int n = 0; n < 2; ++n) { q[bj][n] = (f32x4){0.f, 0.f, 0.f, 0.f};
#pragma unroll
                        for (int m = 0; m < 4; ++m) { const f32x4 v = acc[ai][bj][m][n] * sc[bj][n];
#pragma unroll
                            for (int j = 0; j < 4; ++j) { const float y = gelu_tanh(v[j]); q[bj][n][j] += y * y; } } }
#pragma unroll
                for (int bj = 0; bj < 2; ++bj)
#pragma unroll
                    for (int n = 0; n < 2; ++n)
#pragma unroll
                        for (int j = 0; j < 4; ++j) { float s = q[bj][n][j]; s += __shfl_xor(s, 1); s += __shfl_xor(s, 2); s += __shfl_xor(s, 4); s += __shfl_xor(s, 8);
                            q[bj][n][j] = __builtin_amdgcn_rsqf(s * (1.0f / 64.0f) + RMS_EPS); }
#pragma unroll
                for (int m = 0; m < 4; ++m) { const int cu = chu - 1024 + ai * HALF + m * 16; const float gg = (gv + cu)[fr]; bf16_t* vp = VT + (size_t)cu * 40960 + tu;
#pragma unroll
                    for (int bj = 0; bj < 2; ++bj) { f32x4 y0 = acc[ai][bj][m][0] * sc[bj][0], y1 = acc[ai][bj][m][1] * sc[bj][1];
#pragma unroll
                        for (int j = 0; j < 4; ++j) { y0[j] = gelu_tanh(y0[j]); y1[j] = gelu_tanh(y1[j]); }
                        *(u32x4*)(vp + lo + bj * HALF) = pack8(y0 * q[bj][0] * gg, y1 * q[bj][1] * gg); } }
            }
        }
    }
};
struct EpiDFT {
    static constexpr bool PERM = true, AFTER_DRAIN = false;
    bf16_t* Y; int row_base, S; float scale, msign; int col_lo, col_hi;
    __device__ __forceinline__ void operator()(const f32x4 (&acc)[2][2][4][2], const Unit& u, int wr, int wc, int fr, int fq) const {
        const int ku = u.pm * BM + wr * 64, rb = row_base + (u.pn >> 2) * S, colu = (u.pn & 3) * BM + wc * 32;
        const int lo = fr * 2048 + 8 * fq, lom = -fr * 2048 + 8 * fq; const float ms = scale * msign;
#pragma unroll
        for (int bj = 0; bj < 2; ++bj) { const int col = colu + bj * HALF + 8 * fq; if (col >= col_lo && col < col_hi) {
#pragma unroll
            for (int ai = 0; ai < 2; ++ai)
#pragma unroll
                for (int m = 0; m < 4; ++m) { const int k0 = ku + ai * HALF + m * 16;
                    bf16_t* yp = Y + (size_t)(rb + k0) * 2048 + colu + bj * HALF; bf16_t* ym = Y + (size_t)(rb + S - k0) * 2048 + colu + bj * HALF;
                    *(u32x4*)(yp + lo) = pack8(acc[ai][bj][m][0] * scale, acc[ai][bj][m][1] * scale);
                    if (k0 + fr != 0) *(u32x4*)(ym + lom) = pack8(acc[ai][bj][m][0] * ms, acc[ai][bj][m][1] * ms); } } }
    }
};
struct EpiNull {
    static constexpr bool PERM = true, AFTER_DRAIN = false;
    float* sink;
    __device__ __forceinline__ void operator()(const f32x4 (&acc)[2][2][4][2], const Unit& u, int wr, int wc, int fr, int fq) const {
        float s = 0.f;
#pragma unroll
        for (int ai = 0; ai < 2; ++ai)
#pragma unroll
            for (int bj = 0; bj < 2; ++bj)
#pragma unroll
                for (int m = 0; m < 4; ++m)
#pragma unroll
                    for (int n = 0; n < 2; ++n) s += acc[ai][bj][m][n][0] + acc[ai][bj][m][n][1] + acc[ai][bj][m][n][2] + acc[ai][bj][m][n][3];
        if (s == 1.2345e-30f) sink[u.pm + fr] = s;
    }
};
}
#ifndef MK_N_LAUNCHES
#define MK_N_LAUNCHES 1
#endif
constexpr int NPHASE = 34;
constexpr int T = 40960, TP = 32768, DM = 2048, DFF = 5632, NLAYER = 4;
typedef unsigned short bf16;
#define GAS __attribute__((address_space(1)))
#define LAS __attribute__((address_space(3)))
typedef unsigned v4u __attribute__((ext_vector_type(4)));
typedef unsigned v2u __attribute__((ext_vector_type(2)));
typedef float f32x4 __attribute__((ext_vector_type(4)));
typedef short bf16x8 __attribute__((ext_vector_type(8)));
typedef GAS unsigned gu32;

constexpr size_t MiB = 1u << 20;
constexpr size_t WS_CTL = 0, CTL_BYTES = 6 * MiB;
constexpr int CW_BAR = 4096;
constexpr size_t WS_STATS = 65536;
constexpr size_t WS_W = 6 * MiB;
constexpr size_t SZ_FIN = (size_t)2 * DFF * DM * 2, SZ_FOUT = (size_t)DM * DFF * 2, SZ_SQ = (size_t)DM * DM * 2, SZ_WP = (size_t)DM * 256 * 2;
constexpr size_t WL_F1IN = 0, WL_F1OUT = SZ_FIN, WL_F2IN = SZ_FIN + SZ_FOUT, WL_F2OUT = 2 * SZ_FIN + SZ_FOUT, WL_WG = 2 * SZ_FIN + 2 * SZ_FOUT, WL_WP = WL_WG + SZ_SQ, WL_SIZE = WL_WP + SZ_WP;
constexpr size_t WS_WE = WS_W + NLAYER * WL_SIZE;
constexpr size_t WE_WZ = 0, WE_WU = (size_t)3072 * DM * 2, WE_WO = WE_WU + (size_t)1024 * DM * 2, WE_WS = WE_WO + SZ_SQ, WE_SIZE = WE_WS + (size_t)16 * 128 * 128 * 2;
constexpr size_t WS_WOD = WS_WE + 2 * WE_SIZE;
constexpr size_t WO_WC = 0, WO_WOC = (size_t)6144 * DM * 2, WO_SIZE = WO_WOC + SZ_SQ;
constexpr size_t WS_DP = WS_WOD + 2 * WO_SIZE, SZ_DP = (size_t)2 * 1024 * 2048 * 2;
constexpr size_t WS_DS = WS_DP + SZ_DP, SZ_DS = (size_t)2 * 4096 * 8192 * 2;
constexpr size_t WS_XB0 = WS_DS + SZ_DS, SZ_XB = (size_t)T * DM * 2;
constexpr size_t WS_XB1 = WS_XB0 + SZ_XB;
constexpr size_t WS_H = WS_XB1 + SZ_XB, SZ_H = (size_t)T * DFF * 2;
constexpr size_t WS_ZTP = WS_H, WS_ZTS = WS_ZTP + (size_t)16 * 1024 * 2048 * 2, WS_VT = WS_ZTS + (size_t)1024 * 8192 * 2, WS_U = WS_VT + (size_t)1024 * T * 2;
constexpr size_t WS_Z = WS_H, WS_GB = WS_H + SZ_XB;
constexpr size_t WS_PB = WS_H + SZ_H, SZ_PB = (size_t)NLAYER * T * 256 * 2;
constexpr size_t WS_END = WS_PB + SZ_PB;
static_assert(WS_U + (size_t)T * 1024 * 2 <= WS_H + SZ_H && WS_GB + SZ_XB <= WS_H + SZ_H, "mixer buffers overlay the FFN hidden buffer");
static_assert(WS_STATS + (size_t)18 * T * 8 <= CTL_BYTES && (CW_BAR + 3456) * 4 <= (int)WS_STATS, "control region");
static_assert(WS_END < 1800000000ull, "d_ws map");

constexpr int LDS_BYTES = 147456;
constexpr int LDSCTL_OFF = 131072;

#define LDS_WAIT() asm volatile("s_waitcnt lgkmcnt(0)" ::: "memory")
__device__ __forceinline__ unsigned f2bf(float f) { unsigned u = __builtin_bit_cast(unsigned, f); return (u + 0x7fffu + ((u >> 16) & 1u)) >> 16; }
__device__ __forceinline__ unsigned pk2(float lo, float hi) { return f2bf(lo) | (f2bf(hi) << 16); }
__device__ __forceinline__ float bflo(unsigned w) { return __uint_as_float(w << 16); }
__device__ __forceinline__ float bfhi(unsigned w) { return __uint_as_float(w & 0xffff0000u); }
__device__ __forceinline__ float wave_sum(float v) {
#pragma unroll
    for (int o = 1; o < 64; o <<= 1) v += __shfl_xor(v, o);
    return v;
}
#define XB_TMO      128
#define XB_XCNT(j)  (256  + 64 * (j))
#define XB_XSUB(j)  (1280 + 64 * (j))
#define XB_XGEN(j)  (2304 + 64 * (j))
#define XB_TOP      3328
#define XB_TOPGEN   3392
#define XCD_BAR_WORDS 3456
#define XB_SPIN_CAP (1u << 18)

__device__ __forceinline__ unsigned xb_ld(unsigned* p)              { return __hip_atomic_load(p, __ATOMIC_RELAXED, __HIP_MEMORY_SCOPE_AGENT); }
__device__ __forceinline__ unsigned xb_add(unsigned* p, unsigned v) { return __hip_atomic_fetch_add(p, v, __ATOMIC_RELAXED, __HIP_MEMORY_SCOPE_AGENT); }
__device__ __forceinline__ unsigned xb_xcc_id() { return (unsigned)__builtin_amdgcn_s_getreg((3 << 11) | 20) & 0xFu; }
#define XB_SPIN(cond, bar) do { unsigned _sp = 0; while (cond) { __builtin_amdgcn_s_sleep(1); \
    if ((++_sp & 255u) == 0u) { if (xb_ld(&(bar)[XB_TMO])) break; if (_sp > XB_SPIN_CAP) { atomicAdd(&(bar)[XB_TMO], 1u); break; } } } } while (0)

struct XcdBarrier {
    unsigned* bar; unsigned x;
    volatile LAS unsigned* st;
};

__device__ __forceinline__ XcdBarrier xcd_barrier_post(unsigned* bar, volatile LAS unsigned* st) {
    XcdBarrier b; b.bar = bar; b.x = xb_xcc_id(); b.st = st;
    if (threadIdx.x == 0) (void)xb_add(&bar[XB_XCNT(b.x)], 1u);
    return b;
}
__device__ __forceinline__ void xcd_barrier_complete(unsigned* bar, unsigned x, unsigned& nloc, unsigned& nx) {
    const unsigned G = gridDim.x * gridDim.y * gridDim.z;
    unsigned sum, cnt, mine, sp = 0u;
    for (;;) {
        sum = 0u; cnt = 0u; mine = 0u;
#pragma unroll
        for (unsigned j = 0; j < 16; ++j) { const unsigned c = xb_ld(&bar[XB_XCNT(j)]); sum += c; cnt += (c > 0u) ? 1u : 0u; mine = (j == x) ? c : mine; }
        if (sum == G) break;
        __builtin_amdgcn_s_sleep(1);
        if ((++sp & 255u) == 0u) { if (xb_ld(&bar[XB_TMO])) break; if (sp > XB_SPIN_CAP) { atomicAdd(&bar[XB_TMO], 1u); break; } }
    }
    nloc = mine > 0u ? mine : 1u; nx = cnt > 0u ? cnt : 1u;
}

__device__ __forceinline__ void xcd_barrier(const XcdBarrier& b) {
    asm volatile("s_waitcnt vmcnt(0)" ::: "memory");
    __syncthreads();
    if (threadIdx.x == 0) {
        unsigned* bar = b.bar;
        __builtin_amdgcn_s_waitcnt(0);
        unsigned nloc = b.st[0], nx = b.st[1];
        if (nloc == 0u) { xcd_barrier_complete(bar, b.x, nloc, nx); b.st[0] = nloc; b.st[1] = nx; }
        const unsigned old = xb_add(&bar[XB_XSUB(b.x)], 1u);
        const unsigned gen = old / nloc;
        if (old + 1u == (gen + 1u) * nloc) {
            __builtin_amdgcn_fence(__ATOMIC_RELEASE, "agent");
            asm volatile("s_waitcnt vmcnt(0)" ::: "memory");
            const unsigned og = xb_add(&bar[XB_TOP], 1u);
            const unsigned tg = og / nx;
            if (og + 1u == (tg + 1u) * nx) xb_add(&bar[XB_TOPGEN], 1u);
            else XB_SPIN(xb_ld(&bar[XB_TOPGEN]) == tg, bar);
            __builtin_amdgcn_fence(__ATOMIC_ACQUIRE, "agent");
            xb_add(&bar[XB_XGEN(b.x)], 1u);
            asm volatile("s_waitcnt vmcnt(0)" ::: "memory");
        } else {
            XB_SPIN(xb_ld(&bar[XB_XGEN(b.x)]) == gen, bar);
            __builtin_amdgcn_fence(__ATOMIC_ACQUIRE, "agent");
            asm volatile("s_waitcnt vmcnt(0)" ::: "memory");
        }
    }
    __syncthreads();
}
__device__ __forceinline__ void tr_item(const float* W, int ldw, int K, const float* g, bf16* WT, int dst_row0, LAS float* scr, int k0, int n0, int lane) {
    {
        f32x4 v[8]; const int kr = lane >> 3, n4 = (lane & 7) * 4;
#pragma unroll
        for (int i = 0; i < 8; ++i) v[i] = *(const f32x4*)(W + (size_t)(k0 + 8 * i + kr) * ldw + n0 + n4);
        if (g) {
#pragma unroll
            for (int i = 0; i < 8; ++i) v[i] = v[i] * g[k0 + 8 * i + kr]; }
#pragma unroll
        for (int i = 0; i < 8; ++i) { LAS float* d = scr + (8 * i + kr) * 33 + n4; d[0] = v[i][0]; d[1] = v[i][1]; d[2] = v[i][2]; d[3] = v[i][3]; }
    }
    LDS_WAIT(); asm volatile("" ::: "memory");
    const int c = lane & 7;
#pragma unroll
    for (int j = 0; j < 4; ++j) { const int n = (lane >> 3) + 8 * j; const LAS float* s = scr + (8 * c) * 33 + n;
        v4u o; o.x = pk2(s[0 * 33], s[1 * 33]); o.y = pk2(s[2 * 33], s[3 * 33]); o.z = pk2(s[4 * 33], s[5 * 33]); o.w = pk2(s[6 * 33], s[7 * 33]);
        *(GAS v4u*)(WT + (size_t)(dst_row0 + n) * K + k0 + 8 * c) = o; }
    LDS_WAIT(); asm volatile("" ::: "memory");
}
__device__ __forceinline__ void hc_rows(int kd, int& r1, int& r2, float& c2) {
    if (kd < 528) { const int h = kd / 33, cp = kd - 33 * h; r1 = 64 * h + cp; if (cp == 0 || cp == 32) { r2 = r1; c2 = 0.f; } else { r2 = 64 * h + 64 - cp; c2 = 1.f; } }
    else { const int q = kd - 528, h = q / 31, cp = 1 + q - 31 * h; r1 = 64 * h + 64 - cp; r2 = 64 * h + cp; c2 = -1.f; }
}
__device__ __forceinline__ void tr_item_wofold(const float* W, bf16* WT, LAS float* scr, int k0, int n0, int lane) {
    {   f32x4 v[8], w[8]; float cc[8]; const int kr = lane >> 3, n4 = (lane & 7) * 4;
#pragma unroll
        for (int i = 0; i < 8; ++i) { int r1, r2; hc_rows(k0 + 8 * i + kr, r1, r2, cc[i]); v[i] = *(const f32x4*)(W + (size_t)r1 * DM + n0 + n4); w[i] = *(const f32x4*)(W + (size_t)r2 * DM + n0 + n4); }
#pragma unroll
        for (int i = 0; i < 8; ++i) { const f32x4 t = v[i] + w[i] * cc[i]; LAS float* d = scr + (8 * i + kr) * 33 + n4; d[0] = t[0]; d[1] = t[1]; d[2] = t[2]; d[3] = t[3]; }
    }
    LDS_WAIT(); asm volatile("" ::: "memory");
    const int c = lane & 7;
#pragma unroll
    for (int j = 0; j < 4; ++j) { const int n = (lane >> 3) + 8 * j; const LAS float* s = scr + (8 * c) * 33 + n;
        v4u o; o.x = pk2(s[0 * 33], s[1 * 33]); o.y = pk2(s[2 * 33], s[3 * 33]); o.z = pk2(s[4 * 33], s[5 * 33]); o.w = pk2(s[6 * 33], s[7 * 33]);
        *(GAS v4u*)(WT + (size_t)(n0 + n) * DM + k0 + 8 * c) = o; }
    LDS_WAIT(); asm volatile("" ::: "memory");
}
__device__ __forceinline__ int map_id(int n) { return n; }
__device__ __forceinline__ int map_glu(int n) { return n < DFF ? 256 * (n >> 7) + (n & 127) : 256 * ((n - DFF) >> 7) + 128 + ((n - DFF) & 127); }
__device__ __forceinline__ int map_oddin(int n) { return n < 2048 ? 4096 + n : (n < 4096 ? 256 * ((n - 2048) >> 7) + ((n - 2048) & 127) : 256 * ((n - 4096) >> 7) + 128 + ((n - 4096) & 127)); }

struct Args { const float* in[24]; float* out; unsigned char* ws; int ph_lo, ph_hi; };

__device__ __forceinline__ void p0_prologue(const Args& a, LAS unsigned char* lds, int vcu, int G, int wave, int lane, int tid) {
    unsigned char* ws = a.ws;
    LAS float* scr = (LAS float*)(lds + wave * 16384);
    const int gw = vcu * 8 + wave, NGW = G * 8;
    constexpr int I_FIN = (DM / 64) * (2 * DFF / 32), I_FOUT = (DFF / 64) * (DM / 32), I_SQ = (DM / 64) * (DM / 32), I_WP = (256 / 64) * (DM / 32);
    constexpr int I_L = 2 * I_FIN + 2 * I_FOUT + I_SQ + I_WP;
    constexpr int I_EIN = (DM / 64) * (2048 / 32), I_E = I_EIN + I_SQ;
    constexpr int I_OIN = (DM / 64) * (6144 / 32), I_O = I_OIN + I_SQ;
    constexpr int NITEMS = NLAYER * I_L + 2 * I_E + 2 * I_O;
#define TR_JOB(CNT_, W_, LDW_, K_, NCOLS_, G_, WT_, MAP_) { if (r < (CNT_)) { const int nblk = (NCOLS_) / 32, kb = r / nblk, n0 = (r % nblk) * 32; tr_item(W_, LDW_, K_, G_, WT_, MAP_(n0), scr, kb * 64, n0, lane); continue; } r -= (CNT_); }
    for (int it = gw; it < NITEMS; it += NGW) {
        int r = it;
        if (r < NLAYER * I_L) { const int L = r / I_L; r -= L * I_L; unsigned char* wl = ws + WS_W + (size_t)L * WL_SIZE;
            TR_JOB(I_FIN, a.in[5] + (size_t)L * DM * 2 * DFF, 2 * DFF, DM, 2 * DFF, a.in[4] + L * DM, (bf16*)(wl + WL_F1IN), map_glu)
            TR_JOB(I_FOUT, a.in[6] + (size_t)L * DFF * DM, DM, DFF, DM, (const float*)nullptr, (bf16*)(wl + WL_F1OUT), map_id)
            TR_JOB(I_FIN, a.in[18] + (size_t)L * DM * 2 * DFF, 2 * DFF, DM, 2 * DFF, a.in[17] + L * DM, (bf16*)(wl + WL_F2IN), map_glu)
            TR_JOB(I_FOUT, a.in[19] + (size_t)L * DFF * DM, DM, DFF, DM, (const float*)nullptr, (bf16*)(wl + WL_F2OUT), map_id)
            TR_JOB(I_SQ, a.in[21] + (size_t)L * DM * DM, DM, DM, DM, a.in[20] + L * DM, (bf16*)(wl + WL_WG), map_id)
            TR_JOB(I_WP, a.in[22] + (size_t)L * 256 * DM, DM, 256, DM, (const float*)nullptr, (bf16*)(wl + WL_WP), map_id)
            continue; }
        r -= NLAYER * I_L;
        if (r < 2 * I_E) { const int j = r / I_E; r -= j * I_E; unsigned char* we = ws + WS_WE + (size_t)j * WE_SIZE; const float* gm = a.in[7] + (2 * j) * DM;
            if (r < I_EIN) { const int nblk = 2048 / 32, kb = r / nblk, n0 = (r % nblk) * 32; const float* W = a.in[8] + (size_t)j * DM * 3072 + 1024;
                if (n0 < 1024) tr_item(W, 3072, DM, gm, (bf16*)(we + WE_WU), n0, scr, kb * 64, n0, lane);
                else tr_item(W, 3072, DM, gm, (bf16*)(we + WE_WZ), 1024 + (n0 - 1024), scr, kb * 64, n0, lane);
                continue; }
            r -= I_EIN;
            { const int nblk = DM / 32, kb = r / nblk, n0 = (r % nblk) * 32; const float* W = a.in[12] + (size_t)j * DM * DM;
              if (kb < 16) tr_item_wofold(W, (bf16*)(we + WE_WO), scr, kb * 64, n0, lane); else tr_item(W, DM, DM, (const float*)nullptr, (bf16*)(we + WE_WO), n0, scr, kb * 64, n0, lane); }
            continue; }
        r -= 2 * I_E;
        { const int j = r / I_O; r -= j * I_O; unsigned char* wo = ws + WS_WOD + (size_t)j * WO_SIZE;
            TR_JOB(I_OIN, a.in[13] + (size_t)j * DM * 6144, 6144, DM, 6144, a.in[7] + (2 * j + 1) * DM, (bf16*)(wo + WO_WC), map_oddin)
            TR_JOB(I_SQ, a.in[16] + (size_t)j * DM * DM, DM, DM, DM, (const float*)nullptr, (bf16*)(wo + WO_WOC), map_id)
        }
    }
#undef TR_JOB
    {   LAS float* tab = scr + 2200;
        tab[lane] = cospif((float)lane * (1.0f / 32.0f));
        LDS_WAIT(); asm volatile("" ::: "memory");
        const bool isq = lane >= 33; const int cp = isq ? lane - 32 : lane, toff = isq ? 48 : 0;
        for (int it = gw; it < 2 * 64 * 16; it += NGW) { const int j = it >> 10, kb = (it >> 4) & 63, h = it & 15; const int k0 = kb * 32;
            const float* W = a.in[8] + (size_t)j * DM * 3072 + h * 64; const float* gm = a.in[7] + (2 * j) * DM; bf16* WZ = (bf16*)(ws + WS_WE + (size_t)j * WE_SIZE + WE_WZ);
            const int zr = isq ? 528 + h * 31 + (lane - 33) : h * 33 + lane;
            for (int kq = 0; kq < 4; ++kq) {
                float ac[8];
#pragma unroll
                for (int q = 0; q < 8; ++q) ac[q] = 0.f;
                for (int cc = 0; cc < 64; ++cc) { const float tv = tab[((cc * cp) + toff) & 63];
#pragma unroll
                    for (int q = 0; q < 8; ++q) ac[q] += W[(size_t)(k0 + kq * 8 + q) * 3072 + cc] * tv; }
#pragma unroll
                for (int q = 0; q < 8; ++q) ac[q] *= gm[k0 + kq * 8 + q];
                v4u oc; oc.x = pk2(ac[0], ac[1]); oc.y = pk2(ac[2], ac[3]); oc.z = pk2(ac[4], ac[5]); oc.w = pk2(ac[6], ac[7]);
                *(GAS v4u*)(WZ + (size_t)zr * DM + k0 + kq * 8) = oc; }
        }
        LDS_WAIT(); asm volatile("" ::: "memory");
    }
    const size_t gt = (size_t)vcu * 512 + tid, NGT = (size_t)G * 512;
    for (size_t e = gt; e < (size_t)2 * 16 * 128 * 128 / 8; e += NGT) { const size_t j = e / (16 * 128 * 128 / 8), rem = e % (16 * 128 * 128 / 8);
        const f32x4 v0 = *(const f32x4*)(a.in[10] + e * 8), v1 = *(const f32x4*)(a.in[10] + e * 8 + 4);
        v4u o; o.x = pk2(v0[0], v0[1]); o.y = pk2(v0[2], v0[3]); o.z = pk2(v1[0], v1[1]); o.w = pk2(v1[2], v1[3]);
        *(GAS v4u*)((bf16*)(ws + WS_WE + j * WE_SIZE + WE_WS) + rem * 8) = o; }
#pragma unroll 1
    for (int which = 0; which < 2; ++which) { const int S = which ? 8192 : 2048, lg = which ? 13 : 11; bf16* Dm = (bf16*)(ws + (which ? WS_DS : WS_DP)); const float sc2 = 2.0f / (float)S;
        const size_t per_row = (size_t)(S / 8), per_mat = (size_t)(S / 2) * per_row, total = 2 * per_mat;
        for (size_t e = gt; e < total; e += NGT) { const bool sn = e >= per_mat; const size_t e2 = sn ? e - per_mat : e; const int k = (int)(e2 >> (lg - 3)), s0 = (int)(e2 & (per_row - 1)) * 8; float v[8];
            if (!sn) {
#pragma unroll
                for (int q = 0; q < 8; ++q) v[q] = cospif((float)((k * (s0 + q)) & (S - 1)) * sc2);
            } else {
#pragma unroll
                for (int q = 0; q < 8; ++q) v[q] = sinpif((float)((k * (s0 + q)) & (S - 1)) * sc2);
            }
            v4u o; o.x = pk2(v[0], v[1]); o.y = pk2(v[2], v[3]); o.z = pk2(v[4], v[5]); o.w = pk2(v[6], v[7]);
            *(GAS v4u*)(Dm + e * 8) = o; } }
    { pg8::stat_t* st0 = (pg8::stat_t*)(ws + WS_STATS); bf16* xb0 = (bf16*)(ws + WS_XB0);
        for (int row = gw; row < T; row += NGW) { const float* src = row < TP ? a.in[0] + (size_t)row * DM : a.in[1] + (size_t)(row - TP) * DM;
            const f32x4* xr = (const f32x4*)src + lane; f32x4 v[8]; float s = 0.f;
#pragma unroll
            for (int j = 0; j < 8; ++j) { v[j] = xr[64 * j]; s += (v[j][0] * v[j][0] + v[j][1] * v[j][1]) + (v[j][2] * v[j][2] + v[j][3] * v[j][3]); }
            s = wave_sum(s); if (lane == 0) st0[row] = pg8::stat_fix(s);
            v2u* brow = (v2u*)(xb0 + (size_t)row * DM) + lane;
#pragma unroll
            for (int j = 0; j < 8; ++j) { v2u w; w.x = pk2(v[j][0], v[j][1]); w.y = pk2(v[j][2], v[j][3]); brow[64 * j] = w; } } }
    { bf16* pb = (bf16*)(ws + WS_PB);
        for (size_t e = gt; e < (size_t)NLAYER * T * 256 / 8; e += NGT) { const size_t L = e / ((size_t)T * 32), rem = e % ((size_t)T * 32), row = rem >> 5, c8 = rem & 31;
            const float* src = row < (size_t)TP ? a.in[2] + ((size_t)L * TP + row) * 256 + c8 * 8 : a.in[3] + ((size_t)L * 8192 + (row - TP)) * 256 + c8 * 8;
            const f32x4 v0 = *(const f32x4*)src, v1 = *(const f32x4*)(src + 4);
            v4u o; o.x = pk2(v0[0], v0[1]); o.y = pk2(v0[2], v0[3]); o.z = pk2(v1[0], v1[1]); o.w = pk2(v1[2], v1[3]);
            *(GAS v4u*)(pb + e * 8) = o; } }
}

__device__ __forceinline__ void sgu_phase(const bf16* Wsb, const float* bs, const bf16* VT, const bf16* U, bf16* Y, int idx, int n) {
    int tid_o = threadIdx.x; asm volatile("" : "+v"(tid_o)); const int lane = tid_o & 63, wave = __builtin_amdgcn_readfirstlane(tid_o >> 6);
    const int h = idx & 15, q = idx >> 4, nq = n >> 4, ct = wave & 3, th = wave >> 2, fr = lane & 15, fq = lane >> 4;
    if (idx < 0 || idx >= n || nq == 0) return;
    bf16x8 wf[4][4];
#pragma unroll
    for (int tt = 0; tt < 4; ++tt)
#pragma unroll
        for (int ks = 0; ks < 4; ++ks) wf[tt][ks] = *(const bf16x8*)(Wsb + ((size_t)h * 128 + th * 64 + tt * 16 + fr) * 128 + ks * 32 + fq * 8);
    float bias[4];
#pragma unroll
    for (int tt = 0; tt < 4; ++tt) bias[tt] = bs[h * 128 + th * 64 + tt * 16 + fr];
    for (int ch = q; ch < T / 128; ch += nq) {
        bf16x8 vf[4];
#pragma unroll
        for (int ks = 0; ks < 4; ++ks) vf[ks] = *(const bf16x8*)(VT + (size_t)(h * 64 + ct * 16 + fr) * T + (size_t)ch * 128 + ks * 32 + fq * 8);
#pragma unroll
        for (int tt = 0; tt < 4; ++tt) { f32x4 acc = (f32x4){0.f, 0.f, 0.f, 0.f};
#pragma unroll
            for (int ks = 0; ks < 4; ++ks) acc = __builtin_amdgcn_mfma_f32_16x16x32_bf16(vf[ks], wf[tt][ks], acc, 0, 0, 0);
            const size_t t = (size_t)ch * 128 + th * 64 + tt * 16 + fr; const int c = h * 64 + ct * 16 + fq * 4;
            const v2u uu = *(const v2u*)(U + t * 1024 + c);
            v2u o; o.x = pk2(bflo(uu.x) * (acc[0] + bias[tt]), bfhi(uu.x) * (acc[1] + bias[tt])); o.y = pk2(bflo(uu.y) * (acc[2] + bias[tt]), bfhi(uu.y) * (acc[3] + bias[tt]));
            *(v2u*)(Y + t * 2048 + 1024 + c) = o; }
    }
}
__device__ __forceinline__ void conv_phase(const bf16* Z, const bf16* GB, const float* wc, const float* bc, bf16* Y, int vcu, int G) {
    int tid_o = threadIdx.x; asm volatile("" : "+v"(tid_o)); const size_t gt = (size_t)vcu * 512 + tid_o, NGT = (size_t)G * 512;
    for (size_t e = gt; e < (size_t)T * 256; e += NGT) { const int t = (int)(e >> 8), c0 = (int)(e & 255) * 8;
        const int sp = t < TP ? (t & 2047) : (t - TP), sl = t < TP ? 2048 : 8192;
        const v4u zc = *(const v4u*)(Z + (size_t)t * 2048 + c0), gb = *(const v4u*)(GB + (size_t)t * 2048 + c0);
        v4u zm = (v4u){0u, 0u, 0u, 0u}, zp = (v4u){0u, 0u, 0u, 0u};
        if (sp > 0) zm = *(const v4u*)(Z + (size_t)(t - 1) * 2048 + c0);
        if (sp < sl - 1) zp = *(const v4u*)(Z + (size_t)(t + 1) * 2048 + c0);
        const f32x4 w0a = *(const f32x4*)(wc + c0), w0b = *(const f32x4*)(wc + c0 + 4), w1a = *(const f32x4*)(wc + 2048 + c0), w1b = *(const f32x4*)(wc + 2048 + c0 + 4), w2a = *(const f32x4*)(wc + 4096 + c0), w2b = *(const f32x4*)(wc + 4096 + c0 + 4);
        const f32x4 ba = *(const f32x4*)(bc + c0), bb = *(const f32x4*)(bc + c0 + 4);
        float y[8];
#pragma unroll
        for (int p = 0; p < 4; ++p) { const unsigned m = zm[p], c = zc[p], n = zp[p], g = gb[p]; const int i0 = 2 * p, i1 = 2 * p + 1;
            const float w0l = i0 < 4 ? w0a[i0] : w0b[i0 - 4], w0h = i1 < 4 ? w0a[i1] : w0b[i1 - 4], w1l = i0 < 4 ? w1a[i0] : w1b[i0 - 4], w1h = i1 < 4 ? w1a[i1] : w1b[i1 - 4];
            const float w2l = i0 < 4 ? w2a[i0] : w2b[i0 - 4], w2h = i1 < 4 ? w2a[i1] : w2b[i1 - 4], bl = i0 < 4 ? ba[i0] : bb[i0 - 4], bh = i1 < 4 ? ba[i1] : bb[i1 - 4];
            y[i0] = bflo(g) * (w0l * bflo(m) + w1l * bflo(c) + w2l * bflo(n) + bl);
            y[i1] = bfhi(g) * (w0h * bfhi(m) + w1h * bfhi(c) + w2h * bfhi(n) + bh); }
        v4u o; o.x = pk2(y[0], y[1]); o.y = pk2(y[2], y[3]); o.z = pk2(y[4], y[5]); o.w = pk2(y[6], y[7]);
        *(GAS v4u*)(Y + (size_t)t * 2048 + c0) = o; }
}
__device__ __forceinline__ void final_phase(float* out, const bf16* XBf, const pg8::stat_t* st, const float* gf, int vcu, int G) {
    int tid_o = threadIdx.x; asm volatile("" : "+v"(tid_o)); const int lane = tid_o & 63, gw = vcu * 8 + __builtin_amdgcn_readfirstlane(tid_o >> 6), NGW = G * 8;
    f32x4 g[4][2];
#pragma unroll
    for (int j = 0; j < 4; ++j) { g[j][0] = *(const f32x4*)(gf + 512 * j + 8 * lane); g[j][1] = *(const f32x4*)(gf + 512 * j + 8 * lane + 4); }
    for (int row = gw; row < T; row += NGW) { const float r = pg8::rinv_of(st, row); const bf16* xr = XBf + (size_t)row * DM + 8 * lane; float* orow = out + (size_t)row * DM + 8 * lane;
#pragma unroll
        for (int j = 0; j < 4; ++j) { const v4u w = *(const v4u*)(xr + 512 * j); f32x4 a, b; a[0] = bflo(w.x); a[1] = bfhi(w.x); a[2] = bflo(w.y); a[3] = bfhi(w.y); b[0] = bflo(w.z); b[1] = bfhi(w.z); b[2] = bflo(w.w); b[3] = bfhi(w.w);
            *(f32x4*)(orow + 512 * j) = a * r * g[j][0]; *(f32x4*)(orow + 512 * j + 4) = b * r * g[j][1]; } }
}

__device__ __forceinline__ void dft_mid_rows(const bf16* ZTP, const bf16* ZTS, bf16* Y, int idx, int n) {
    int tid_o = threadIdx.x; asm volatile("" : "+v"(tid_o)); const int lane = tid_o & 63, wave = __builtin_amdgcn_readfirstlane(tid_o >> 6);
    if (idx < 0 || idx >= n) return;
    for (int it = idx * 8 + wave; it < 17 * 529; it += n * 8) { const int b = it / 529, col = it - 529 * b; const int S = b < 16 ? 2048 : 8192; const size_t row = (b < 16 ? (size_t)b * 2048 : (size_t)TP) + S / 2;
        if (col == 528) { unsigned zz = 0u; asm volatile("" : "+v"(zz)); v4u z4; z4.x = zz; z4.y = zz; z4.z = zz; z4.w = zz;
            if (lane < 62) *(GAS v4u*)(Y + row * 2048 + 528 + 8 * lane) = z4; continue; }
        const bf16* z = b < 16 ? ZTP + ((size_t)b * 1024 + col) * 2048 : ZTS + (size_t)col * 8192; float sum = 0.f;
        for (int s0 = lane * 8; s0 < S; s0 += 512) { const v4u w = *(const v4u*)(z + s0);
            sum += (bflo(w.x) - bfhi(w.x)) + (bflo(w.y) - bfhi(w.y)) + (bflo(w.z) - bfhi(w.z)) + (bflo(w.w) - bfhi(w.w)); }
        sum = wave_sum(sum);
        if (lane == 0) Y[row * 2048 + col] = (bf16)f2bf(sum * (b < 16 ? 0.0027621358640099515f : 0.0013810679320049757f)); }
}
struct DftOrder {
    int nM, ntile, tile0, nunits, n, c;
    __device__ void init(int nM_, int ntile_, int tile0_, int nbatch, int lo, int n_, int rot, int bx) { nM = nM_; ntile = ntile_; tile0 = tile0_; nunits = nM_ * ntile_ * nbatch; n = n_; c = (bx >= lo && bx < lo + n_) ? (bx - lo + rot) % n_ : 0x40000000; }
    __device__ bool next(int i, pg8::Unit& u) const { const long L = (long)i * n + c; if (L >= nunits) return false; const int l = (int)L, r = l / nM; u.pm = l - r * nM; u.pn = 4 * (r / ntile) + tile0 + r % ntile; return true; }
    __device__ __forceinline__ void a_ready(const pg8::Unit&) const {}
    __device__ __forceinline__ void done(const pg8::Unit&) const {}
};
struct DirOrder : pg8::StaticOrder {
    bool rev;
    __device__ void init_dir(int M, int N, int G_, int c_, bool rev_) { init(M, N, G_, c_); rev = rev_; }
    __device__ bool next(int i, pg8::Unit& u) const {
        const long L = (long)i * G + c; if (L >= nwg) return false;
        const int q = nwg / pg8::NXCD, r = nwg % pg8::NXCD; int wgid = (int)L; const int xcd = wgid % pg8::NXCD, off = wgid / pg8::NXCD;
        const int len = xcd < r ? q + 1 : q, base = xcd < r ? xcd * (q + 1) : r * (q + 1) + (xcd - r) * q;
        wgid = base + (rev ? len - 1 - off : off);
        const int nig = pg8::WGM * nN, gid = wgid / nig, fm = gid * pg8::WGM, gsz = (nM - fm) < pg8::WGM ? (nM - fm) : pg8::WGM;
        u.pm = fm + ((wgid % nig) % gsz); u.pn = (wgid % nig) / gsz; return true;
    }
};
struct RangeOrder : pg8::StaticOrder {
    __device__ void init_range(int M, int N, int lo, int n, int bx) { const int c_ = (bx >= lo && bx < lo + n) ? bx - lo : 0x40000000; init(M, N, n, c_); }
};

#ifndef MK_SITES
#define MK_SITES 0xFFFFFFFFu
#endif
#define SITE(n) (((MK_SITES) >> (n)) & 1u)
#ifndef MK_DUP
#define MK_DUP 0u
#endif
#define NREP(n) ((((MK_DUP) >> (n)) & 1u) ? 2 : 1)
#define DRY(n) (NREP(n) == 2 && rep == 0)
struct SameTileOrder : pg8::StaticOrder {
    __device__ bool next(int i, pg8::Unit& u) const { const bool r = pg8::StaticOrder::next(i, u); u.pm = 0; u.pn = 0; return r; }
};
#define OPAQUE_WS() unsigned char* wsl = ws; asm volatile("" : "+s"(wsl)); unsigned char* const wl = wsl + WS_W + (size_t)L * WL_SIZE; bf16* const xb = (bf16*)(wsl + ((L & 1) ? WS_XB1 : WS_XB0)); bf16* const xalt = (bf16*)(wsl + ((L & 1) ? WS_XB0 : WS_XB1)); bf16* const Hb = (bf16*)(wsl + WS_H); (void)wl; (void)xb; (void)xalt; (void)Hb
#ifndef MK_DIR
#define MK_DIR 1
#endif
#define PH_REV(k) ((MK_DIR) != 0 && ((k) & 1) != 0)
__global__ void __launch_bounds__(512, 2) mk_fwd(Args args) {
    extern __shared__ __attribute__((aligned(16))) unsigned char lds_raw[];
    LAS unsigned char* lds = (LAS unsigned char*)lds_raw;
    const int tid = threadIdx.x, lane = tid & 63, wave = __builtin_amdgcn_readfirstlane(tid >> 6);
    const int G = gridDim.x, bx = blockIdx.x;
    const int vcu = (G % 8 == 0) ? (bx % 8) * (G / 8) + bx / 8 : bx;
    unsigned char* ws = args.ws;
    volatile LAS unsigned* MISC = (volatile LAS unsigned*)(lds + LDSCTL_OFF);
    for (int u = tid; u < (LDS_BYTES - LDSCTL_OFF) / 4; u += 512) ((LAS unsigned*)(lds + LDSCTL_OFF))[u] = 0u;
    __syncthreads();
    XcdBarrier bar; bar.bar = (unsigned*)(ws + WS_CTL) + CW_BAR; bar.x = 0; bar.st = nullptr;
    if (MK_N_LAUNCHES == 1) bar = xcd_barrier_post((unsigned*)(ws + WS_CTL) + CW_BAR, MISC + 8);
    const int lo = args.ph_lo, hi = args.ph_hi;
#define IN(k) (lo <= (k) && (k) < hi)
#define SEAM(k) do { if (IN(k) && IN((k) + 1)) xcd_barrier(bar); } while (0)
    pg8::stat_t* stats = (pg8::stat_t*)(ws + WS_STATS); pg8::stat_t* st_dummy = stats + (size_t)17 * T;

    if (IN(0) && SITE(0)) for (int rep = 0; rep < NREP(0); ++rep) { p0_prologue(args, lds, vcu, G, wave, lane, tid); }
    SEAM(0);

#pragma unroll 1
    for (int L = 0; L < NLAYER; ++L) {
        const int pb0 = 1 + 8 * L, j = L >> 1; const bool odd = (L & 1) != 0;
        pg8::stat_t* st0 = stats + (size_t)(4 * L + 0) * T; pg8::stat_t* st1 = stats + (size_t)(4 * L + 1) * T; pg8::stat_t* st2 = stats + (size_t)(4 * L + 2) * T; pg8::stat_t* st3 = stats + (size_t)(4 * L + 3) * T; pg8::stat_t* st4 = stats + (size_t)(4 * L + 4) * T;
        { OPAQUE_WS();
#ifdef MK_NULLP
        if (IN(pb0 + 0) && (MK_NULLP & 4)) { pg8::Gemm g{xb, (const bf16*)(wl + WL_F1IN), T, 2 * DFF, DM}; SameTileOrder S; S.init(T, 2 * DFF, G, bx);
            pg8::EpiNull E{(float*)st_dummy}; pg8::gemm_phase<pg8::EpiNull, SameTileOrder, MK_ALIGN, MK_SP2>(lds, g, S, E); }
        if (IN(pb0 + 0) && (MK_NULLP & 1)) { pg8::Gemm g{xb, (const bf16*)(wl + WL_F1IN), T, 2 * DFF, DM}; pg8::StaticOrder S; S.init(T, 2 * DFF, G, bx);
            pg8::EpiNull E{(float*)st_dummy}; pg8::gemm_phase<pg8::EpiNull, pg8::StaticOrder, MK_ALIGN, MK_SP2>(lds, g, S, E); }
        if (IN(pb0 + 1) && (MK_NULLP & 2)) { pg8::Gemm g{(const bf16*)(wsl + WS_H), (const bf16*)(wl + WL_F1OUT), T, DM, DFF}; pg8::StaticOrder S; S.init(T, DM, G, bx);
            pg8::EpiNull E{(float*)st_dummy}; pg8::gemm_phase<pg8::EpiNull, pg8::StaticOrder, MK_ALIGN, MK_SP2>(lds, g, S, E); }
#endif
        if (IN(pb0 + 0) && SITE(1)) for (int rep = 0; rep < NREP(1); ++rep) { pg8::Gemm g{xb, (const bf16*)(wl + WL_F1IN), T, 2 * DFF, DM}; DirOrder S; S.init_dir(T, 2 * DFF, G, bx, PH_REV(0));
            pg8::EpiSwiGLU E{Hb, DFF, st0}; pg8::gemm_phase<pg8::EpiSwiGLU, DirOrder, MK_ALIGN, MK_SP2>(lds, g, S, E); }
        }
        SEAM(pb0 + 0);
        { OPAQUE_WS();
        if (IN(pb0 + 1) && SITE(2)) for (int rep = 0; rep < NREP(2); ++rep) { pg8::Gemm g{Hb, (const bf16*)(wl + WL_F1OUT), T, DM, DFF}; DirOrder S; S.init_dir(T, DM, G, bx, PH_REV(1));
            pg8::EpiRmw<0> E{xb, xb, nullptr, DRY(2) ? st_dummy : st1, DRY(2) ? 0.0f : 0.5f}; pg8::gemm_phase<pg8::EpiRmw<0>, DirOrder, MK_ALIGN, MK_SP2>(lds, g, S, E); }
        }
        SEAM(pb0 + 1);
        { OPAQUE_WS();
        if (IN(pb0 + 2)) {
            if (!odd) { unsigned char* we = wsl + WS_WE + (size_t)j * WE_SIZE;
                if (SITE(3)) for (int rep = 0; rep < NREP(3); ++rep) { pg8::Gemm g{(const bf16*)(we + WE_WZ), xb, 2048, T, DM}; DirOrder S; S.init_dir(2048, T, G, bx, PH_REV(2));
                  pg8::EpiMT E{(bf16*)(wsl + WS_ZTP), (bf16*)(wsl + WS_ZTS), (bf16*)(wsl + WS_VT), st1, args.in[9] + j * 1024};
                  pg8::gemm_phase<pg8::EpiMT, DirOrder, MK_ALIGN, MK_SP2>(lds, g, S, E); }
                if (SITE(4)) for (int rep = 0; rep < NREP(4); ++rep) { pg8::Gemm g{xb, (const bf16*)(we + WE_WU), T, 1024, DM}; DirOrder S; S.init_dir(T, 1024, G, (bx + G / 2) % G, PH_REV(2));
                  pg8::EpiRowBf16<1> E{(bf16*)(wsl + WS_U), 1024, st1}; pg8::gemm_phase<pg8::EpiRowBf16<1>, DirOrder, MK_ALIGN, MK_SP2>(lds, g, S, E); }
            } else if (SITE(5)) for (int rep = 0; rep < NREP(5); ++rep) { unsigned char* wo = wsl + WS_WOD + (size_t)j * WO_SIZE;
                pg8::Gemm g{xb, (const bf16*)(wo + WO_WC), T, 6144, DM}; DirOrder S; S.init_dir(T, 6144, G, bx, PH_REV(2));
                pg8::EpiOddIn E{(bf16*)(wsl + WS_Z), (bf16*)(wsl + WS_GB), st1}; pg8::gemm_phase<pg8::EpiOddIn, DirOrder, MK_ALIGN, MK_SP2>(lds, g, S, E); }
        }
        }
        SEAM(pb0 + 2);
        { OPAQUE_WS();
        if (IN(pb0 + 3)) {
            if (!odd) { unsigned char* we = wsl + WS_WE + (size_t)j * WE_SIZE;
                const bool tuned = (G == 256); const int s_lo = 0, sp_n = tuned ? 48 : G, sq_lo = tuned ? 48 : 0, sq_n = tuned ? 32 : G, p_lo = tuned ? 80 : 0, p_n = tuned ? 176 : G;
                const bf16* dpc = (const bf16*)(wsl + WS_DP); const bf16* dps = dpc + (size_t)1024 * 2048; const bf16* dsc = (const bf16*)(wsl + WS_DS); const bf16* dss = dsc + (size_t)4096 * 8192;
                if (SITE(7)) for (int rep = 0; rep < NREP(7); ++rep) {
                  { pg8::Gemm g{dsc, (const bf16*)(wsl + WS_ZTS), 4096, 1024, 8192}; DftOrder S; S.init(16, 3, 0, 1, s_lo, sp_n, 0, bx);
                    pg8::EpiDFT E{xalt, TP, 8192, 0.0013810679320049757f, 1.0f, 0, 528}; pg8::gemm_phase<pg8::EpiDFT, DftOrder, MK_ALIGN, MK_SP2>(lds, g, S, E); }
                  { pg8::Gemm g{dss, (const bf16*)(wsl + WS_ZTS), 4096, 1024, 8192}; DftOrder S; S.init(16, 2, 2, 1, sq_lo, sq_n, 0, bx);
                    pg8::EpiDFT E{xalt, TP, 8192, 0.0013810679320049757f, -1.0f, 528, 1024}; pg8::gemm_phase<pg8::EpiDFT, DftOrder, MK_ALIGN, MK_SP2>(lds, g, S, E); } }
                if (SITE(6)) for (int rep = 0; rep < NREP(6); ++rep) {
                  { pg8::Gemm g{dpc, (const bf16*)(wsl + WS_ZTP), 1024, 16 * 1024, 2048}; DftOrder S; S.init(4, 3, 0, 16, p_lo, p_n, 0, bx);
                    pg8::EpiDFT E{xalt, 0, 2048, 0.0027621358640099515f, 1.0f, 0, 528}; pg8::gemm_phase<pg8::EpiDFT, DftOrder, MK_ALIGN, MK_SP2>(lds, g, S, E); }
                  { pg8::Gemm g{dps, (const bf16*)(wsl + WS_ZTP), 1024, 16 * 1024, 2048}; DftOrder S; S.init(4, 2, 2, 16, p_lo, p_n, tuned ? 160 : 0, bx);
                    pg8::EpiDFT E{xalt, 0, 2048, 0.0027621358640099515f, -1.0f, 528, 1024}; pg8::gemm_phase<pg8::EpiDFT, DftOrder, MK_ALIGN, MK_SP2>(lds, g, S, E); } }
                dft_mid_rows((const bf16*)(wsl + WS_ZTP), (const bf16*)(wsl + WS_ZTS), xalt, tuned ? bx : bx, tuned ? 80 : G);
                if (SITE(8)) for (int rep = 0; rep < NREP(8); ++rep) sgu_phase((const bf16*)(we + WE_WS), args.in[11] + j * 2048, (const bf16*)(wsl + WS_VT), (const bf16*)(wsl + WS_U), xalt, bx - p_lo, p_n & ~15);
            } else if (SITE(9)) for (int rep = 0; rep < NREP(9); ++rep) {
                conv_phase((const bf16*)(wsl + WS_Z), (const bf16*)(wsl + WS_GB), args.in[14] + j * 3 * 2048, args.in[15] + j * 2048, xalt, vcu, G);
            }
        }
        }
        SEAM(pb0 + 3);
        { OPAQUE_WS();
        if (IN(pb0 + 4) && SITE(10)) for (int rep = 0; rep < NREP(10); ++rep) { const bf16* wout = odd ? (const bf16*)(wsl + WS_WOD + (size_t)j * WO_SIZE + WO_WOC) : (const bf16*)(wsl + WS_WE + (size_t)j * WE_SIZE + WE_WO);
            pg8::Gemm g{xalt, wout, T, DM, DM}; DirOrder S; S.init_dir(T, DM, G, bx, PH_REV(4));
            pg8::EpiRmw<0> E{xb, xb, nullptr, DRY(10) ? st_dummy : st2, DRY(10) ? 0.0f : 1.0f}; pg8::gemm_phase<pg8::EpiRmw<0>, DirOrder, MK_ALIGN, MK_SP2>(lds, g, S, E); }
        }
        SEAM(pb0 + 4);
        { OPAQUE_WS();
        if (IN(pb0 + 5) && SITE(11)) for (int rep = 0; rep < NREP(11); ++rep) { pg8::Gemm g{xb, (const bf16*)(wl + WL_F2IN), T, 2 * DFF, DM}; DirOrder S; S.init_dir(T, 2 * DFF, G, bx, PH_REV(5));
            pg8::EpiSwiGLU E{Hb, DFF, st2}; pg8::gemm_phase<pg8::EpiSwiGLU, DirOrder, MK_ALIGN, MK_SP2>(lds, g, S, E); }
        }
        SEAM(pb0 + 5);
        { OPAQUE_WS();
        if (IN(pb0 + 6)) {
            if (SITE(12)) for (int rep = 0; rep < NREP(12); ++rep) { pg8::Gemm g{Hb, (const bf16*)(wl + WL_F2OUT), T, DM, DFF}; DirOrder S; S.init_dir(T, DM, G, bx, PH_REV(6));
              pg8::EpiRmw<0> E{xb, xb, nullptr, DRY(12) ? st_dummy : st3, DRY(12) ? 0.0f : 0.5f}; pg8::gemm_phase<pg8::EpiRmw<0>, DirOrder, MK_ALIGN, MK_SP2>(lds, g, S, E); }
            if (SITE(13)) for (int rep = 0; rep < NREP(13); ++rep) { int kpe = 256; asm volatile("" : "+s"(kpe));
              pg8::Gemm g{(const bf16*)(wsl + WS_PB) + (size_t)L * T * 256, (const bf16*)(wl + WL_WP), T, DM, kpe}; DirOrder S; S.init_dir(T, DM, G, bx, PH_REV(6));
              pg8::EpiRowBf16<0> E{xalt, 2048, nullptr}; pg8::gemm_phase<pg8::EpiRowBf16<0>, DirOrder, MK_ALIGN, MK_SP2>(lds, g, S, E); }
        }
        }
        SEAM(pb0 + 6);
        { OPAQUE_WS();
        if (IN(pb0 + 7) && SITE(14)) for (int rep = 0; rep < NREP(14); ++rep) { pg8::Gemm g{xb, (const bf16*)(wl + WL_WG), T, DM, DM}; DirOrder S; S.init_dir(T, DM, G, bx, PH_REV(7));
            pg8::EpiRmw<1> E{xb, xalt, st3, DRY(14) ? st_dummy : st4, DRY(14) ? 0.0f : 1.0f}; pg8::gemm_phase<pg8::EpiRmw<1>, DirOrder, MK_ALIGN, MK_SP2>(lds, g, S, E); }
        }
        SEAM(pb0 + 7);
    }
    if (IN(33) && SITE(15)) final_phase(args.out, (const bf16*)(ws + WS_XB0), stats + (size_t)16 * T, args.in[23], vcu, G);
#undef IN
#undef SEAM
}

extern "C" void kernel_launch(void* const* d_in, const int* in_sizes, int n_in, void* d_out, int out_size, void* d_ws, size_t ws_size, hipStream_t stream) {
    static int grid = 0;
    if (grid == 0) {
        if (n_in != 24 || out_size != T * DM || ws_size < WS_END) { fprintf(stderr, "kernel_launch: unexpected sizes (n_in %d, out %d, ws %zu, need %zu); nothing launched\n", n_in, out_size, ws_size, (size_t)WS_END); grid = -1; return; }
        int dev = 0, cus = 0, per_cu = 0;
        if (hipGetDevice(&dev) != hipSuccess || hipDeviceGetAttribute(&cus, hipDeviceAttributeMultiprocessorCount, dev) != hipSuccess) { grid = -1; return; }
        if (hipFuncSetAttribute((const void*)mk_fwd, hipFuncAttributeMaxDynamicSharedMemorySize, LDS_BYTES) != hipSuccess) { fprintf(stderr, "kernel_launch: hipFuncSetAttribute failed\n"); grid = -1; return; }
        if (hipOccupancyMaxActiveBlocksPerMultiprocessor(&per_cu, (const void*)mk_fwd, 512, LDS_BYTES) != hipSuccess || per_cu < 1) fprintf(stderr, "kernel_launch: occupancy query reports %d workgroups per CU\n", per_cu);
        (void)hipGetLastError();
        grid = cus;
    }
    if (grid < 0) return;
#ifdef MK_POISON_WS
    if (hipMemsetAsync((char*)d_ws, 0xFF, WS_END, stream) != hipSuccess) return;
#endif
    if (hipMemsetAsync((char*)d_ws + WS_CTL, 0, CTL_BYTES, stream) != hipSuccess) return;
    Args a{};
    for (int i = 0; i < 24; ++i) a.in[i] = (const float*)d_in[i];
    a.out = (float*)d_out; a.ws = (unsigned char*)d_ws;
    if (MK_N_LAUNCHES == 1) { a.ph_lo = 0; a.ph_hi = NPHASE; hipLaunchKernelGGL(mk_fwd, dim3(grid), dim3(512), LDS_BYTES, stream, a); }
    else for (int p = 0; p < NPHASE; ++p) { a.ph_lo = p; a.ph_hi = p + 1; hipLaunchKernelGGL(mk_fwd, dim3(grid), dim3(512), LDS_BYTES, stream, a); }
}
```

```cpp
#include <hip/hip_runtime.h>
#include <cstdio>
#include <cstdint>
#ifndef MK_WGM
#define MK_WGM 4
#endif
#ifndef MK_SP2
#define MK_SP2 true
#endif
#ifndef MK_ALIGN
#define MK_ALIGN true
#endif
namespace pg8 {
#define PG8_LAS __attribute__((address_space(3)))
typedef unsigned short bf16_t;
typedef short bf16x8 __attribute__((ext_vector_type(8)));
typedef float f32x4 __attribute__((ext_vector_type(4)));
typedef unsigned u32x4 __attribute__((ext_vector_type(4)));
constexpr int BM = 256, BK = 64, HALF = 128, HTB = HALF * BK * 2  , STAGE_BYTES = 8 * HTB, NXCD = 8, WGM = MK_WGM;

__host__ __device__ __forceinline__ int lds_byte(int r, int c) { const int st = (r >> 4) * 2 + (c >> 5), rr = r & 15, cc = c & 31, ob = rr * 64 + cc * 2; return st * 1024 + (ob ^ (((ob >> 9) & 1) << 5)); }
__host__ __device__ __forceinline__ void stage_rc(int b, int& R, int& C) { const int st = b / 1024, sb = b % 1024, swz = sb ^ (((sb >> 9) & 1) << 5); R = (st >> 1) * 16 + swz / 64; C = (st & 1) * 32 + (swz % 64) / 2; }
__host__ __device__ __forceinline__ int perm32(int rho) { const int n = rho >> 4, i = rho & 15; return 8 * (i >> 2) + 4 * n + (i & 3); }

struct Unit { int pm, pn; };
struct Gemm { const bf16_t* A; const bf16_t* Bt; int M, N, K; };

struct StaticOrder {
    int nM, nN, nwg, G, c;
    __host__ __device__ void init(int M, int N, int G_, int c_) { nM = M / BM; nN = N / BM; nwg = nM * nN; G = G_; c = c_; }
    __host__ __device__ bool next(int i, Unit& u) const {
        const long L = (long)i * G + c; if (L >= nwg) return false;
        int wgid = (int)L; { const int q = nwg / NXCD, r = nwg % NXCD, xcd = wgid % NXCD, off = wgid / NXCD; wgid = (xcd < r ? xcd * (q + 1) : r * (q + 1) + (xcd - r) * q) + off; }
        const int nig = WGM * nN, gid = wgid / nig, fm = gid * WGM, gsz = (nM - fm) < WGM ? (nM - fm) : WGM;
        u.pm = fm + ((wgid % nig) % gsz); u.pn = (wgid % nig) / gsz; return true;
    }
    __device__ __forceinline__ void a_ready(const Unit&) const {}
    __device__ __forceinline__ void done(const Unit&) const {}
};

__device__ __forceinline__ unsigned cvt_pk_bf16(float lo, float hi) { unsigned r; asm volatile("v_cvt_pk_bf16_f32 %0, %1, %2" : "=v"(r) : "v"(lo), "v"(hi)); return r; }
typedef float f32x2 __attribute__((ext_vector_type(2)));
__device__ __forceinline__ f32x2 gelu_pk(f32x2 v) {
    const f32x2 av = __builtin_elementwise_abs(v), d = av * 0.2316418882f + 1.0f;
    f32x2 t; t.x = __builtin_amdgcn_rcpf(d.x); t.y = __builtin_amdgcn_rcpf(d.y);
    f32x2 q = t * 0.5307027145f + (-0.7265760135f); q = q * t + 0.7107068705f; q = q * t + (-0.142248368f); q = q * t + 0.127414796f; q = q * t;
    const f32x2 s = (v * v) * (-0.72134752044f);
    f32x2 e; e.x = __builtin_amdgcn_exp2f(s.x); e.y = __builtin_amdgcn_exp2f(s.y);
    const f32x2 m = v * (q * e), r = v - m;
    f32x2 o; o.x = v.x < 0.f ? m.x : r.x; o.y = v.y < 0.f ? m.y : r.y; return o;
}

template <class Epi, class Sched, bool ALIGN_EPI = false, bool SP2 = false>
__device__ __forceinline__ void gemm_phase(PG8_LAS unsigned char* lds, const Gemm g, const Sched& S, const Epi& E) {
    int tid_o = threadIdx.x; asm volatile("" : "+v"(tid_o));
    const int tid = tid_o, wid = __builtin_amdgcn_readfirstlane(tid >> 6), lane = tid & 63, wr = wid >> 2, wc = wid & 3, fr = lane & 15, fq = lane >> 4;
    const int K = g.K, nt = K / BK;
    unsigned voffA[2], voffB[2];
#pragma unroll
    for (int i = 0; i < 2; ++i) { int R, C; stage_rc(tid * 16 + i * 8192, R, C); const int Rb = Epi::PERM ? ((R & ~31) + perm32(R & 31)) : R;
        voffA[i] = (unsigned)(R * K + C) * 2u; voffB[i] = (unsigned)(Rb * K + C) * 2u; }
    const unsigned kstep = (unsigned)(BK * 2);
    const unsigned hstep = (unsigned)HALF * (unsigned)K * 2u;
    const unsigned tstep = 2u * hstep;
    const unsigned ldsw = (unsigned)wid * 1024u;
    const int aoff = lds_byte(wr * 64 + fr, fq * 8), boff = lds_byte(wc * 32 + fr, fq * 8);
#define PG8_SA(b, h) (((b) * 2 + (h)) * HTB)
#define PG8_SB(b, h) ((4 + (b) * 2 + (h)) * HTB)
    const __amdgpu_buffer_rsrc_t rs_voffA = __builtin_amdgcn_make_buffer_rsrc((void*)g.A, (short)0, -1, 0x00020000);
    const __amdgpu_buffer_rsrc_t rs_voffB = __builtin_amdgcn_make_buffer_rsrc((void*)g.Bt, (short)0, -1, 0x00020000);
#define PG8_STAGE(bufoff, gbase, voff) do { _Pragma("unroll") for (int _i = 0; _i < 2; ++_i) \
        __builtin_amdgcn_raw_ptr_buffer_load_lds(rs_##voff, (PG8_LAS void*)(lds + (bufoff) + ldsw + _i * 8192), 16, (int)(voff)[_i], (int)(gbase), 0, 0); } while (0)
#define PG8_LDA(dst, b, h) do { _Pragma("unroll") for (int m = 0; m < 4; ++m) _Pragma("unroll") for (int k = 0; k < 2; ++k) dst[m][k] = *(const PG8_LAS bf16x8*)(lds + PG8_SA(b, h) + aoff + m * 2048 + k * 1024); } while (0)
#define PG8_LDB(dst, b, h) do { _Pragma("unroll") for (int n = 0; n < 2; ++n) _Pragma("unroll") for (int k = 0; k < 2; ++k) dst[n][k] = *(const PG8_LAS bf16x8*)(lds + PG8_SB(b, h) + boff + n * 2048 + k * 1024); } while (0)
#define PG8_MMA(ai, bj, At, Bt) do { __builtin_amdgcn_s_setprio(1); _Pragma("unroll") for (int m = 0; m < 4; ++m) _Pragma("unroll") for (int n = 0; n < 2; ++n) _Pragma("unroll") for (int k = 0; k < 2; ++k) \
        acc[ai][bj][m][n] = __builtin_amdgcn_mfma_f32_16x16x32_bf16(Bt[n][k], At[m][k], acc[ai][bj][m][n], 0, 0, 0); __builtin_amdgcn_s_setprio(0); } while (0)
#define PG8_WAIT_V(n) asm volatile("s_waitcnt vmcnt(" #n ")" ::: "memory")
#define PG8_WAIT_L(n) asm volatile("s_waitcnt lgkmcnt(" #n ")" ::: "memory")
#define PG8_BAR __builtin_amdgcn_s_barrier()
#define PG8_SCHED __builtin_amdgcn_sched_barrier(0)
    Unit cur, nxt; int ui = 0;
    if (!S.next(0, cur)) return;
    f32x4 acc[2][2][4][2];
#pragma unroll
    for (int a = 0; a < 2; ++a)
#pragma unroll
        for (int b = 0; b < 2; ++b)
#pragma unroll
            for (int m = 0; m < 4; ++m)
#pragma unroll
                for (int n = 0; n < 2; ++n) acc[a][b][m][n] = (f32x4){0.f, 0.f, 0.f, 0.f};
    bf16x8 At[4][2], B0[2][2], B1[2][2];
    unsigned cA = (unsigned)cur.pm * tstep, cB = (unsigned)cur.pn * tstep;
    S.a_ready(cur);
    if constexpr (SP2) {
        PG8_STAGE(PG8_SB(0, 0), cB, voffB); PG8_STAGE(PG8_SB(0, 1), cB + hstep, voffB); PG8_STAGE(PG8_SA(0, 0), cA, voffA); PG8_STAGE(PG8_SA(0, 1), cA + hstep, voffA);
        if (wr == 1) PG8_BAR;
        PG8_WAIT_V(2); PG8_BAR;
        PG8_STAGE(PG8_SB(1, 0), cB + kstep, voffB); PG8_STAGE(PG8_SA(1, 0), cA + kstep, voffA); PG8_STAGE(PG8_SB(1, 1), cB + hstep + kstep, voffB);
        PG8_WAIT_V(6); PG8_BAR;
    } else {
        PG8_STAGE(PG8_SB(0, 0), cB, voffB); PG8_STAGE(PG8_SA(0, 0), cA, voffA); PG8_STAGE(PG8_SB(0, 1), cB + hstep, voffB); PG8_STAGE(PG8_SA(0, 1), cA + hstep, voffA);
        if (wr == 1) PG8_BAR;
        PG8_WAIT_V(4); PG8_BAR;
        PG8_STAGE(PG8_SB(1, 0), cB + kstep, voffB); PG8_STAGE(PG8_SA(1, 0), cA + kstep, voffA); PG8_STAGE(PG8_SB(1, 1), cB + hstep + kstep, voffB);
        PG8_WAIT_V(6); PG8_BAR;
    }
    for (;;) {
        const bool has_next = S.next(ui + 1, nxt);
        const unsigned nA = has_next ? (unsigned)nxt.pm * tstep : cA, nB = has_next ? (unsigned)nxt.pn * tstep : cB;
        for (int t = 0; t < nt; t += 2) {
            const bool last = (t == nt - 2);
            const unsigned a1 = cA + (unsigned)(t + 1) * kstep;
            const unsigned a2 = last ? nA : cA + (unsigned)(t + 2) * kstep, b2 = last ? nB : cB + (unsigned)(t + 2) * kstep;
            const unsigned a3 = a2 + kstep, b3 = b2 + kstep;
            if (last && has_next) S.a_ready(nxt);
            if constexpr (SP2) {
            PG8_LDB(B0, 0, 0); PG8_LDB(B1, 0, 1); PG8_SCHED; PG8_LDA(At, 0, 0); PG8_STAGE(PG8_SA(1, 1), a1 + hstep, voffA);
            PG8_WAIT_V(8); PG8_WAIT_L(0); PG8_BAR; PG8_MMA(0, 0, At, B0); PG8_MMA(0, 1, At, B1); PG8_BAR; PG8_SCHED;
            PG8_LDA(At, 0, 1); PG8_STAGE(PG8_SB(0, 0), b2, voffB); PG8_STAGE(PG8_SB(0, 1), b2 + hstep, voffB); PG8_STAGE(PG8_SA(0, 0), a2, voffA);
            PG8_WAIT_V(8); PG8_WAIT_L(0); PG8_BAR; PG8_MMA(1, 0, At, B0); PG8_MMA(1, 1, At, B1); PG8_BAR; PG8_SCHED;
            PG8_LDB(B0, 1, 0); PG8_LDB(B1, 1, 1); PG8_SCHED; PG8_LDA(At, 1, 0); PG8_STAGE(PG8_SA(0, 1), a2 + hstep, voffA);
            PG8_WAIT_V(8); PG8_WAIT_L(0); PG8_BAR; PG8_MMA(0, 0, At, B0); PG8_MMA(0, 1, At, B1); PG8_BAR; PG8_SCHED;
            PG8_LDA(At, 1, 1); PG8_STAGE(PG8_SB(1, 0), b3, voffB); PG8_STAGE(PG8_SB(1, 1), b3 + hstep, voffB); PG8_STAGE(PG8_SA(1, 0), a3, voffA);
            PG8_WAIT_V(8); PG8_WAIT_L(0); PG8_BAR; PG8_MMA(1, 0, At, B0); PG8_MMA(1, 1, At, B1); PG8_BAR; PG8_SCHED;
            } else {
            PG8_LDB(B0, 0, 0); PG8_SCHED; PG8_LDA(At, 0, 0); PG8_STAGE(PG8_SA(1, 1), a1 + hstep, voffA);
            PG8_WAIT_L(8); PG8_BAR; PG8_WAIT_L(0); PG8_MMA(0, 0, At, B0); PG8_BAR; PG8_SCHED;
            PG8_LDB(B1, 0, 1); PG8_STAGE(PG8_SB(0, 0), b2, voffB);
            PG8_BAR; PG8_WAIT_L(0); PG8_MMA(0, 1, At, B1); PG8_BAR;
            PG8_LDA(At, 0, 1); PG8_STAGE(PG8_SA(0, 0), a2, voffA);
            PG8_BAR; PG8_WAIT_L(0); PG8_MMA(1, 0, At, B0); PG8_BAR; PG8_SCHED;
            PG8_STAGE(PG8_SB(0, 1), b2 + hstep, voffB);
            PG8_WAIT_V(6); PG8_BAR; PG8_MMA(1, 1, At, B1); PG8_BAR;
            PG8_LDB(B0, 1, 0); PG8_SCHED; PG8_LDA(At, 1, 0); PG8_STAGE(PG8_SA(0, 1), a2 + hstep, voffA);
            PG8_WAIT_L(8); PG8_BAR; PG8_WAIT_L(0); PG8_MMA(0, 0, At, B0); PG8_BAR; PG8_SCHED;
            PG8_LDB(B1, 1, 1); PG8_STAGE(PG8_SB(1, 0), b3, voffB);
            PG8_BAR; PG8_WAIT_L(0); PG8_MMA(0, 1, At, B1); PG8_BAR;
            PG8_LDA(At, 1, 1); PG8_STAGE(PG8_SA(1, 0), a3, voffA);
            PG8_BAR; PG8_WAIT_L(0); PG8_MMA(1, 0, At, B0); PG8_BAR; PG8_SCHED;
            PG8_STAGE(PG8_SB(1, 1), b3 + hstep, voffB);
            PG8_WAIT_V(6); PG8_BAR; PG8_MMA(1, 1, At, B1); PG8_BAR;
            }
        }
        if constexpr (ALIGN_EPI) { if (wr == 0) PG8_BAR; }
        if constexpr (!Epi::AFTER_DRAIN) { E(acc, cur, wr, wc, fr, fq); S.done(cur); }
        if (!has_next) break;
#pragma unroll
        for (int a = 0; a < 2; ++a)
#pragma unroll
            for (int b = 0; b < 2; ++b)
#pragma unroll
                for (int m = 0; m < 4; ++m)
#pragma unroll
                    for (int n = 0; n < 2; ++n) acc[a][b][m][n] = (f32x4){0.f, 0.f, 0.f, 0.f};
        cur = nxt; cA = nA; cB = nB; ++ui;
        if constexpr (ALIGN_EPI) { if (wr == 1) PG8_BAR; }
    }
    PG8_WAIT_V(0);
    if constexpr (!ALIGN_EPI) { if (wr == 0) PG8_BAR; }
    PG8_BAR;
    if constexpr (Epi::AFTER_DRAIN) { E.fused(acc, cur, wr, wc, fr, fq, lds, wid, lane); S.done(cur); }
#undef PG8_SA
#undef PG8_SB
#undef PG8_STAGE
#undef PG8_LDA
#undef PG8_LDB
#undef PG8_MMA
#undef PG8_WAIT_V
#undef PG8_WAIT_L
#undef PG8_BAR
#undef PG8_SCHED
}
}
namespace pg8 {
#define PG8_GAS __attribute__((address_space(1)))
constexpr float RMS_EPS = 1e-6f;
typedef unsigned long long stat_t;
typedef unsigned long long u64x2 __attribute__((ext_vector_type(2)));
constexpr float STAT_SCALE = 1048576.0f;
__device__ __forceinline__ stat_t stat_fix(float ss) { return (stat_t)(ss * STAT_SCALE + 0.5f); }
__device__ __forceinline__ float msq_from(stat_t q) { const float lo = (float)(unsigned)q * (1.0f / (2048.0f * STAT_SCALE)) + RMS_EPS; return (float)(unsigned)(q >> 32) * (4294967296.0f / (2048.0f * STAT_SCALE)) + lo; }
__device__ __forceinline__ float rinv_from(stat_t q) { return __builtin_amdgcn_rsqf(msq_from(q)); }
__device__ __forceinline__ float rinv_of(const stat_t* st, int row) { return rinv_from(st[row]); }
__device__ __forceinline__ float fast_sigmoid(float v) { return __builtin_amdgcn_rcpf(1.0f + __expf(-v)); }
__device__ __forceinline__ float gelu_tanh(float v) { const float y = 1.5957691216f * (v + 0.044715f * v * v * v); return v * fast_sigmoid(y); }
__device__ __forceinline__ u32x4 pack8(const f32x4 a, const f32x4 b) { u32x4 w; w.x = cvt_pk_bf16(a[0], a[1]); w.y = cvt_pk_bf16(a[2], a[3]); w.z = cvt_pk_bf16(b[0], b[1]); w.w = cvt_pk_bf16(b[2], b[3]); return w; }
__device__ __forceinline__ void unpack8(const u32x4 w, f32x4& a, f32x4& b) {
    a[0] = __uint_as_float(w.x << 16); a[1] = __uint_as_float(w.x & 0xffff0000u); a[2] = __uint_as_float(w.y << 16); a[3] = __uint_as_float(w.y & 0xffff0000u);
    b[0] = __uint_as_float(w.z << 16); b[1] = __uint_as_float(w.z & 0xffff0000u); b[2] = __uint_as_float(w.w << 16); b[3] = __uint_as_float(w.w & 0xffff0000u); }
__device__ __forceinline__ float sumsq8(const f32x4 a, const f32x4 b) { return (a[0] * a[0] + a[1] * a[1]) + (a[2] * a[2] + a[3] * a[3]) + (b[0] * b[0] + b[1] * b[1]) + (b[2] * b[2] + b[3] * b[3]); }

struct EpiSwiGLU {
    static constexpr bool PERM = true, AFTER_DRAIN = false;
    bf16_t* H; int ldh; const stat_t* st;
    __device__ __forceinline__ void operator()(const f32x4 (&acc)[2][2][4][2], const Unit& u, int wr, int wc, int fr, int fq) const {
        const int rowu = u.pm * BM + wr * 64; const unsigned lo = (unsigned)(fr * ldh + 8 * fq);
        stat_t q[8];
#pragma unroll
        for (int g = 0; g < 8; ++g) q[g] = ((const PG8_GAS stat_t*)(st + rowu + (g >> 2) * HALF + (g & 3) * 16))[fr];
        asm volatile("" ::: "memory");
#pragma unroll
        for (int ai = 0; ai < 2; ++ai)
#pragma unroll
            for (int m = 0; m < 4; ++m) { const int ru = rowu + ai * HALF + m * 16;
                const float v = msq_from(q[ai * 4 + m]), sn = __builtin_amdgcn_rsqf(v) * -1.4426950408889634f;
                f32x4 h[2];
#pragma unroll
                for (int n = 0; n < 2; ++n) { const f32x4 g = acc[ai][0][m][n], up = acc[ai][1][m][n];
#pragma unroll
                    for (int p = 0; p < 2; ++p) { const f32x2 g2 = (f32x2){g[2 * p], g[2 * p + 1]}, u2 = (f32x2){up[2 * p], up[2 * p + 1]}; const f32x2 a2 = g2 * sn;
                        f32x2 e2; e2.x = __builtin_amdgcn_exp2f(a2.x); e2.y = __builtin_amdgcn_exp2f(a2.y);
                        const f32x2 d2 = e2 * v + v; f32x2 r2; r2.x = __builtin_amdgcn_rcpf(d2.x); r2.y = __builtin_amdgcn_rcpf(d2.y);
                        const f32x2 h2 = (g2 * u2) * r2; h[n][2 * p] = h2.x; h[n][2 * p + 1] = h2.y; } }
                bf16_t* hp = H + (size_t)ru * ldh + u.pn * HALF + wc * 32;
                *(PG8_GAS u32x4*)(hp + lo) = pack8(h[0], h[1]); }
    }
};
template <int MODE> struct EpiRmw {
    static constexpr bool PERM = true, AFTER_DRAIN = false;
    const bf16_t* XB; bf16_t* XN; const stat_t* st; stat_t* stn; float alpha;
    __device__ __forceinline__ void operator()(const f32x4 (&acc)[2][2][4][2], const Unit& u, int wr, int wc, int fr, int fq) const {
        const int rowu = u.pm * BM + wr * 64, colu = u.pn * BM + wc * 32; const unsigned lo = (unsigned)(fr * 2048 + 8 * fq);
        const bf16_t* const xbase = XB + (size_t)rowu * 2048 + colu; bf16_t* const nbase = XN + (size_t)rowu * 2048 + colu;
        u32x4 xv[2][2][2], pv[2][2][2];
        stat_t rq[2][2];
        float ss[8];
#define RMW_LOAD(k, b) do { _Pragma("unroll") for (int q = 0; q < 2; ++q) { const int g = 2 * (k) + q, ro = ((g >> 2) * HALF + (g & 3) * 16) * 2048; \
            if (MODE == 1) rq[b][q] = ((const PG8_GAS stat_t*)(st + rowu + (g >> 2) * HALF + (g & 3) * 16))[fr]; \
            _Pragma("unroll") for (int bj = 0; bj < 2; ++bj) { xv[b][q][bj] = *(const PG8_GAS u32x4*)(xbase + ro + lo + bj * HALF); \
                if (MODE == 1) pv[b][q][bj] = *(const PG8_GAS u32x4*)(nbase + ro + lo + bj * HALF); } } } while (0)
        RMW_LOAD(0, 0);
        asm volatile("" ::: "memory");
#pragma unroll
        for (int k = 0; k < 4; ++k) { const int b = k & 1; u32x4 ov[2][2];
#pragma unroll
            for (int q = 0; q < 2; ++q) { const int g = 2 * k + q, ai = g >> 2, m = g & 3; float s2 = 0.f; const float rsg = (MODE == 1) ? rinv_from(rq[b][q]) : 0.f;
#pragma unroll
                for (int bj = 0; bj < 2; ++bj) { f32x4 x0, x1; unpack8(xv[b][q][bj], x0, x1);
                    if (MODE == 0) { x0 += acc[ai][bj][m][0] * alpha; x1 += acc[ai][bj][m][1] * alpha; }
                    else { f32x4 p0, p1; unpack8(pv[b][q][bj], p0, p1);
#pragma unroll
                        for (int j = 0; j < 4; ++j) { x0[j] += alpha * fast_sigmoid(acc[ai][bj][m][0][j] * rsg) * p0[j]; x1[j] += alpha * fast_sigmoid(acc[ai][bj][m][1][j] * rsg) * p1[j]; } }
                    s2 += sumsq8(x0, x1); ov[q][bj] = pack8(x0, x1); }
                s2 += __shfl_xor(s2, 16); s2 += __shfl_xor(s2, 32); ss[g] = s2; }
            if (k < 3) { RMW_LOAD(k + 1, b ^ 1); }
            asm volatile("" ::: "memory");
#pragma unroll
            for (int q = 0; q < 2; ++q) { const int g = 2 * k + q, ro = ((g >> 2) * HALF + (g & 3) * 16) * 2048;
#pragma unroll
                for (int bj = 0; bj < 2; ++bj) if (MODE == 0 || alpha != 0.f) *(PG8_GAS u32x4*)(nbase + ro + lo + bj * HALF) = ov[q][bj]; }
            asm volatile("" ::: "memory");
        }
#undef RMW_LOAD
        if (fq == 0) {
#pragma unroll
            for (int g = 0; g < 8; ++g) __hip_atomic_fetch_add((PG8_GAS stat_t*)(stn + rowu + (g >> 2) * HALF + (g & 3) * 16 + fr), stat_fix(ss[g]), __ATOMIC_RELAXED, __HIP_MEMORY_SCOPE_AGENT);
        }
    }
};
template <int MODE> struct EpiRowBf16 {
    static constexpr bool PERM = true, AFTER_DRAIN = false;
    bf16_t* O; int ldc; const stat_t* st;
    __device__ __forceinline__ void operator()(const f32x4 (&acc)[2][2][4][2], const Unit& u, int wr, int wc, int fr, int fq) const {
        const int rowu = u.pm * BM + wr * 64, colu = u.pn * BM + wc * 32; const unsigned lo = (unsigned)(fr * ldc + 8 * fq);
        stat_t q[8];
        if (MODE == 1) {
#pragma unroll
            for (int g = 0; g < 8; ++g) q[g] = ((const PG8_GAS stat_t*)(st + rowu + (g >> 2) * HALF + (g & 3) * 16))[fr];
            asm volatile("" ::: "memory"); }
#pragma unroll
        for (int ai = 0; ai < 2; ++ai)
#pragma unroll
            for (int m = 0; m < 4; ++m) { const int ru = rowu + ai * HALF + m * 16; float s = 1.0f; if (MODE == 1) s = rinv_from(q[ai * 4 + m]);
                bf16_t* op = O + (size_t)ru * ldc + colu;
#pragma unroll
                for (int bj = 0; bj < 2; ++bj) { f32x4 v0 = acc[ai][bj][m][0] * s, v1 = acc[ai][bj][m][1] * s;
                    if (MODE == 1) {
#pragma unroll
                        for (int j = 0; j < 4; ++j) { v0[j] = gelu_tanh(v0[j]); v1[j] = gelu_tanh(v1[j]); } }
                    *(PG8_GAS u32x4*)(op + lo + bj * HALF) = pack8(v0, v1); } }
    }
};
struct EpiOddIn {
    static constexpr bool PERM = true, AFTER_DRAIN = false;
    bf16_t* Z; bf16_t* GB; const stat_t* st;
    __device__ __forceinline__ void operator()(const f32x4 (&acc)[2][2][4][2], const Unit& u, int wr, int wc, int fr, int fq) const {
        const int rowu = u.pm * BM + wr * 64; const unsigned lo = (unsigned)(fr * 2048 + 8 * fq);
        stat_t q[8];
#pragma unroll
        for (int g = 0; g < 8; ++g) q[g] = ((const PG8_GAS stat_t*)(st + rowu + (g >> 2) * HALF + (g & 3) * 16))[fr];
        asm volatile("" ::: "memory");
        if (u.pn < 16) { const int colu = u.pn * HALF + wc * 32;
#pragma unroll
            for (int ai = 0; ai < 2; ++ai)
#pragma unroll
                for (int m = 0; m < 4; ++m) { const int ru = rowu + ai * HALF + m * 16; const float s = rinv_from(q[ai * 4 + m]), s2 = s * s;
                    const f32x4 z0 = acc[ai][0][m][0] * acc[ai][1][m][0] * s2, z1 = acc[ai][0][m][1] * acc[ai][1][m][1] * s2;
                    bf16_t* zp = Z + (size_t)ru * 2048 + colu;
                    *(PG8_GAS u32x4*)(zp + lo) = pack8(z0, z1); }
        } else { const int colu = (u.pn - 16) * BM + wc * 32;
#pragma unroll
            for (int ai = 0; ai < 2; ++ai)
#pragma unroll
                for (int m = 0; m < 4; ++m) { const int ru = rowu + ai * HALF + m * 16; const float s = rinv_from(q[ai * 4 + m]);
                    bf16_t* gp = GB + (size_t)ru * 2048 + colu;
#pragma unroll
                    for (int bj = 0; bj < 2; ++bj) *(PG8_GAS u32x4*)(gp + lo + bj * HALF) = pack8(acc[ai][bj][m][0] * s, acc[ai][bj][m][1] * s); }
        }
    }
};
struct EpiMT {
    static constexpr bool PERM = true, AFTER_DRAIN = false;
    bf16_t* ZTP; bf16_t* ZTS; bf16_t* VT; const stat_t* st; const float* gv;
    __device__ __forceinline__ void operator()(const f32x4 (&acc)[2][2][4][2], const Unit& u, int wr, int wc, int fr, int fq) const {
        const int tu = u.pn * BM + wc * 32;
        f32x4 sc[2][2];
#pragma unroll
        for (int bj = 0; bj < 2; ++bj)
#pragma unroll
            for (int n = 0; n < 2; ++n) { const stat_t* sp = (st + tu + bj * HALF + 4 * n) + 8 * fq; const u64x2 a = *(const PG8_GAS u64x2*)sp, b = *(const PG8_GAS u64x2*)(sp + 2);
                sc[bj][n][0] = rinv_from(a[0]); sc[bj][n][1] = rinv_from(a[1]); sc[bj][n][2] = rinv_from(b[0]); sc[bj][n][3] = rinv_from(b[1]); }
        const int chu = u.pm * BM + wr * 64;
        if (u.pm < 4) {
            bf16_t* base; int S2;
            if (u.pn < 128) { const int tt = u.pn * BM; base = ZTP + (size_t)(tt >> 11) * (1024 * 2048) + (tt & 2047) + wc * 32; S2 = 2048; }
            else { base = ZTS + (u.pn - 128) * BM + wc * 32; S2 = 8192; }
            const unsigned lo = (unsigned)(fr * S2 + 8 * fq);
#pragma unroll
            for (int ai = 0; ai < 2; ++ai)
#pragma unroll
                for (int m = 0; m < 4; ++m) { bf16_t* rp = base + (size_t)(chu + ai * HALF + m * 16) * S2;
#pragma unroll
                    for (int bj = 0; bj < 2; ++bj) *(PG8_GAS u32x4*)(rp + lo + bj * HALF) = pack8(acc[ai][bj][m][0] * sc[bj][0], acc[ai][bj][m][1] * sc[bj][1]); }
        } else {
            const unsigned lo = (unsigned)(fr * 40960 + 8 * fq);
#pragma unroll
            for (int ai = 0; ai < 2; ++ai) {
                f32x4 q[2][2];
#pragma unroll
                for (int bj = 0; bj < 2; ++bj)
#pragma unroll
                    for (int n = 0; n < 2; ++n) { q[bj][n] = (f32x4){0.f, 0.f, 0.f, 0.f};
#pragma unroll
                        for (int m = 0; m < 4; ++m) { const f32x4 v = acc[ai][bj][m][n] * sc[bj][n];
#pragma unroll
                            for (int j = 0; j < 4; ++j) { const float y = gelu_tanh(v[j]); q[bj][n][j] += y * y; } } }
#pragma unroll
                for (int bj = 0; bj < 2; ++bj)
#pragma unroll
                    for (int n = 0; n < 2; ++n)
#pragma unroll
                        for (int j = 0; j < 4; ++j) { float s = q[bj][n][j]; s += __shfl_xor(s, 1); s += __shfl_xor(s, 2); s += __shfl_xor(s, 4); s += __shfl_xor(s, 8);
                            q[bj][n][j] = __builtin_amdgcn_rsqf(s * (1.0f / 64.0f) + RMS_EPS); }
#pragma unroll
                for (int m = 0; m < 4; ++m) { const int cu = chu - 1024 + ai * HALF + m * 16; const float gg = ((const PG8_GAS float*)(gv + cu))[fr]; bf16_t* vp = VT + (size_t)cu * 40960 + tu;
#pragma unroll
                    for (int bj = 0; bj < 2; ++bj) { f32x4 y0 = acc[ai][bj][m][0] * sc[bj][0], y1 = acc[ai][bj][m][1] * sc[bj][1];
#pragma unroll
                        for (int j = 0; j < 4; ++j) { y0[j] = gelu_tanh(y0[j]); y1[j] = gelu_tanh(y1[j]); }
                        *(PG8_GAS u32x4*)(vp + lo + bj * HALF) = pack8(y0 * q[bj][0] * gg, y1 * q[bj][1] * gg); } }
            }
        }
    }
};
struct EpiDFT {
    static constexpr bool PERM = true, AFTER_DRAIN = false;
    bf16_t* Y; int row_base, S; float scale, msign; int col_lo, col_hi;
    __device__ __forceinline__ void operator()(const f32x4 (&acc)[2][2][4][2], const Unit& u, int wr, int wc, int fr, int fq) const {
        const int ku = u.pm * BM + wr * 64, rb = row_base + (u.pn >> 2) * S, colu = (u.pn & 3) * BM + wc * 32;
        const int lo = fr * 2048 + 8 * fq, lom = -fr * 2048 + 8 * fq; const float ms = scale * msign;
#pragma unroll
        for (int bj = 0; bj < 2; ++bj) { const int col = colu + bj * HALF + 8 * fq; if (col >= col_lo && col < col_hi) {
#pragma unroll
            for (int ai = 0; ai < 2; ++ai)
#pragma unroll
                for (int m = 0; m < 4; ++m) { const int k0 = ku + ai * HALF + m * 16;
                    bf16_t* yp = Y + (size_t)(rb + k0) * 2048 + colu + bj * HALF; bf16_t* ym = Y + (size_t)(rb + S - k0) * 2048 + colu + bj * HALF;
                    *(PG8_GAS u32x4*)(yp + lo) = pack8(acc[ai][bj][m][0] * scale, acc[ai][bj][m][1] * scale);
                    if (k0 + fr != 0) *(PG8_GAS u32x4*)(ym + lom) = pack8(acc[ai][bj][m][0] * ms, acc[ai][bj][m][1] * ms); } } }
    }
};
struct EpiNull {
    static constexpr bool PERM = true, AFTER_DRAIN = false;
    float* sink;
    __device__ __forceinline__ void operator()(const f32x4 (&acc)[2][2][4][2], const Unit& u, int wr, int wc, int fr, int fq) const {
        float s = 0.f;
#pragma unroll
        for (int ai = 0; ai < 2; ++ai)
#pragma unroll
            for (int bj = 0; bj < 2; ++bj)
#pragma unroll
                for (int m = 0; m < 4; ++m)
#pragma unroll
                    for (int n = 0; n < 2; ++n) s += acc[ai][bj][m][n][0] + acc[ai][bj][m][n][1] + acc[ai][bj][m][n][2] + acc[ai][bj][m][n][3];
        if (s == 1.2345e-30f) sink[u.pm + fr] = s;
    }
};
}
#ifndef MK_N_LAUNCHES
#define MK_N_LAUNCHES 1
#endif
constexpr int NPHASE = 34;
constexpr int T = 40960, TP = 32768, DM = 2048, DFF = 5632, NLAYER = 4;
typedef unsigned short bf16;
#define GAS __attribute__((address_space(1)))
#define LAS __attribute__((address_space(3)))
typedef unsigned v4u __attribute__((ext_vector_type(4)));
typedef unsigned v2u __attribute__((ext_vector_type(2)));
typedef float f32x4 __attribute__((ext_vector_type(4)));
typedef short bf16x8 __attribute__((ext_vector_type(8)));
typedef GAS unsigned gu32;

constexpr size_t MiB = 1u << 20;
constexpr size_t WS_CTL = 0, CTL_BYTES = 6 * MiB;
constexpr int CW_BAR = 4096;
constexpr size_t WS_STATS = 65536;
constexpr size_t WS_W = 6 * MiB;
constexpr size_t SZ_FIN = (size_t)2 * DFF * DM * 2, SZ_FOUT = (size_t)DM * DFF * 2, SZ_SQ = (size_t)DM * DM * 2, SZ_WP = (size_t)DM * 256 * 2;
constexpr size_t WL_F1IN = 0, WL_F1OUT = SZ_FIN, WL_F2IN = SZ_FIN + SZ_FOUT, WL_F2OUT = 2 * SZ_FIN + SZ_FOUT, WL_WG = 2 * SZ_FIN + 2 * SZ_FOUT, WL_WP = WL_WG + SZ_SQ, WL_SIZE = WL_WP + SZ_WP;
constexpr size_t WS_WE = WS_W + NLAYER * WL_SIZE;
constexpr size_t WE_WZ = 0, WE_WU = (size_t)3072 * DM * 2, WE_WO = WE_WU + (size_t)1024 * DM * 2, WE_WS = WE_WO + SZ_SQ, WE_SIZE = WE_WS + (size_t)16 * 128 * 128 * 2;
constexpr size_t WS_WOD = WS_WE + 2 * WE_SIZE;
constexpr size_t WO_WC = 0, WO_WOC = (size_t)6144 * DM * 2, WO_SIZE = WO_WOC + SZ_SQ;
constexpr size_t WS_DP = WS_WOD + 2 * WO_SIZE, SZ_DP = (size_t)2 * 1024 * 2048 * 2;
constexpr size_t WS_DS = WS_DP + SZ_DP, SZ_DS = (size_t)2 * 4096 * 8192 * 2;
constexpr size_t WS_XB0 = WS_DS + SZ_DS, SZ_XB = (size_t)T * DM * 2;
constexpr size_t WS_XB1 = WS_XB0 + SZ_XB;
constexpr size_t WS_H = WS_XB1 + SZ_XB, SZ_H = (size_t)T * DFF * 2;
constexpr size_t WS_ZTP = WS_H, WS_ZTS = WS_ZTP + (size_t)16 * 1024 * 2048 * 2, WS_VT = WS_ZTS + (size_t)1024 * 8192 * 2, WS_U = WS_VT + (size_t)1024 * T * 2;
constexpr size_t WS_Z = WS_H, WS_GB = WS_H + SZ_XB;
constexpr size_t WS_PB = WS_H + SZ_H, SZ_PB = (size_t)NLAYER * T * 256 * 2;
constexpr size_t WS_END = WS_PB + SZ_PB;
static_assert(WS_U + (size_t)T * 1024 * 2 <= WS_H + SZ_H && WS_GB + SZ_XB <= WS_H + SZ_H, "mixer buffers overlay the FFN hidden buffer");
static_assert(WS_STATS + (size_t)18 * T * 8 <= CTL_BYTES && (CW_BAR + 3456) * 4 <= (int)WS_STATS, "control region");
static_assert(WS_END < 1800000000ull, "d_ws map");

constexpr int LDS_BYTES = 147456;
constexpr int LDSCTL_OFF = 131072;

#define LDS_WAIT() asm volatile("s_waitcnt lgkmcnt(0)" ::: "memory")
__device__ __forceinline__ unsigned f2bf(float f) { unsigned u = __builtin_bit_cast(unsigned, f); return (u + 0x7fffu + ((u >> 16) & 1u)) >> 16; }
__device__ __forceinline__ unsigned pk2(float lo, float hi) { return f2bf(lo) | (f2bf(hi) << 16); }
__device__ __forceinline__ float bflo(unsigned w) { return __uint_as_float(w << 16); }
__device__ __forceinline__ float bfhi(unsigned w) { return __uint_as_float(w & 0xffff0000u); }
__device__ __forceinline__ float wave_sum(float v) {
#pragma unroll
    for (int o = 1; o < 64; o <<= 1) v += __shfl_xor(v, o);
    return v;
}
#define XB_TMO      128
#define XB_XCNT(j)  (256  + 64 * (j))
#define XB_XSUB(j)  (1280 + 64 * (j))
#define XB_XGEN(j)  (2304 + 64 * (j))
#define XB_TOP      3328
#define XB_TOPGEN   3392
#define XCD_BAR_WORDS 3456
#define XB_SPIN_CAP (1u << 18)

__device__ __forceinline__ unsigned xb_ld(unsigned* p)              { return __hip_atomic_load(p, __ATOMIC_RELAXED, __HIP_MEMORY_SCOPE_AGENT); }
__device__ __forceinline__ unsigned xb_add(unsigned* p, unsigned v) { return __hip_atomic_fetch_add(p, v, __ATOMIC_RELAXED, __HIP_MEMORY_SCOPE_AGENT); }
__device__ __forceinline__ unsigned xb_xcc_id() { return (unsigned)__builtin_amdgcn_s_getreg((3 << 11) | 20) & 0xFu; }
#define XB_SPIN(cond, bar) do { unsigned _sp = 0; while (cond) { __builtin_amdgcn_s_sleep(1); \
    if ((++_sp & 255u) == 0u) { if (xb_ld(&(bar)[XB_TMO])) break; if (_sp > XB_SPIN_CAP) { atomicAdd(&(bar)[XB_TMO], 1u); break; } } } } while (0)

struct XcdBarrier {
    unsigned* bar; unsigned x;
    volatile LAS unsigned* st;
};

__device__ __forceinline__ XcdBarrier xcd_barrier_post(unsigned* bar, volatile LAS unsigned* st) {
    XcdBarrier b; b.bar = bar; b.x = xb_xcc_id(); b.st = st;
    if (threadIdx.x == 0) (void)xb_add(&bar[XB_XCNT(b.x)], 1u);
    return b;
}
__device__ __forceinline__ void xcd_barrier_complete(unsigned* bar, unsigned x, unsigned& nloc, unsigned& nx) {
    const unsigned G = gridDim.x * gridDim.y * gridDim.z;
    unsigned sum, cnt, mine, sp = 0u;
    for (;;) {
        sum = 0u; cnt = 0u; mine = 0u;
#pragma unroll
        for (unsigned j = 0; j < 16; ++j) { const unsigned c = xb_ld(&bar[XB_XCNT(j)]); sum += c; cnt += (c > 0u) ? 1u : 0u; mine = (j == x) ? c : mine; }
        if (sum == G) break;
        __builtin_amdgcn_s_sleep(1);
        if ((++sp & 255u) == 0u) { if (xb_ld(&bar[XB_TMO])) break; if (sp > XB_SPIN_CAP) { atomicAdd(&bar[XB_TMO], 1u); break; } }
    }
    nloc = mine > 0u ? mine : 1u; nx = cnt > 0u ? cnt : 1u;
}

__device__ __forceinline__ void xcd_barrier(const XcdBarrier& b) {
    asm volatile("s_waitcnt vmcnt(0)" ::: "memory");
    __syncthreads();
    if (threadIdx.x == 0) {
        unsigned* bar = b.bar;
        __builtin_amdgcn_s_waitcnt(0);
        unsigned nloc = b.st[0], nx = b.st[1];
        if (nloc == 0u) { xcd_barrier_complete(bar, b.x, nloc, nx); b.st[0] = nloc; b.st[1] = nx; }
        const unsigned old = xb_add(&bar[XB_XSUB(b.x)], 1u);
        const unsigned gen = old / nloc;
        if (old + 1u == (gen + 1u) * nloc) {
            __builtin_amdgcn_fence(__ATOMIC_RELEASE, "agent");
            asm volatile("s_waitcnt vmcnt(0)" ::: "memory");
            const unsigned og = xb_add(&bar[XB_TOP], 1u);
            const unsigned tg = og / nx;
            if (og + 1u == (tg + 1u) * nx) xb_add(&bar[XB_TOPGEN], 1u);
            else XB_SPIN(xb_ld(&bar[XB_TOPGEN]) == tg, bar);
            __builtin_amdgcn_fence(__ATOMIC_ACQUIRE, "agent");
            xb_add(&bar[XB_XGEN(b.x)], 1u);
            asm volatile("s_waitcnt vmcnt(0)" ::: "memory");
        } else {
            XB_SPIN(xb_ld(&bar[XB_XGEN(b.x)]) == gen, bar);
            __builtin_amdgcn_fence(__ATOMIC_ACQUIRE, "agent");
            asm volatile("s_waitcnt vmcnt(0)" ::: "memory");
        }
    }
    __syncthreads();
}
__device__ __forceinline__ void tr_item(const float* W, int ldw, int K, const float* g, bf16* WT, int dst_row0, LAS float* scr, int k0, int n0, int lane) {
    {
        f32x4 v[8]; const int kr = lane >> 3, n4 = (lane & 7) * 4;
#pragma unroll
        for (int i = 0; i < 8; ++i) v[i] = *(const f32x4*)(W + (size_t)(k0 + 8 * i + kr) * ldw + n0 + n4);
        if (g) {
#pragma unroll
            for (int i = 0; i < 8; ++i) v[i] = v[i] * g[k0 + 8 * i + kr]; }
#pragma unroll
        for (int i = 0; i < 8; ++i) { LAS float* d = scr + (8 * i + kr) * 33 + n4; d[0] = v[i][0]; d[1] = v[i][1]; d[2] = v[i][2]; d[3] = v[i][3]; }
    }
    LDS_WAIT(); asm volatile("" ::: "memory");
    const int c = lane & 7;
#pragma unroll
    for (int j = 0; j < 4; ++j) { const int n = (lane >> 3) + 8 * j; const LAS float* s = scr + (8 * c) * 33 + n;
        v4u o; o.x = pk2(s[0 * 33], s[1 * 33]); o.y = pk2(s[2 * 33], s[3 * 33]); o.z = pk2(s[4 * 33], s[5 * 33]); o.w = pk2(s[6 * 33], s[7 * 33]);
        *(GAS v4u*)(WT + (size_t)(dst_row0 + n) * K + k0 + 8 * c) = o; }
    LDS_WAIT(); asm volatile("" ::: "memory");
}
__device__ __forceinline__ void hc_rows(int kd, int& r1, int& r2, float& c2) {
    if (kd < 528) { const int h = kd / 33, cp = kd - 33 * h; r1 = 64 * h + cp; if (cp == 0 || cp == 32) { r2 = r1; c2 = 0.f; } else { r2 = 64 * h + 64 - cp; c2 = 1.f; } }
    else { const int q = kd - 528, h = q / 31, cp = 1 + q - 31 * h; r1 = 64 * h + 64 - cp; r2 = 64 * h + cp; c2 = -1.f; }
}
__device__ __forceinline__ void tr_item_wofold(const float* W, bf16* WT, LAS float* scr, int k0, int n0, int lane) {
    {   f32x4 v[8], w[8]; float cc[8]; const int kr = lane >> 3, n4 = (lane & 7) * 4;
#pragma unroll
        for (int i = 0; i < 8; ++i) { int r1, r2; hc_rows(k0 + 8 * i + kr, r1, r2, cc[i]); v[i] = *(const f32x4*)(W + (size_t)r1 * DM + n0 + n4); w[i] = *(const f32x4*)(W + (size_t)r2 * DM + n0 + n4); }
#pragma unroll
        for (int i = 0; i < 8; ++i) { const f32x4 t = v[i] + w[i] * cc[i]; LAS float* d = scr + (8 * i + kr) * 33 + n4; d[0] = t[0]; d[1] = t[1]; d[2] = t[2]; d[3] = t[3]; }
    }
    LDS_WAIT(); asm volatile("" ::: "memory");
    const int c = lane & 7;
#pragma unroll
    for (int j = 0; j < 4; ++j) { const int n = (lane >> 3) + 8 * j; const LAS float* s = scr + (8 * c) * 33 + n;
        v4u o; o.x = pk2(s[0 * 33], s[1 * 33]); o.y = pk2(s[2 * 33], s[3 * 33]); o.z = pk2(s[4 * 33], s[5 * 33]); o.w = pk2(s[6 * 33], s[7 * 33]);
        *(GAS v4u*)(WT + (size_t)(n0 + n) * DM + k0 + 8 * c) = o; }
    LDS_WAIT(); asm volatile("" ::: "memory");
}
__device__ __forceinline__ int map_id(int n) { return n; }
__device__ __forceinline__ int map_glu(int n) { return n < DFF ? 256 * (n >> 7) + (n & 127) : 256 * ((n - DFF) >> 7) + 128 + ((n - DFF) & 127); }
__device__ __forceinline__ int map_oddin(int n) { return n < 2048 ? 4096 + n : (n < 4096 ? 256 * ((n - 2048) >> 7) + ((n - 2048) & 127) : 256 * ((n - 4096) >> 7) + 128 + ((n - 4096) & 127)); }

struct Args { const float* in[24]; float* out; unsigned char* ws; int ph_lo, ph_hi; };

__device__ __forceinline__ void p0_prologue(const Args& a, LAS unsigned char* lds, int vcu, int G, int wave, int lane, int tid) {
    unsigned char* ws = a.ws;
    LAS float* scr = (LAS float*)(lds + wave * 16384);
    const int gw = vcu * 8 + wave, NGW = G * 8;
    constexpr int I_FIN = (DM / 64) * (2 * DFF / 32), I_FOUT = (DFF / 64) * (DM / 32), I_SQ = (DM / 64) * (DM / 32), I_WP = (256 / 64) * (DM / 32);
    constexpr int I_L = 2 * I_FIN + 2 * I_FOUT + I_SQ + I_WP;
    constexpr int I_EIN = (DM / 64) * (2048 / 32), I_E = I_EIN + I_SQ;
    constexpr int I_OIN = (DM / 64) * (6144 / 32), I_O = I_OIN + I_SQ;
    constexpr int NITEMS = NLAYER * I_L + 2 * I_E + 2 * I_O;
#define TR_JOB(CNT_, W_, LDW_, K_, NCOLS_, G_, WT_, MAP_) { if (r < (CNT_)) { const int nblk = (NCOLS_) / 32, kb = r / nblk, n0 = (r % nblk) * 32; tr_item(W_, LDW_, K_, G_, WT_, MAP_(n0), scr, kb * 64, n0, lane); continue; } r -= (CNT_); }
    for (int it = gw; it < NITEMS; it += NGW) {
        int r = it;
        if (r < NLAYER * I_L) { const int L = r / I_L; r -= L * I_L; unsigned char* wl = ws + WS_W + (size_t)L * WL_SIZE;
            TR_JOB(I_FIN, a.in[5] + (size_t)L * DM * 2 * DFF, 2 * DFF, DM, 2 * DFF, a.in[4] + L * DM, (bf16*)(wl + WL_F1IN), map_glu)
            TR_JOB(I_FOUT, a.in[6] + (size_t)L * DFF * DM, DM, DFF, DM, (const float*)nullptr, (bf16*)(wl + WL_F1OUT), map_id)
            TR_JOB(I_FIN, a.in[18] + (size_t)L * DM * 2 * DFF, 2 * DFF, DM, 2 * DFF, a.in[17] + L * DM, (bf16*)(wl + WL_F2IN), map_glu)
            TR_JOB(I_FOUT, a.in[19] + (size_t)L * DFF * DM, DM, DFF, DM, (const float*)nullptr, (bf16*)(wl + WL_F2OUT), map_id)
            TR_JOB(I_SQ, a.in[21] + (size_t)L * DM * DM, DM, DM, DM, a.in[20] + L * DM, (bf16*)(wl + WL_WG), map_id)
            TR_JOB(I_WP, a.in[22] + (size_t)L * 256 * DM, DM, 256, DM, (const float*)nullptr, (bf16*)(wl + WL_WP), map_id)
            continue; }
        r -= NLAYER * I_L;
        if (r < 2 * I_E) { const int j = r / I_E; r -= j * I_E; unsigned char* we = ws + WS_WE + (size_t)j * WE_SIZE; const float* gm = a.in[7] + (2 * j) * DM;
            if (r < I_EIN) { const int nblk = 2048 / 32, kb = r / nblk, n0 = (r % nblk) * 32; const float* W = a.in[8] + (size_t)j * DM * 3072 + 1024;
                if (n0 < 1024) tr_item(W, 3072, DM, gm, (bf16*)(we + WE_WU), n0, scr, kb * 64, n0, lane);
                else tr_item(W, 3072, DM, gm, (bf16*)(we + WE_WZ), 1024 + (n0 - 1024), scr, kb * 64, n0, lane);
                continue; }
            r -= I_EIN;
            { const int nblk = DM / 32, kb = r / nblk, n0 = (r % nblk) * 32; const float* W = a.in[12] + (size_t)j * DM * DM;
              if (kb < 16) tr_item_wofold(W, (bf16*)(we + WE_WO), scr, kb * 64, n0, lane); else tr_item(W, DM, DM, (const float*)nullptr, (bf16*)(we + WE_WO), n0, scr, kb * 64, n0, lane); }
            continue; }
        r -= 2 * I_E;
        { const int j = r / I_O; r -= j * I_O; unsigned char* wo = ws + WS_WOD + (size_t)j * WO_SIZE;
            TR_JOB(I_OIN, a.in[13] + (size_t)j * DM * 6144, 6144, DM, 6144, a.in[7] + (2 * j + 1) * DM, (bf16*)(wo + WO_WC), map_oddin)
            TR_JOB(I_SQ, a.in[16] + (size_t)j * DM * DM, DM, DM, DM, (const float*)nullptr, (bf16*)(wo + WO_WOC), map_id)
        }
    }
#undef TR_JOB
    {   LAS float* tab = scr + 2200;
        tab[lane] = cospif((float)lane * (1.0f / 32.0f));
        LDS_WAIT(); asm volatile("" ::: "memory");
        const bool isq = lane >= 33; const int cp = isq ? lane - 32 : lane, toff = isq ? 48 : 0;
        for (int it = gw; it < 2 * 64 * 16; it += NGW) { const int j = it >> 10, kb = (it >> 4) & 63, h = it & 15; const int k0 = kb * 32;
            const float* W = a.in[8] + (size_t)j * DM * 3072 + h * 64; const float* gm = a.in[7] + (2 * j) * DM; bf16* WZ = (bf16*)(ws + WS_WE + (size_t)j * WE_SIZE + WE_WZ);
            const int zr = isq ? 528 + h * 31 + (lane - 33) : h * 33 + lane;
            for (int kq = 0; kq < 4; ++kq) {
                float ac[8];
#pragma unroll
                for (int q = 0; q < 8; ++q) ac[q] = 0.f;
                for (int cc = 0; cc < 64; ++cc) { const float tv = tab[((cc * cp) + toff) & 63];
#pragma unroll
                    for (int q = 0; q < 8; ++q) ac[q] += W[(size_t)(k0 + kq * 8 + q) * 3072 + cc] * tv; }
#pragma unroll
                for (int q = 0; q < 8; ++q) ac[q] *= gm[k0 + kq * 8 + q];
                v4u oc; oc.x = pk2(ac[0], ac[1]); oc.y = pk2(ac[2], ac[3]); oc.z = pk2(ac[4], ac[5]); oc.w = pk2(ac[6], ac[7]);
                *(GAS v4u*)(WZ + (size_t)zr * DM + k0 + kq * 8) = oc; }
        }
        LDS_WAIT(); asm volatile("" ::: "memory");
    }
    const size_t gt = (size_t)vcu * 512 + tid, NGT = (size_t)G * 512;
    for (size_t e = gt; e < (size_t)2 * 16 * 128 * 128 / 8; e += NGT) { const size_t j = e / (16 * 128 * 128 / 8), rem = e % (16 * 128 * 128 / 8);
        const f32x4 v0 = *(const f32x4*)(a.in[10] + e * 8), v1 = *(const f32x4*)(a.in[10] + e * 8 + 4);
        v4u o; o.x = pk2(v0[0], v0[1]); o.y = pk2(v0[2], v0[3]); o.z = pk2(v1[0], v1[1]); o.w = pk2(v1[2], v1[3]);
        *(GAS v4u*)((bf16*)(ws + WS_WE + j * WE_SIZE + WE_WS) + rem * 8) = o; }
#pragma unroll 1
    for (int which = 0; which < 2; ++which) { const int S = which ? 8192 : 2048, lg = which ? 13 : 11; bf16* Dm = (bf16*)(ws + (which ? WS_DS : WS_DP)); const float sc2 = 2.0f / (float)S;
        const size_t per_row = (size_t)(S / 8), per_mat = (size_t)(S / 2) * per_row, total = 2 * per_mat;
        for (size_t e = gt; e < total; e += NGT) { const bool sn = e >= per_mat; const size_t e2 = sn ? e - per_mat : e; const int k = (int)(e2 >> (lg - 3)), s0 = (int)(e2 & (per_row - 1)) * 8; float v[8];
            if (!sn) {
#pragma unroll
                for (int q = 0; q < 8; ++q) v[q] = cospif((float)((k * (s0 + q)) & (S - 1)) * sc2);
            } else {
#pragma unroll
                for (int q = 0; q < 8; ++q) v[q] = sinpif((float)((k * (s0 + q)) & (S - 1)) * sc2);
            }
            v4u o; o.x = pk2(v[0], v[1]); o.y = pk2(v[2], v[3]); o.z = pk2(v[4], v[5]); o.w = pk2(v[6], v[7]);
            *(GAS v4u*)(Dm + e * 8) = o; } }
    { pg8::stat_t* st0 = (pg8::stat_t*)(ws + WS_STATS); bf16* xb0 = (bf16*)(ws + WS_XB0);
        for (int row = gw; row < T; row += NGW) { const float* src = row < TP ? a.in[0] + (size_t)row * DM : a.in[1] + (size_t)(row - TP) * DM;
            const f32x4* xr = (const f32x4*)src + lane; f32x4 v[8]; float s = 0.f;
#pragma unroll
            for (int j = 0; j < 8; ++j) { v[j] = xr[64 * j]; s += (v[j][0] * v[j][0] + v[j][1] * v[j][1]) + (v[j][2] * v[j][2] + v[j][3] * v[j][3]); }
            s = wave_sum(s); if (lane == 0) st0[row] = pg8::stat_fix(s);
            v2u* brow = (v2u*)(xb0 + (size_t)row * DM) + lane;
#pragma unroll
            for (int j = 0; j < 8; ++j) { v2u w; w.x = pk2(v[j][0], v[j][1]); w.y = pk2(v[j][2], v[j][3]); brow[64 * j] = w; } } }
    { bf16* pb = (bf16*)(ws + WS_PB);
        for (size_t e = gt; e < (size_t)NLAYER * T * 256 / 8; e += NGT) { const size_t L = e / ((size_t)T * 32), rem = e % ((size_t)T * 32), row = rem >> 5, c8 = rem & 31;
            const float* src = row < (size_t)TP ? a.in[2] + ((size_t)L * TP + row) * 256 + c8 * 8 : a.in[3] + ((size_t)L * 8192 + (row - TP)) * 256 + c8 * 8;
            const f32x4 v0 = *(const f32x4*)src, v1 = *(const f32x4*)(src + 4);
            v4u o; o.x = pk2(v0[0], v0[1]); o.y = pk2(v0[2], v0[3]); o.z = pk2(v1[0], v1[1]); o.w = pk2(v1[2], v1[3]);
            *(GAS v4u*)(pb + e * 8) = o; } }
}

__device__ __forceinline__ void sgu_phase(const bf16* Wsb, const float* bs, const bf16* VT, const bf16* U, bf16* Y, int idx, int n) {
    int tid_o = threadIdx.x; asm volatile("" : "+v"(tid_o)); const int lane = tid_o & 63, wave = __builtin_amdgcn_readfirstlane(tid_o >> 6);
    const int h = idx & 15, q = idx >> 4, nq = n >> 4, ct = wave & 3, th = wave >> 2, fr = lane & 15, fq = lane >> 4;
    if (idx < 0 || idx >= n || nq == 0) return;
    bf16x8 wf[4][4];
#pragma unroll
    for (int tt = 0; tt < 4; ++tt)
#pragma unroll
        for (int ks = 0; ks < 4; ++ks) wf[tt][ks] = *(const bf16x8*)(Wsb + ((size_t)h * 128 + th * 64 + tt * 16 + fr) * 128 + ks * 32 + fq * 8);
    float bias[4];
#pragma unroll
    for (int tt = 0; tt < 4; ++tt) bias[tt] = bs[h * 128 + th * 64 + tt * 16 + fr];
    for (int ch = q; ch < T / 128; ch += nq) {
        bf16x8 vf[4];
#pragma unroll
        for (int ks = 0; ks < 4; ++ks) vf[ks] = *(const bf16x8*)(VT + (size_t)(h * 64 + ct * 16 + fr) * T + (size_t)ch * 128 + ks * 32 + fq * 8);
#pragma unroll
        for (int tt = 0; tt < 4; ++tt) { f32x4 acc = (f32x4){0.f, 0.f, 0.f, 0.f};
#pragma unroll
            for (int ks = 0; ks < 4; ++ks) acc = __builtin_amdgcn_mfma_f32_16x16x32_bf16(vf[ks], wf[tt][ks], acc, 0, 0, 0);
            const size_t t = (size_t)ch * 128 + th * 64 + tt * 16 + fr; const int c = h * 64 + ct * 16 + fq * 4;
            const v2u uu = *(const v2u*)(U + t * 1024 + c);
            v2u o; o.x = pk2(bflo(uu.x) * (acc[0] + bias[tt]), bfhi(uu.x) * (acc[1] + bias[tt])); o.y = pk2(bflo(uu.y) * (acc[2] + bias[tt]), bfhi(uu.y) * (acc[3] + bias[tt]));
            *(v2u*)(Y + t * 2048 + 1024 + c) = o; }
    }
}
__device__ __forceinline__ void conv_phase(const bf16* Z, const bf16* GB, const float* wc, const float* bc, bf16* Y, int vcu, int G) {
    int tid_o = threadIdx.x; asm volatile("" : "+v"(tid_o)); const size_t gt = (size_t)vcu * 512 + tid_o, NGT = (size_t)G * 512;
    for (size_t e = gt; e < (size_t)T * 256; e += NGT) { const int t = (int)(e >> 8), c0 = (int)(e & 255) * 8;
        const int sp = t < TP ? (t & 2047) : (t - TP), sl = t < TP ? 2048 : 8192;
        const v4u zc = *(const v4u*)(Z + (size_t)t * 2048 + c0), gb = *(const v4u*)(GB + (size_t)t * 2048 + c0);
        v4u zm = (v4u){0u, 0u, 0u, 0u}, zp = (v4u){0u, 0u, 0u, 0u};
        if (sp > 0) zm = *(const v4u*)(Z + (size_t)(t - 1) * 2048 + c0);
        if (sp < sl - 1) zp = *(const v4u*)(Z + (size_t)(t + 1) * 2048 + c0);
        const f32x4 w0a = *(const f32x4*)(wc + c0), w0b = *(const f32x4*)(wc + c0 + 4), w1a = *(const f32x4*)(wc + 2048 + c0), w1b = *(const f32x4*)(wc + 2048 + c0 + 4), w2a = *(const f32x4*)(wc + 4096 + c0), w2b = *(const f32x4*)(wc + 4096 + c0 + 4);
        const f32x4 ba = *(const f32x4*)(bc + c0), bb = *(const f32x4*)(bc + c0 + 4);
        float y[8];
#pragma unroll
        for (int p = 0; p < 4; ++p) { const unsigned m = zm[p], c = zc[p], n = zp[p], g = gb[p]; const int i0 = 2 * p, i1 = 2 * p + 1;
            const float w0l = i0 < 4 ? w0a[i0] : w0b[i0 - 4], w0h = i1 < 4 ? w0a[i1] : w0b[i1 - 4], w1l = i0 < 4 ? w1a[i0] : w1b[i0 - 4], w1h = i1 < 4 ? w1a[i1] : w1b[i1 - 4];
            const float w2l = i0 < 4 ? w2a[i0] : w2b[i0 - 4], w2h = i1 < 4 ? w2a[i1] : w2b[i1 - 4], bl = i0 < 4 ? ba[i0] : bb[i0 - 4], bh = i1 < 4 ? ba[i1] : bb[i1 - 4];
            y[i0] = bflo(g) * (w0l * bflo(m) + w1l * bflo(c) + w2l * bflo(n) + bl);
            y[i1] = bfhi(g) * (w0h * bfhi(m) + w1h * bfhi(c) + w2h * bfhi(n) + bh); }
        v4u o; o.x = pk2(y[0], y[1]); o.y = pk2(y[2], y[3]); o.z = pk2(y[4], y[5]); o.w = pk2(y[6], y[7]);
        *(GAS v4u*)(Y + (size_t)t * 2048 + c0) = o; }
}
__device__ __forceinline__ void final_phase(float* out, const bf16* XBf, const pg8::stat_t* st, const float* gf, int vcu, int G) {
    int tid_o = threadIdx.x; asm volatile("" : "+v"(tid_o)); const int lane = tid_o & 63, gw = vcu * 8 + __builtin_amdgcn_readfirstlane(tid_o >> 6), NGW = G * 8;
    f32x4 g[4][2];
#pragma unroll
    for (int j = 0; j < 4; ++j) { g[j][0] = *(const f32x4*)(gf + 512 * j + 8 * lane); g[j][1] = *(const f32x4*)(gf + 512 * j + 8 * lane + 4); }
    for (int row = gw; row < T; row += NGW) { const float r = pg8::rinv_of(st, row); const bf16* xr = XBf + (size_t)row * DM + 8 * lane; float* orow = out + (size_t)row * DM + 8 * lane;
#pragma unroll
        for (int j = 0; j < 4; ++j) { const v4u w = *(const v4u*)(xr + 512 * j); f32x4 a, b; a[0] = bflo(w.x); a[1] = bfhi(w.x); a[2] = bflo(w.y); a[3] = bfhi(w.y); b[0] = bflo(w.z); b[1] = bfhi(w.z); b[2] = bflo(w.w); b[3] = bfhi(w.w);
            *(f32x4*)(orow + 512 * j) = a * r * g[j][0]; *(f32x4*)(orow + 512 * j + 4) = b * r * g[j][1]; } }
}

__device__ __forceinline__ void dft_mid_rows(const bf16* ZTP, const bf16* ZTS, bf16* Y, int idx, int n) {
    int tid_o = threadIdx.x; asm volatile("" : "+v"(tid_o)); const int lane = tid_o & 63, wave = __builtin_amdgcn_readfirstlane(tid_o >> 6);
    if (idx < 0 || idx >= n) return;
    for (int it = idx * 8 + wave; it < 17 * 529; it += n * 8) { const int b = it / 529, col = it - 529 * b; const int S = b < 16 ? 2048 : 8192; const size_t row = (b < 16 ? (size_t)b * 2048 : (size_t)TP) + S / 2;
        if (col == 528) { unsigned zz = 0u; asm volatile("" : "+v"(zz)); v4u z4; z4.x = zz; z4.y = zz; z4.z = zz; z4.w = zz;
            if (lane < 62) *(GAS v4u*)(Y + row * 2048 + 528 + 8 * lane) = z4; continue; }
        const bf16* z = b < 16 ? ZTP + ((size_t)b * 1024 + col) * 2048 : ZTS + (size_t)col * 8192; float sum = 0.f;
        for (int s0 = lane * 8; s0 < S; s0 += 512) { const v4u w = *(const v4u*)(z + s0);
            sum += (bflo(w.x) - bfhi(w.x)) + (bflo(w.y) - bfhi(w.y)) + (bflo(w.z) - bfhi(w.z)) + (bflo(w.w) - bfhi(w.w)); }
        sum = wave_sum(sum);
        if (lane == 0) Y[row * 2048 + col] = (bf16)f2bf(sum * (b < 16 ? 0.0027621358640099515f : 0.0013810679320049757f)); }
}
struct DftOrder {
    int nM, ntile, tile0, nunits, n, c;
    __device__ void init(int nM_, int ntile_, int tile0_, int nbatch, int lo, int n_, int rot, int bx) { nM = nM_; ntile = ntile_; tile0 = tile0_; nunits = nM_ * ntile_ * nbatch; n = n_; c = (bx >= lo && bx < lo + n_) ? (bx - lo + rot) % n_ : 0x40000000; }
    __device__ bool next(int i, pg8::Unit& u) const { const long L = (long)i * n + c; if (L >= nunits) return false; const int l = (int)L, r = l / nM; u.pm = l - r * nM; u.pn = 4 * (r / ntile) + tile0 + r % ntile; return true; }
    __device__ __forceinline__ void a_ready(const pg8::Unit&) const {}
    __device__ __forceinline__ void done(const pg8::Unit&) const {}
};
struct DirOrder : pg8::StaticOrder {
    bool rev;
    __device__ void init_dir(int M, int N, int G_, int c_, bool rev_) { init(M, N, G_, c_); rev = rev_; }
    __device__ bool next(int i, pg8::Unit& u) const {
        const long L = (long)i * G + c; if (L >= nwg) return false;
        const int q = nwg / pg8::NXCD, r = nwg % pg8::NXCD; int wgid = (int)L; const int xcd = wgid % pg8::NXCD, off = wgid / pg8::NXCD;
        const int len = xcd < r ? q + 1 : q, base = xcd < r ? xcd * (q + 1) : r * (q + 1) + (xcd - r) * q;
        wgid = base + (rev ? len - 1 - off : off);
        const int nig = pg8::WGM * nN, gid = wgid / nig, fm = gid * pg8::WGM, gsz = (nM - fm) < pg8::WGM ? (nM - fm) : pg8::WGM;
        u.pm = fm + ((wgid % nig) % gsz); u.pn = (wgid % nig) / gsz; return true;
    }
};
struct RangeOrder : pg8::StaticOrder {
    __device__ void init_range(int M, int N, int lo, int n, int bx) { const int c_ = (bx >= lo && bx < lo + n) ? bx - lo : 0x40000000; init(M, N, n, c_); }
};

#ifndef MK_SITES
#define MK_SITES 0xFFFFFFFFu
#endif
#define SITE(n) (((MK_SITES) >> (n)) & 1u)
#ifndef MK_DUP
#define MK_DUP 0u
#endif
#define NREP(n) ((((MK_DUP) >> (n)) & 1u) ? 2 : 1)
#define DRY(n) (NREP(n) == 2 && rep == 0)
struct SameTileOrder : pg8::StaticOrder {
    __device__ bool next(int i, pg8::Unit& u) const { const bool r = pg8::StaticOrder::next(i, u); u.pm = 0; u.pn = 0; return r; }
};
#define OPAQUE_WS() unsigned char* wsl = ws; asm volatile("" : "+s"(wsl)); unsigned char* const wl = wsl + WS_W + (size_t)L * WL_SIZE; bf16* const xb = (bf16*)(wsl + ((L & 1) ? WS_XB1 : WS_XB0)); bf16* const xalt = (bf16*)(wsl + ((L & 1) ? WS_XB0 : WS_XB1)); bf16* const Hb = (bf16*)(wsl + WS_H); (void)wl; (void)xb; (void)xalt; (void)Hb
#ifndef MK_DIR
#define MK_DIR 1
#endif
#define PH_REV(k) ((MK_DIR) != 0 && ((k) & 1) != 0)
__global__ void __launch_bounds__(512, 2) mk_fwd(Args args) {
    extern __shared__ __attribute__((aligned(16))) unsigned char lds_raw[];
    LAS unsigned char* lds = (LAS unsigned char*)lds_raw;
    const int tid = threadIdx.x, lane = tid & 63, wave = __builtin_amdgcn_readfirstlane(tid >> 6);
    const int G = gridDim.x, bx = blockIdx.x;
    const int vcu = (G % 8 == 0) ? (bx % 8) * (G / 8) + bx / 8 : bx;
    unsigned char* ws = args.ws;
    volatile LAS unsigned* MISC = (volatile LAS unsigned*)(lds + LDSCTL_OFF);
    for (int u = tid; u < (LDS_BYTES - LDSCTL_OFF) / 4; u += 512) ((LAS unsigned*)(lds + LDSCTL_OFF))[u] = 0u;
    __syncthreads();
    XcdBarrier bar; bar.bar = (unsigned*)(ws + WS_CTL) + CW_BAR; bar.x = 0; bar.st = nullptr;
    if (MK_N_LAUNCHES == 1) bar = xcd_barrier_post((unsigned*)(ws + WS_CTL) + CW_BAR, MISC + 8);
    const int lo = args.ph_lo, hi = args.ph_hi;
#define IN(k) (lo <= (k) && (k) < hi)
#define SEAM(k) do { if (IN(k) && IN((k) + 1)) xcd_barrier(bar); } while (0)
    pg8::stat_t* stats = (pg8::stat_t*)(ws + WS_STATS); pg8::stat_t* st_dummy = stats + (size_t)17 * T;

    if (IN(0) && SITE(0)) for (int rep = 0; rep < NREP(0); ++rep) { p0_prologue(args, lds, vcu, G, wave, lane, tid); }
    SEAM(0);

#pragma unroll 1
    for (int L = 0; L < NLAYER; ++L) {
        const int pb0 = 1 + 8 * L, j = L >> 1; const bool odd = (L & 1) != 0;
        pg8::stat_t* st0 = stats + (size_t)(4 * L + 0) * T; pg8::stat_t* st1 = stats + (size_t)(4 * L + 1) * T; pg8::stat_t* st2 = stats + (size_t)(4 * L + 2) * T; pg8::stat_t* st3 = stats + (size_t)(4 * L + 3) * T; pg8::stat_t* st4 = stats + (size_t)(4 * L + 4) * T;
        { OPAQUE_WS();
#ifdef MK_NULLP
        if (IN(pb0 + 0) && (MK_NULLP & 4)) { pg8::Gemm g{xb, (const bf16*)(wl + WL_F1IN), T, 2 * DFF, DM}; SameTileOrder S; S.init(T, 2 * DFF, G, bx);
            pg8::EpiNull E{(float*)st_dummy}; pg8::gemm_phase<pg8::EpiNull, SameTileOrder, MK_ALIGN, MK_SP2>(lds, g, S, E); }
        if (IN(pb0 + 0) && (MK_NULLP & 1)) { pg8::Gemm g{xb, (const bf16*)(wl + WL_F1IN), T, 2 * DFF, DM}; pg8::StaticOrder S; S.init(T, 2 * DFF, G, bx);
            pg8::EpiNull E{(float*)st_dummy}; pg8::gemm_phase<pg8::EpiNull, pg8::StaticOrder, MK_ALIGN, MK_SP2>(lds, g, S, E); }
        if (IN(pb0 + 1) && (MK_NULLP & 2)) { pg8::Gemm g{(const bf16*)(wsl + WS_H), (const bf16*)(wl + WL_F1OUT), T, DM, DFF}; pg8::StaticOrder S; S.init(T, DM, G, bx);
            pg8::EpiNull E{(float*)st_dummy}; pg8::gemm_phase<pg8::EpiNull, pg8::StaticOrder, MK_ALIGN, MK_SP2>(lds, g, S, E); }
#endif
        if (IN(pb0 + 0) && SITE(1)) for (int rep = 0; rep < NREP(1); ++rep) { pg8::Gemm g{xb, (const bf16*)(wl + WL_F1IN), T, 2 * DFF, DM}; DirOrder S; S.init_dir(T, 2 * DFF, G, bx, PH_REV(0));
            pg8::EpiSwiGLU E{Hb, DFF, st0}; pg8::gemm_phase<pg8::EpiSwiGLU, DirOrder, MK_ALIGN, MK_SP2>(lds, g, S, E); }
        }
        SEAM(pb0 + 0);
        { OPAQUE_WS();
        if (IN(pb0 + 1) && SITE(2)) for (int rep = 0; rep < NREP(2); ++rep) { pg8::Gemm g{Hb, (const bf16*)(wl + WL_F1OUT), T, DM, DFF}; DirOrder S; S.init_dir(T, DM, G, bx, PH_REV(1));
            pg8::EpiRmw<0> E{xb, xb, nullptr, DRY(2) ? st_dummy : st1, DRY(2) ? 0.0f : 0.5f}; pg8::gemm_phase<pg8::EpiRmw<0>, DirOrder, MK_ALIGN, MK_SP2>(lds, g, S, E); }
        }
        SEAM(pb0 + 1);
        { OPAQUE_WS();
        if (IN(pb0 + 2)) {
            if (!odd) { unsigned char* we = wsl + WS_WE + (size_t)j * WE_SIZE;
                if (SITE(3)) for (int rep = 0; rep < NREP(3); ++rep) { pg8::Gemm g{(const bf16*)(we + WE_WZ), xb, 2048, T, DM}; DirOrder S; S.init_dir(2048, T, G, bx, PH_REV(2));
                  pg8::EpiMT E{(bf16*)(wsl + WS_ZTP), (bf16*)(wsl + WS_ZTS), (bf16*)(wsl + WS_VT), st1, args.in[9] + j * 1024};
                  pg8::gemm_phase<pg8::EpiMT, DirOrder, MK_ALIGN, MK_SP2>(lds, g, S, E); }
                if (SITE(4)) for (int rep = 0; rep < NREP(4); ++rep) { pg8::Gemm g{xb, (const bf16*)(we + WE_WU), T, 1024, DM}; DirOrder S; S.init_dir(T, 1024, G, (bx + G / 2) % G, PH_REV(2));
                  pg8::EpiRowBf16<1> E{(bf16*)(wsl + WS_U), 1024, st1}; pg8::gemm_phase<pg8::EpiRowBf16<1>, DirOrder, MK_ALIGN, MK_SP2>(lds, g, S, E); }
            } else if (SITE(5)) for (int rep = 0; rep < NREP(5); ++rep) { unsigned char* wo = wsl + WS_WOD + (size_t)j * WO_SIZE;
                pg8::Gemm g{xb, (const bf16*)(wo + WO_WC), T, 6144, DM}; DirOrder S; S.init_dir(T, 6144, G, bx, PH_REV(2));
                pg8::EpiOddIn E{(bf16*)(wsl + WS_Z), (bf16*)(wsl + WS_GB), st1}; pg8::gemm_phase<pg8::EpiOddIn, DirOrder, MK_ALIGN, MK_SP2>(lds, g, S, E); }
        }
        }
        SEAM(pb0 + 2);
        { OPAQUE_WS();
        if (IN(pb0 + 3)) {
            if (!odd) { unsigned char* we = wsl + WS_WE + (size_t)j * WE_SIZE;
                const bool tuned = (G == 256); const int s_lo = 0, sp_n = tuned ? 48 : G, sq_lo = tuned ? 48 : 0, sq_n = tuned ? 32 : G, p_lo = tuned ? 80 : 0, p_n = tuned ? 176 : G;
                const bf16* dpc = (const bf16*)(wsl + WS_DP); const bf16* dps = dpc + (size_t)1024 * 2048; const bf16* dsc = (const bf16*)(wsl + WS_DS); const bf16* dss = dsc + (size_t)4096 * 8192;
                if (SITE(7)) for (int rep = 0; rep < NREP(7); ++rep) {
                  { pg8::Gemm g{dsc, (const bf16*)(wsl + WS_ZTS), 4096, 1024, 8192}; DftOrder S; S.init(16, 3, 0, 1, s_lo, sp_n, 0, bx);
                    pg8::EpiDFT E{xalt, TP, 8192, 0.0013810679320049757f, 1.0f, 0, 528}; pg8::gemm_phase<pg8::EpiDFT, DftOrder, MK_ALIGN, MK_SP2>(lds, g, S, E); }
                  { pg8::Gemm g{dss, (const bf16*)(wsl + WS_ZTS), 4096, 1024, 8192}; DftOrder S; S.init(16, 2, 2, 1, sq_lo, sq_n, 0, bx);
                    pg8::EpiDFT E{xalt, TP, 8192, 0.0013810679320049757f, -1.0f, 528, 1024}; pg8::gemm_phase<pg8::EpiDFT, DftOrder, MK_ALIGN, MK_SP2>(lds, g, S, E); } }
                if (SITE(6)) for (int rep = 0; rep < NREP(6); ++rep) {
                  { pg8::Gemm g{dpc, (const bf16*)(wsl + WS_ZTP), 1024, 16 * 1024, 2048}; DftOrder S; S.init(4, 3, 0, 16, p_lo, p_n, 0, bx);
                    pg8::EpiDFT E{xalt, 0, 2048, 0.0027621358640099515f, 1.0f, 0, 528}; pg8::gemm_phase<pg8::EpiDFT, DftOrder, MK_ALIGN, MK_SP2>(lds, g, S, E); }
                  { pg8::Gemm g{dps, (const bf16*)(wsl + WS_ZTP), 1024, 16 * 1024, 2048}; DftOrder S; S.init(4, 2, 2, 16, p_lo, p_n, tuned ? 160 : 0, bx);
                    pg8::EpiDFT E{xalt, 0, 2048, 0.0027621358640099515f, -1.0f, 528, 1024}; pg8::gemm_phase<pg8::EpiDFT, DftOrder, MK_ALIGN, MK_SP2>(lds, g, S, E); } }
                dft_mid_rows((const bf16*)(wsl + WS_ZTP), (const bf16*)(wsl + WS_ZTS), xalt, tuned ? bx : bx, tuned ? 80 : G);
                if (SITE(8)) for (int rep = 0; rep < NREP(8); ++rep) sgu_phase((const bf16*)(we + WE_WS), args.in[11] + j * 2048, (const bf16*)(wsl + WS_VT), (const bf16*)(wsl + WS_U), xalt, bx - p_lo, p_n & ~15);
            } else if (SITE(9)) for (int rep = 0; rep < NREP(9); ++rep) {
                conv_phase((const bf16*)(wsl + WS_Z), (const bf16*)(wsl + WS_GB), args.in[14] + j * 3 * 2048, args.in[15] + j * 2048, xalt, vcu, G);
            }
        }
        }
        SEAM(pb0 + 3);
        { OPAQUE_WS();
        if (IN(pb0 + 4) && SITE(10)) for (int rep = 0; rep < NREP(10); ++rep) { const bf16* wout = odd ? (const bf16*)(wsl + WS_WOD + (size_t)j * WO_SIZE + WO_WOC) : (const bf16*)(wsl + WS_WE + (size_t)j * WE_SIZE + WE_WO);
            pg8::Gemm g{xalt, wout, T, DM, DM}; DirOrder S; S.init_dir(T, DM, G, bx, PH_REV(4));
            pg8::EpiRmw<0> E{xb, xb, nullptr, DRY(10) ? st_dummy : st2, DRY(10) ? 0.0f : 1.0f}; pg8::gemm_phase<pg8::EpiRmw<0>, DirOrder, MK_ALIGN, MK_SP2>(lds, g, S, E); }
        }
        SEAM(pb0 + 4);
        { OPAQUE_WS();
        if (IN(pb0 + 5) && SITE(11)) for (int rep = 0; rep < NREP(11); ++rep) { pg8::Gemm g{xb, (const bf16*)(wl + WL_F2IN), T, 2 * DFF, DM}; DirOrder S; S.init_dir(T, 2 * DFF, G, bx, PH_REV(5));
            pg8::EpiSwiGLU E{Hb, DFF, st2}; pg8::gemm_phase<pg8::EpiSwiGLU, DirOrder, MK_ALIGN, MK_SP2>(lds, g, S, E); }
        }
        SEAM(pb0 + 5);
        { OPAQUE_WS();
        if (IN(pb0 + 6)) {
            if (SITE(12)) for (int rep = 0; rep < NREP(12); ++rep) { pg8::Gemm g{Hb, (const bf16*)(wl + WL_F2OUT), T, DM, DFF}; DirOrder S; S.init_dir(T, DM, G, bx, PH_REV(6));
              pg8::EpiRmw<0> E{xb, xb, nullptr, DRY(12) ? st_dummy : st3, DRY(12) ? 0.0f : 0.5f}; pg8::gemm_phase<pg8::EpiRmw<0>, DirOrder, MK_ALIGN, MK_SP2>(lds, g, S, E); }
            if (SITE(13)) for (int rep = 0; rep < NREP(13); ++rep) { int kpe = 256; asm volatile("" : "+s"(kpe));
              pg8::Gemm g{(const bf16*)(wsl + WS_PB) + (size_t)L * T * 256, (const bf16*)(wl + WL_WP), T, DM, kpe}; DirOrder S; S.init_dir(T, DM, G, bx, PH_REV(6));
              pg8::EpiRowBf16<0> E{xalt, 2048, nullptr}; pg8::gemm_phase<pg8::EpiRowBf16<0>, DirOrder, MK_ALIGN, MK_SP2>(lds, g, S, E); }
        }
        }
        SEAM(pb0 + 6);
        { OPAQUE_WS();
        if (IN(pb0 + 7) && SITE(14)) for (int rep = 0; rep < NREP(14); ++rep) { pg8::Gemm g{xb, (const bf16*)(wl + WL_WG), T, DM, DM}; DirOrder S; S.init_dir(T, DM, G, bx, PH_REV(7));
            pg8::EpiRmw<1> E{xb, xalt, st3, DRY(14) ? st_dummy : st4, DRY(14) ? 0.0f : 1.0f}; pg8::gemm_phase<pg8::EpiRmw<1>, DirOrder, MK_ALIGN, MK_SP2>(lds, g, S, E); }
        }
        SEAM(pb0 + 7);
    }
    if (IN(33) && SITE(15)) final_phase(args.out, (const bf16*)(ws + WS_XB0), stats + (size_t)16 * T, args.in[23], vcu, G);
#undef IN
#undef SEAM
}

extern "C" void kernel_launch(void* const* d_in, const int* in_sizes, int n_in, void* d_out, int out_size, void* d_ws, size_t ws_size, hipStream_t stream) {
    static int grid = 0;
    if (grid == 0) {
        if (n_in != 24 || out_size != T * DM || ws_size < WS_END) { fprintf(stderr, "kernel_launch: unexpected sizes (n_in %d, out %d, ws %zu, need %zu); nothing launched\n", n_in, out_size, ws_size, (size_t)WS_END); grid = -1; return; }
        int dev = 0, cus = 0, per_cu = 0;
        if (hipGetDevice(&dev) != hipSuccess || hipDeviceGetAttribute(&cus, hipDeviceAttributeMultiprocessorCount, dev) != hipSuccess) { grid = -1; return; }
        if (hipFuncSetAttribute((const void*)mk_fwd, hipFuncAttributeMaxDynamicSharedMemorySize, LDS_BYTES) != hipSuccess) { fprintf(stderr, "kernel_launch: hipFuncSetAttribute failed\n"); grid = -1; return; }
        if (hipOccupancyMaxActiveBlocksPerMultiprocessor(&per_cu, (const void*)mk_fwd, 512, LDS_BYTES) != hipSuccess || per_cu < 1) fprintf(stderr, "kernel_launch: occupancy query reports %d workgroups per CU\n", per_cu);
        (void)hipGetLastError();
        grid = cus;
    }
    if (grid < 0) return;
#ifdef MK_POISON_WS
    if (hipMemsetAsync((char*)d_ws, 0xFF, WS_END, stream) != hipSuccess) return;
#endif
    if (hipMemsetAsync((char*)d_ws + WS_CTL, 0, CTL_BYTES, stream) != hipSuccess) return;
    Args a{};
    for (int i = 0; i < 24; ++i) a.in[i] = (const float*)d_in[i];
    a.out = (float*)d_out; a.ws = (unsigned char*)d_ws;
    if (MK_N_LAUNCHES == 1) { a.ph_lo = 0; a.ph_hi = NPHASE; hipLaunchKernelGGL(mk_fwd, dim3(grid), dim3(512), LDS_BYTES, stream, a); }
    else for (int p = 0; p < NPHASE; ++p) { a.ph_lo = p; a.ph_hi = p + 1; hipLaunchKernelGGL(mk_fwd, dim3(grid), dim3(512), LDS_BYTES, stream, a); }
}
```

```cpp
#include <hip/hip_runtime.h>
#include <cstdio>
#include <cstdint>
#ifndef MK_WGM
#define MK_WGM 4
#endif
#ifndef MK_SP2
#define MK_SP2 true
#endif
#ifndef MK_ALIGN
#define MK_ALIGN true
#endif
namespace pg8 {
#define PG8_LAS __attribute__((address_space(3)))
typedef unsigned short bf16_t;
typedef short bf16x8 __attribute__((ext_vector_type(8)));
typedef float f32x4 __attribute__((ext_vector_type(4)));
typedef unsigned u32x4 __attribute__((ext_vector_type(4)));
constexpr int BM = 256, BK = 64, HALF = 128, HTB = HALF * BK * 2  , STAGE_BYTES = 8 * HTB, NXCD = 8, WGM = MK_WGM;

__host__ __device__ __forceinline__ int lds_byte(int r, int c) { const int st = (r >> 4) * 2 + (c >> 5), rr = r & 15, cc = c & 31, ob = rr * 64 + cc * 2; return st * 1024 + (ob ^ (((ob >> 9) & 1) << 5)); }
__host__ __device__ __forceinline__ void stage_rc(int b, int& R, int& C) { const int st = b / 1024, sb = b % 1024, swz = sb ^ (((sb >> 9) & 1) << 5); R = (st >> 1) * 16 + swz / 64; C = (st & 1) * 32 + (swz % 64) / 2; }
__host__ __device__ __forceinline__ int perm32(int rho) { const int n = rho >> 4, i = rho & 15; return 8 * (i >> 2) + 4 * n + (i & 3); }

struct Unit { int pm, pn; };
struct Gemm { const bf16_t* A; const bf16_t* Bt; int M, N, K; };

struct StaticOrder {
    int nM, nN, nwg, G, c;
    __host__ __device__ void init(int M, int N, int G_, int c_) { nM = M / BM; nN = N / BM; nwg = nM * nN; G = G_; c = c_; }
    __host__ __device__ bool next(int i, Unit& u) const {
        const long L = (long)i * G + c; if (L >= nwg) return false;
        int wgid = (int)L; { const int q = nwg / NXCD, r = nwg % NXCD, xcd = wgid % NXCD, off = wgid / NXCD; wgid = (xcd < r ? xcd * (q + 1) : r * (q + 1) + (xcd - r) * q) + off; }
        const int nig = WGM * nN, gid = wgid / nig, fm = gid * WGM, gsz = (nM - fm) < WGM ? (nM - fm) : WGM;
        u.pm = fm + ((wgid % nig) % gsz); u.pn = (wgid % nig) / gsz; return true;
    }
    __device__ __forceinline__ void a_ready(const Unit&) const {}
    __device__ __forceinline__ void done(const Unit&) const {}
};

__device__ __forceinline__ unsigned cvt_pk_bf16(float lo, float hi) { unsigned r; asm volatile("v_cvt_pk_bf16_f32 %0, %1, %2" : "=v"(r) : "v"(lo), "v"(hi)); return r; }
typedef float f32x2 __attribute__((ext_vector_type(2)));
__device__ __forceinline__ f32x2 gelu_pk(f32x2 v) {
    const f32x2 av = __builtin_elementwise_abs(v), d = av * 0.2316418882f + 1.0f;
    f32x2 t; t.x = __builtin_amdgcn_rcpf(d.x); t.y = __builtin_amdgcn_rcpf(d.y);
    f32x2 q = t * 0.5307027145f + (-0.7265760135f); q = q * t + 0.7107068705f; q = q * t + (-0.142248368f); q = q * t + 0.127414796f; q = q * t;
    const f32x2 s = (v * v) * (-0.72134752044f);
    f32x2 e; e.x = __builtin_amdgcn_exp2f(s.x); e.y = __builtin_amdgcn_exp2f(s.y);
    const f32x2 m = v * (q * e), r = v - m;
    f32x2 o; o.x = v.x < 0.f ? m.x : r.x; o.y = v.y < 0.f ? m.y : r.y; return o;
}

template <class Epi, class Sched, bool ALIGN_EPI = false, bool SP2 = false>
__device__ __forceinline__ void gemm_phase(PG8_LAS unsigned char* lds, const Gemm g, const Sched& S, const Epi& E) {
    int tid_o = threadIdx.x; asm volatile("" : "+v"(tid_o));
    const int tid = tid_o, wid = __builtin_amdgcn_readfirstlane(tid >> 6), lane = tid & 63, wr = wid >> 2, wc = wid & 3, fr = lane & 15, fq = lane >> 4;
    const int K = g.K, nt = K / BK;
    unsigned voffA[2], voffB[2];
#pragma unroll
    for (int i = 0; i < 2; ++i) { int R, C; stage_rc(tid * 16 + i * 8192, R, C); const int Rb = Epi::PERM ? ((R & ~31) + perm32(R & 31)) : R;
        voffA[i] = (unsigned)(R * K + C) * 2u; voffB[i] = (unsigned)(Rb * K + C) * 2u; }
    const unsigned kstep = (unsigned)(BK * 2);
    const unsigned hstep = (unsigned)HALF * (unsigned)K * 2u;
    const unsigned tstep = 2u * hstep;
    const unsigned ldsw = (unsigned)wid * 1024u;
    const int aoff = lds_byte(wr * 64 + fr, fq * 8), boff = lds_byte(wc * 32 + fr, fq * 8);
#define PG8_SA(b, h) (((b) * 2 + (h)) * HTB)
#define PG8_SB(b, h) ((4 + (b) * 2 + (h)) * HTB)
    const __amdgpu_buffer_rsrc_t rs_voffA = __builtin_amdgcn_make_buffer_rsrc((void*)g.A, (short)0, -1, 0x00020000);
    const __amdgpu_buffer_rsrc_t rs_voffB = __builtin_amdgcn_make_buffer_rsrc((void*)g.Bt, (short)0, -1, 0x00020000);
#define PG8_STAGE(bufoff, gbase, voff) do { _Pragma("unroll") for (int _i = 0; _i < 2; ++_i) \
        __builtin_amdgcn_raw_ptr_buffer_load_lds(rs_##voff, (PG8_LAS void*)(lds + (bufoff) + ldsw + _i * 8192), 16, (int)(voff)[_i], (int)(gbase), 0, 0); } while (0)
#define PG8_LDA(dst, b, h) do { _Pragma("unroll") for (int m = 0; m < 4; ++m) _Pragma("unroll") for (int k = 0; k < 2; ++k) dst[m][k] = *(const PG8_LAS bf16x8*)(lds + PG8_SA(b, h) + aoff + m * 2048 + k * 1024); } while (0)
#define PG8_LDB(dst, b, h) do { _Pragma("unroll") for (int n = 0; n < 2; ++n) _Pragma("unroll") for (int k = 0; k < 2; ++k) dst[n][k] = *(const PG8_LAS bf16x8*)(lds + PG8_SB(b, h) + boff + n * 2048 + k * 1024); } while (0)
#define PG8_MMA(ai, bj, At, Bt) do { __builtin_amdgcn_s_setprio(1); _Pragma("unroll") for (int m = 0; m < 4; ++m) _Pragma("unroll") for (int n = 0; n < 2; ++n) _Pragma("unroll") for (int k = 0; k < 2; ++k) \
        acc[ai][bj][m][n] = __builtin_amdgcn_mfma_f32_16x16x32_bf16(Bt[n][k], At[m][k], acc[ai][bj][m][n], 0, 0, 0); __builtin_amdgcn_s_setprio(0); } while (0)
#define PG8_WAIT_V(n) asm volatile("s_waitcnt vmcnt(" #n ")" ::: "memory")
#define PG8_WAIT_L(n) asm volatile("s_waitcnt lgkmcnt(" #n ")" ::: "memory")
#define PG8_BAR __builtin_amdgcn_s_barrier()
#define PG8_SCHED __builtin_amdgcn_sched_barrier(0)
    Unit cur, nxt; int ui = 0;
    if (!S.next(0, cur)) return;
    f32x4 acc[2][2][4][2];
#pragma unroll
    for (int a = 0; a < 2; ++a)
#pragma unroll
        for (int b = 0; b < 2; ++b)
#pragma unroll
            for (int m = 0; m < 4; ++m)
#pragma unroll
                for (int n = 0; n < 2; ++n) acc[a][b][m][n] = (f32x4){0.f, 0.f, 0.f, 0.f};
    bf16x8 At[4][2], B0[2][2], B1[2][2];
    unsigned cA = (unsigned)cur.pm * tstep, cB = (unsigned)cur.pn * tstep;
    S.a_ready(cur);
    if constexpr (SP2) {
        PG8_STAGE(PG8_SB(0, 0), cB, voffB); PG8_STAGE(PG8_SB(0, 1), cB + hstep, voffB); PG8_STAGE(PG8_SA(0, 0), cA, voffA); PG8_STAGE(PG8_SA(0, 1), cA + hstep, voffA);
        if (wr == 1) PG8_BAR;
        PG8_WAIT_V(2); PG8_BAR;
        PG8_STAGE(PG8_SB(1, 0), cB + kstep, voffB); PG8_STAGE(PG8_SA(1, 0), cA + kstep, voffA); PG8_STAGE(PG8_SB(1, 1), cB + hstep + kstep, voffB);
        PG8_WAIT_V(6); PG8_BAR;
    } else {
        PG8_STAGE(PG8_SB(0, 0), cB, voffB); PG8_STAGE(PG8_SA(0, 0), cA, voffA); PG8_STAGE(PG8_SB(0, 1), cB + hstep, voffB); PG8_STAGE(PG8_SA(0, 1), cA + hstep, voffA);
        if (wr == 1) PG8_BAR;
        PG8_WAIT_V(4); PG8_BAR;
        PG8_STAGE(PG8_SB(1, 0), cB + kstep, voffB); PG8_STAGE(PG8_SA(1, 0), cA + kstep, voffA); PG8_STAGE(PG8_SB(1, 1), cB + hstep + kstep, voffB);
        PG8_WAIT_V(6); PG8_BAR;
    }
    for (;;) {
        const bool has_next = S.next(ui + 1, nxt);
        const unsigned nA = has_next ? (unsigned)nxt.pm * tstep : cA, nB = has_next ? (unsigned)nxt.pn * tstep : cB;
        for (int t = 0; t < nt; t += 2) {
            const bool last = (t == nt - 2);
            const unsigned a1 = cA + (unsigned)(t + 1) * kstep;
            const unsigned a2 = last ? nA : cA + (unsigned)(t + 2) * kstep, b2 = last ? nB : cB + (unsigned)(t + 2) * kstep;
            const unsigned a3 = a2 + kstep, b3 = b2 + kstep;
            if (last && has_next) S.a_ready(nxt);
            if constexpr (SP2) {
            PG8_LDB(B0, 0, 0); PG8_LDB(B1, 0, 1); PG8_SCHED; PG8_LDA(At, 0, 0); PG8_STAGE(PG8_SA(1, 1), a1 + hstep, voffA);
            PG8_WAIT_V(8); PG8_WAIT_L(0); PG8_BAR; PG8_MMA(0, 0, At, B0); PG8_MMA(0, 1, At, B1); PG8_BAR; PG8_SCHED;
            PG8_LDA(At, 0, 1); PG8_STAGE(PG8_SB(0, 0), b2, voffB); PG8_STAGE(PG8_SB(0, 1), b2 + hstep, voffB); PG8_STAGE(PG8_SA(0, 0), a2, voffA);
            PG8_WAIT_V(8); PG8_WAIT_L(0); PG8_BAR; PG8_MMA(1, 0, At, B0); PG8_MMA(1, 1, At, B1); PG8_BAR; PG8_SCHED;
            PG8_LDB(B0, 1, 0); PG8_LDB(B1, 1, 1); PG8_SCHED; PG8_LDA(At, 1, 0); PG8_STAGE(PG8_SA(0, 1), a2 + hstep, voffA);
            PG8_WAIT_V(8); PG8_WAIT_L(0); PG8_BAR; PG8_MMA(0, 0, At, B0); PG8_MMA(0, 1, At, B1); PG8_BAR; PG8_SCHED;
            PG8_LDA(At, 1, 1); PG8_STAGE(PG8_SB(1, 0), b3, voffB); PG8_STAGE(PG8_SB(1, 1), b3 + hstep, voffB); PG8_STAGE(PG8_SA(1, 0), a3, voffA);
            PG8_WAIT_V(8); PG8_WAIT_L(0); PG8_BAR; PG8_MMA(1, 0, At, B0); PG8_MMA(1, 1, At, B1); PG8_BAR; PG8_SCHED;
            } else {
            PG8_LDB(B0, 0, 0); PG8_SCHED; PG8_LDA(At, 0, 0); PG8_STAGE(PG8_SA(1, 1), a1 + hstep, voffA);
            PG8_WAIT_L(8); PG8_BAR; PG8_WAIT_L(0); PG8_MMA(0, 0, At, B0); PG8_BAR; PG8_SCHED;
            PG8_LDB(B1, 0, 1); PG8_STAGE(PG8_SB(0, 0), b2, voffB);
            PG8_BAR; PG8_WAIT_L(0); PG8_MMA(0, 1, At, B1); PG8_BAR;
            PG8_LDA(At, 0, 1); PG8_STAGE(PG8_SA(0, 0), a2, voffA);
            PG8_BAR; PG8_WAIT_L(0); PG8_MMA(1, 0, At, B0); PG8_BAR; PG8_SCHED;
            PG8_STAGE(PG8_SB(0, 1), b2 + hstep, voffB);
            PG8_WAIT_V(6); PG8_BAR; PG8_MMA(1, 1, At, B1); PG8_BAR;
            PG8_LDB(B0, 1, 0); PG8_SCHED; PG8_LDA(At, 1, 0); PG8_STAGE(PG8_SA(0, 1), a2 + hstep, voffA);
            PG8_WAIT_L(8); PG8_BAR; PG8_WAIT_L(0); PG8_MMA(0, 0, At, B0); PG8_BAR; PG8_SCHED;
            PG8_LDB(B1, 1, 1); PG8_STAGE(PG8_SB(1, 0), b3, voffB);
            PG8_BAR; PG8_WAIT_L(0); PG8_MMA(0, 1, At, B1); PG8_BAR;
            PG8_LDA(At, 1, 1); PG8_STAGE(PG8_SA(1, 0), a3, voffA);
            PG8_BAR; PG8_WAIT_L(0); PG8_MMA(1, 0, At, B0); PG8_BAR; PG8_SCHED;
            PG8_STAGE(PG8_SB(1, 1), b3 + hstep, voffB);
            PG8_WAIT_V(6); PG8_BAR; PG8_MMA(1, 1, At, B1); PG8_BAR;
            }
        }
        if constexpr (ALIGN_EPI) { if (wr == 0) PG8_BAR; }
        if constexpr (!Epi::AFTER_DRAIN) { E(acc, cur, wr, wc, fr, fq); S.done(cur); }
        if (!has_next) break;
#pragma unroll
        for (int a = 0; a < 2; ++a)
#pragma unroll
            for (int b = 0; b < 2; ++b)
#pragma unroll
                for (int m = 0; m < 4; ++m)
#pragma unroll
                    for (int n = 0; n < 2; ++n) acc[a][b][m][n] = (f32x4){0.f, 0.f, 0.f, 0.f};
        cur = nxt; cA = nA; cB = nB; ++ui;
        if constexpr (ALIGN_EPI) { if (wr == 1) PG8_BAR; }
    }
    PG8_WAIT_V(0);
    if constexpr (!ALIGN_EPI) { if (wr == 0) PG8_BAR; }
    PG8_BAR;
    if constexpr (Epi::AFTER_DRAIN) { E.fused(acc, cur, wr, wc, fr, fq, lds, wid, lane); S.done(cur); }
#undef PG8_SA
#undef PG8_SB
#undef PG8_STAGE
#undef PG8_LDA
#undef PG8_LDB
#undef PG8_MMA
#undef PG8_WAIT_V
#undef PG8_WAIT_L
#undef PG8_BAR
#undef PG8_SCHED
}
}
namespace pg8 {
#define PG8_GAS __attribute__((address_space(1)))
constexpr float RMS_EPS = 1e-6f;
typedef unsigned long long stat_t;
typedef unsigned long long u64x2 __attribute__((ext_vector_type(2)));
constexpr float STAT_SCALE = 1048576.0f;
__device__ __forceinline__ stat_t stat_fix(float ss) { return (stat_t)(ss * STAT_SCALE + 0.5f); }
__device__ __forceinline__ float msq_from(stat_t q) { const float lo = (float)(unsigned)q * (1.0f / (2048.0f * STAT_SCALE)) + RMS_EPS; return (float)(unsigned)(q >> 32) * (4294967296.0f / (2048.0f * STAT_SCALE)) + lo; }
__device__ __forceinline__ float rinv_from(stat_t q) { return __builtin_amdgcn_rsqf(msq_from(q)); }
__device__ __forceinline__ float rinv_of(const stat_t* st, int row) { return rinv_from(st[row]); }
__device__ __forceinline__ float fast_sigmoid(float v) { return __builtin_amdgcn_rcpf(1.0f + __expf(-v)); }
__device__ __forceinline__ float gelu_tanh(float v) { const float y = 1.5957691216f * (v + 0.044715f * v * v * v); return v * fast_sigmoid(y); }
__device__ __forceinline__ u32x4 pack8(const f32x4 a, const f32x4 b) { u32x4 w; w.x = cvt_pk_bf16(a[0], a[1]); w.y = cvt_pk_bf16(a[2], a[3]); w.z = cvt_pk_bf16(b[0], b[1]); w.w = cvt_pk_bf16(b[2], b[3]); return w; }
__device__ __forceinline__ void unpack8(const u32x4 w, f32x4& a, f32x4& b) {
    a[0] = __uint_as_float(w.x << 16); a[1] = __uint_as_float(w.x & 0xffff0000u); a[2] = __uint_as_float(w.y << 16); a[3] = __uint_as_float(w.y & 0xffff0000u);
    b[0] = __uint_as_float(w.z << 16); b[1] = __uint_as_float(w.z & 0xffff0000u); b[2] = __uint_as_float(w.w << 16); b[3] = __uint_as_float(w.w & 0xffff0000u); }
__device__ __forceinline__ float sumsq8(const f32x4 a, const f32x4 b) { return (a[0] * a[0] + a[1] * a[1]) + (a[2] * a[2] + a[3] * a[3]) + (b[0] * b[0] + b[1] * b[1]) + (b[2] * b[2] + b[3] * b[3]); }

struct EpiSwiGLU {
    static constexpr bool PERM = true, AFTER_DRAIN = false;
    bf16_t* H; int ldh; const stat_t* st;
    __device__ __forceinline__ void operator()(const f32x4 (&acc)[2][2][4][2], const Unit& u, int wr, int wc, int fr, int fq) const {
        const int rowu = u.pm * BM + wr * 64; const unsigned lo = (unsigned)(fr * ldh + 8 * fq);
        stat_t q[8];
#pragma unroll
        for (int g = 0; g < 8; ++g) q[g] = ((const PG8_GAS stat_t*)(st + rowu + (g >> 2) * HALF + (g & 3) * 16))[fr];
        asm volatile("" ::: "memory");
#pragma unroll
        for (int ai = 0; ai < 2; ++ai)
#pragma unroll
            for (int m = 0; m < 4; ++m) { const int ru = rowu + ai * HALF + m * 16;
                const float v = msq_from(q[ai * 4 + m]), sn = __builtin_amdgcn_rsqf(v) * -1.4426950408889634f;
                f32x4 h[2];
#pragma unroll
                for (int n = 0; n < 2; ++n) { const f32x4 g = acc[ai][0][m][n], up = acc[ai][1][m][n];
#pragma unroll
                    for (int p = 0; p < 2; ++p) { const f32x2 g2 = (f32x2){g[2 * p], g[2 * p + 1]}, u2 = (f32x2){up[2 * p], up[2 * p + 1]}; const f32x2 a2 = g2 * sn;
                        f32x2 e2; e2.x = __builtin_amdgcn_exp2f(a2.x); e2.y = __builtin_amdgcn_exp2f(a2.y);
                        const f32x2 d2 = e2 * v + v; f32x2 r2; r2.x = __builtin_amdgcn_rcpf(d2.x); r2.y = __builtin_amdgcn_rcpf(d2.y);
                        const f32x2 h2 = (g2 * u2) * r2; h[n][2 * p] = h2.x; h[n][2 * p + 1] = h2.y; } }
                bf16_t* hp = H + (size_t)ru * ldh + u.pn * HALF + wc * 32;
                *(PG8_GAS u32x4*)(hp + lo) = pack8(h[0], h[1]); }
    }
};
template <int MODE> struct EpiRmw {
    static constexpr bool PERM = true, AFTER_DRAIN = false;
    const bf16_t* XB; bf16_t* XN; const stat_t* st; stat_t* stn; float alpha;
    __device__ __forceinline__ void operator()(const f32x4 (&acc)[2][2][4][2], const Unit& u, int wr, int wc, int fr, int fq) const {
        const int rowu = u.pm * BM + wr * 64, colu = u.pn * BM + wc * 32; const unsigned lo = (unsigned)(fr * 2048 + 8 * fq);
        const bf16_t* const xbase = XB + (size_t)rowu * 2048 + colu; bf16_t* const nbase = XN + (size_t)rowu * 2048 + colu;
        u32x4 xv[2][2][2], pv[2][2][2];
        stat_t rq[2][2];
        float ss[8];
#define RMW_LOAD(k, b) do { _Pragma("unroll") for (int q = 0; q < 2; ++q) { const int g = 2 * (k) + q, ro = ((g >> 2) * HALF + (g & 3) * 16) * 2048; \
            if (MODE == 1) rq[b][q] = ((const PG8_GAS stat_t*)(st + rowu + (g >> 2) * HALF + (g & 3) * 16))[fr]; \
            _Pragma("unroll") for (int bj = 0; bj < 2; ++bj) { xv[b][q][bj] = *(const PG8_GAS u32x4*)(xbase + ro + lo + bj * HALF); \
                if (MODE == 1) pv[b][q][bj] = *(const PG8_GAS u32x4*)(nbase + ro + lo + bj * HALF); } } } while (0)
        RMW_LOAD(0, 0);
        asm volatile("" ::: "memory");
#pragma unroll
        for (int k = 0; k < 4; ++k) { const int b = k & 1; u32x4 ov[2][2];
#pragma unroll
            for (int q = 0; q < 2; ++q) { const int g = 2 * k + q, ai = g >> 2, m = g & 3; float s2 = 0.f; const float rsg = (MODE == 1) ? rinv_from(rq[b][q]) : 0.f;
#pragma unroll
                for (int bj = 0; bj < 2; ++bj) { f32x4 x0, x1; unpack8(xv[b][q][bj], x0, x1);
                    if (MODE == 0) { x0 += acc[ai][bj][m][0] * alpha; x1 += acc[ai][bj][m][1] * alpha; }
                    else { f32x4 p0, p1; unpack8(pv[b][q][bj], p0, p1);
#pragma unroll
                        for (int j = 0; j < 4; ++j) { x0[j] += alpha * fast_sigmoid(acc[ai][bj][m][0][j] * rsg) * p0[j]; x1[j] += alpha * fast_sigmoid(acc[ai][bj][m][1][j] * rsg) * p1[j]; } }
                    s2 += sumsq8(x0, x1); ov[q][bj] = pack8(x0, x1); }
                s2 += __shfl_xor(s2, 16); s2 += __shfl_xor(s2, 32); ss[g] = s2; }
            if (k < 3) { RMW_LOAD(k + 1, b ^ 1); }
            asm volatile("" ::: "memory");
#pragma unroll
            for (int q = 0; q < 2; ++q) { const int g = 2 * k + q, ro = ((g >> 2) * HALF + (g & 3) * 16) * 2048;
#pragma unroll
                for (int bj = 0; bj < 2; ++bj) if (MODE == 0 || alpha != 0.f) *(PG8_GAS u32x4*)(nbase + ro + lo + bj * HALF) = ov[q][bj]; }
            asm volatile("" ::: "memory");
        }
#undef RMW_LOAD
        if (fq == 0) {
#pragma unroll
            for (int g = 0; g < 8; ++g) __hip_atomic_fetch_add((PG8_GAS stat_t*)(stn + rowu + (g >> 2) * HALF + (g & 3) * 16 + fr), stat_fix(ss[g]), __ATOMIC_RELAXED, __HIP_MEMORY_SCOPE_AGENT);
        }
    }
};
template <int MODE> struct EpiRowBf16 {
    static constexpr bool PERM = true, AFTER_DRAIN = false;
    bf16_t* O; int ldc; const stat_t* st;
    __device__ __forceinline__ void operator()(const f32x4 (&acc)[2][2][4][2], const Unit& u, int wr, int wc, int fr, int fq) const {
        const int rowu = u.pm * BM + wr * 64, colu = u.pn * BM + wc * 32; const unsigned lo = (unsigned)(fr * ldc + 8 * fq);
        stat_t q[8];
        if (MODE == 1) {
#pragma unroll
            for (int g = 0; g < 8; ++g) q[g] = ((const PG8_GAS stat_t*)(st + rowu + (g >> 2) * HALF + (g & 3) * 16))[fr];
            asm volatile("" ::: "memory"); }
#pragma unroll
        for (int ai = 0; ai < 2; ++ai)
#pragma unroll
            for (int m = 0; m < 4; ++m) { const int ru = rowu + ai * HALF + m * 16; float s = 1.0f; if (MODE == 1) s = rinv_from(q[ai * 4 + m]);
                bf16_t* op = O + (size_t)ru * ldc + colu;
#pragma unroll
                for (int bj = 0; bj < 2; ++bj) { f32x4 v0 = acc[ai][bj][m][0] * s, v1 = acc[ai][bj][m][1] * s;
                    if (MODE == 1) {
#pragma unroll
                        for (int j = 0; j < 4; ++j) { v0[j] = gelu_tanh(v0[j]); v1[j] = gelu_tanh(v1[j]); } }
                    *(PG8_GAS u32x4*)(op + lo + bj * HALF) = pack8(v0, v1); } }
    }
};
struct EpiOddIn {
    static constexpr bool PERM = true, AFTER_DRAIN = false;
    bf16_t* Z; bf16_t* GB; const stat_t* st;
    __device__ __forceinline__ void operator()(const f32x4 (&acc)[2][2][4][2], const Unit& u, int wr, int wc, int fr, int fq) const {
        const int rowu = u.pm * BM + wr * 64; const unsigned lo = (unsigned)(fr * 2048 + 8 * fq);
        stat_t q[8];
#pragma unroll
        for (int g = 0; g < 8; ++g) q[g] = ((const PG8_GAS stat_t*)(st + rowu + (g >> 2) * HALF + (g & 3) * 16))[fr];
        asm volatile("" ::: "memory");
        if (u.pn < 16) { const int colu = u.pn * HALF + wc * 32;
#pragma unroll
            for (int ai = 0; ai < 2; ++ai)
#pragma unroll
                for (int m = 0; m < 4; ++m) { const int ru = rowu + ai * HALF + m * 16; const float s = rinv_from(q[ai * 4 + m]), s2 = s * s;
                    const f32x4 z0 = acc[ai][0][m][0] * acc[ai][1][m][0] * s2, z1 = acc[ai][0][m][1] * acc[ai][1][m][1] * s2;
                    bf16_t* zp = Z + (size_t)ru * 2048 + colu;
                    *(PG8_GAS u32x4*)(zp + lo) = pack8(z0, z1); }
        } else { const int colu = (u.pn - 16) * BM + wc * 32;
#pragma unroll
            for (int ai = 0; ai < 2; ++ai)
#pragma unroll
                for (int m = 0; m < 4; ++m) { const int ru = rowu + ai * HALF + m * 16; const float s = rinv_from(q[ai * 4 + m]);
                    bf16_t* gp = GB + (size_t)ru * 2048 + colu;
#pragma unroll
                    for (int bj = 0; bj < 2; ++bj) *(PG8_GAS u32x4*)(gp + lo + bj * HALF) = pack8(acc[ai][bj][m][0] * s, acc[ai][bj][m][1] * s); }
        }
    }
};
struct EpiMT {
    static constexpr bool PERM = true, AFTER_DRAIN = false;
    bf16_t* ZTP; bf16_t* ZTS; bf16_t* VT; const stat_t* st; const float* gv;
    __device__ __forceinline__ void operator()(const f32x4 (&acc)[2][2][4][2], const Unit& u, int wr, int wc, int fr, int fq) const {
        const int tu = u.pn * BM + wc * 32;
        f32x4 sc[2][2];
#pragma unroll
        for (int bj = 0; bj < 2; ++bj)
#pragma unroll
            for (int n = 0; n < 2; ++n) { const stat_t* sp = (st + tu + bj * HALF + 4 * n) + 8 * fq; const u64x2 a = *(const PG8_GAS u64x2*)sp, b = *(const PG8_GAS u64x2*)(sp + 2);
                sc[bj][n][0] = rinv_from(a[0]); sc[bj][n][1] = rinv_from(a[1]); sc[bj][n][2] = rinv_from(b[0]); sc[bj][n][3] = rinv_from(b[1]); }
        const int chu = u.pm * BM + wr * 64;
        if (u.pm < 4) {
            bf16_t* base; int S2;
            if (u.pn < 128) { const int tt = u.pn * BM; base = ZTP + (size_t)(tt >> 11) * (1024 * 2048) + (tt & 2047) + wc * 32; S2 = 2048; }
            else { base = ZTS + (u.pn - 128) * BM + wc * 32; S2 = 8192; }
            const unsigned lo = (unsigned)(fr * S2 + 8 * fq);
#pragma unroll
            for (int ai = 0; ai < 2; ++ai)
#pragma unroll
                for (int m = 0; m < 4; ++m) { bf16_t* rp = base + (size_t)(chu + ai * HALF + m * 16) * S2;
#pragma unroll
                    for (int bj = 0; bj < 2; ++bj) *(PG8_GAS u32x4*)(rp + lo + bj * HALF) = pack8(acc[ai][bj][m][0] * sc[bj][0], acc[ai][bj][m][1] * sc[bj][1]); }
        } else {
            const unsigned lo = (unsigned)(fr * 40960 + 8 * fq);
#pragma unroll
            for (int ai = 0; ai < 2; ++ai) {
                f32x4 q[2][2];
#pragma unroll
                for (int bj = 0; bj < 2; ++bj)
#pragma unroll
                    for (int n = 0; n < 2; ++n) { q[bj][n] = (f32x4){0.f, 0.f, 0.f, 0.f};
#pragma unroll
                        for (int m = 0; m < 4; ++m) { const f32x4 v = acc[ai][bj][m][n] * sc[bj][n];
#pragma unroll
                            for (int j = 0; j < 4; ++j) { const float y = gelu_tanh(v[j]); q[bj][n][j] += y * y; } } }
#pragma unroll
                for (int bj = 0; bj < 2; ++bj)
#pragma unroll
                    for (int n = 0; n < 2; ++n)
#pragma unroll
                        for (int j = 0; j < 4; ++j) { float s = q[bj][n][j]; s += __shfl_xor(s, 1); s += __shfl_xor(s, 2); s += __shfl_xor(s, 4); s += __shfl_xor(s, 8);
                            q[bj][n][j] = __builtin_amdgcn_rsqf(s * (1.0f / 64.0f) + RMS_EPS); }
#pragma unroll
                for (int m = 0; m < 4; ++m) { const int cu = chu - 1024 + ai * HALF + m * 16; const float gg = ((const PG8_GAS float*)(gv + cu))[fr]; bf16_t* vp = VT + (size_t)cu * 40960 + tu;
#pragma unroll
                    for (int bj = 0; bj < 2; ++bj) { f32x4 y0 = acc[ai][bj][m][0] * sc[bj][0], y1 = acc[ai][bj][m][1] * sc[bj][1];
#pragma unroll
                        for (int j = 0; j < 4; ++j) { y0[j] = gelu_tanh(y0[j]); y1[j] = gelu_tanh(y1[j]); }
                        *(PG8_GAS u32x4*)(vp + lo + bj * HALF) = pack8(y0 * q[bj][0] * gg, y1 * q[bj][1] * gg); } }
            }
        }
    }
};
struct EpiDFT {
    static constexpr bool PERM = true, AFTER_DRAIN = false;
    bf16_t* Y; int row_base, S; float scale, msign; int col_lo, col_hi;
    __device__ __forceinline__ void operator()(const f32x4 (&acc)[2][2][4][2], const Unit& u, int wr, int wc, int fr, int fq) const {
        const int ku = u.pm * BM + wr * 64, rb = row_base + (u.pn >> 2) * S, colu = (u.pn & 3) * BM + wc * 32;
        const int lo = fr * 2048 + 8 * fq, lom = -fr * 2048 + 8 * fq; const float ms = scale * msign;
#pragma unroll
        for (int bj = 0; bj < 2; ++bj) { const int col = colu + bj * HALF + 8 * fq; if (col >= col_lo && col < col_hi) {
#pragma unroll
            for (int ai = 0; ai < 2; ++ai)
#pragma unroll
                for (int m = 0; m < 4; ++m) { const int k0 = ku + ai * HALF + m * 16;
                    bf16_t* yp = Y + (size_t)(rb + k0) * 2048 + colu + bj * HALF; bf16_t* ym = Y + (size_t)(rb + S - k0) * 2048 + colu + bj * HALF;
                    *(PG8_GAS u32x4*)(yp + lo) = pack8(acc[ai][bj][m][0] * scale, acc[ai][bj][m][1] * scale);
                    if (k0 + fr != 0) *(PG8_GAS u32x4*)(ym + lom) = pack8(acc[ai][bj][m][0] * ms, acc[ai][bj][m][1] * ms); } } }
    }
};
struct EpiNull {
    static constexpr bool PERM = true, AFTER_DRAIN = false;
    float* sink;
    __device__ __forceinline__ void operator()(const f32x4 (&acc)[2][2][4][2], const Unit& u, int wr, int wc, int fr, int fq) const {
        float s = 0.f;
#pragma unroll
        for (int ai = 0; ai < 2; ++ai)
#pragma unroll
            for (int bj = 0; bj < 2; ++bj)
#pragma unroll
                for (int m = 0; m < 4; ++m)
#pragma unroll
                    for (int n = 0; n < 2; ++n) s += acc[ai][bj][m][n][0] + acc[ai][bj][m][n][1] + acc[ai][bj][m][n][2] + acc[ai][bj][m][n][3];
        if (s == 1.2345e-30f) sink[u.pm + fr] = s;
    }
};
}
#ifndef MK_N_LAUNCHES
#define MK_N_LAUNCHES 1
#endif
constexpr int NPHASE = 34;
constexpr int T = 40960, TP = 32768, DM = 2048, DFF = 5632, NLAYER = 4;
typedef unsigned short bf16;
#define GAS __attribute__((address_space(1)))
#define LAS __attribute__((address_space(3)))
typedef unsigned v4u __attribute__((ext_vector_type(4)));
typedef unsigned v2u __attribute__((ext_vector_type(2)));
typedef float f32x4 __attribute__((ext_vector_type(4)));
typedef short bf16x8 __attribute__((ext_vector_type(8)));
typedef GAS unsigned gu32;

constexpr size_t MiB = 1u << 20;
constexpr size_t WS_CTL = 0, CTL_BYTES = 6 * MiB;
constexpr int CW_BAR = 4096;
constexpr size_t WS_STATS = 65536;
constexpr size_t WS_W = 6 * MiB;
constexpr size_t SZ_FIN = (size_t)2 * DFF * DM * 2, SZ_FOUT = (size_t)DM * DFF * 2, SZ_SQ = (size_t)DM * DM * 2, SZ_WP = (size_t)DM * 256 * 2;
constexpr size_t WL_F1IN = 0, WL_F1OUT = SZ_FIN, WL_F2IN = SZ_FIN + SZ_FOUT, WL_F2OUT = 2 * SZ_FIN + SZ_FOUT, WL_WG = 2 * SZ_FIN + 2 * SZ_FOUT, WL_WP = WL_WG + SZ_SQ, WL_SIZE = WL_WP + SZ_WP;
constexpr size_t WS_WE = WS_W + NLAYER * WL_SIZE;
constexpr size_t WE_WZ = 0, WE_WU = (size_t)3072 * DM * 2, WE_WO = WE_WU + (size_t)1024 * DM * 2, WE_WS = WE_WO + SZ_SQ, WE_SIZE = WE_WS + (size_t)16 * 128 * 128 * 2;
constexpr size_t WS_WOD = WS_WE + 2 * WE_SIZE;
constexpr size_t WO_WC = 0, WO_WOC = (size_t)6144 * DM * 2, WO_SIZE = WO_WOC + SZ_SQ;
constexpr size_t WS_DP = WS_WOD + 2 * WO_SIZE, SZ_DP = (size_t)2 * 1024 * 2048 * 2;
constexpr size_t WS_DS = WS_DP + SZ_DP, SZ_DS = (size_t)2 * 4096 * 8192 * 2;
constexpr size_t WS_XB0 = WS_DS + SZ_DS, SZ_XB = (size_t)T * DM * 2;
constexpr size_t WS_XB1 = WS_XB0 + SZ_XB;
constexpr size_t WS_H = WS_XB1 + SZ_XB, SZ_H = (size_t)T * DFF * 2;
constexpr size_t WS_ZTP = WS_H, WS_ZTS = WS_ZTP + (size_t)16 * 1024 * 2048 * 2, WS_VT = WS_ZTS + (size_t)1024 * 8192 * 2, WS_U = WS_VT + (size_t)1024 * T * 2;
constexpr size_t WS_Z = WS_H, WS_GB = WS_H + SZ_XB;
constexpr size_t WS_PB = WS_H + SZ_H, SZ_PB = (size_t)NLAYER * T * 256 * 2;
constexpr size_t WS_END = WS_PB + SZ_PB;
static_assert(WS_U + (size_t)T * 1024 * 2 <= WS_H + SZ_H && WS_GB + SZ_XB <= WS_H + SZ_H, "mixer buffers overlay the FFN hidden buffer");
static_assert(WS_STATS + (size_t)18 * T * 8 <= CTL_BYTES && (CW_BAR + 3456) * 4 <= (int)WS_STATS, "control region");
static_assert(WS_END < 1800000000ull, "d_ws map");

constexpr int LDS_BYTES = 147456;
constexpr int LDSCTL_OFF = 131072;

#define LDS_WAIT() asm volatile("s_waitcnt lgkmcnt(0)" ::: "memory")
__device__ __forceinline__ unsigned f2bf(float f) { unsigned u = __builtin_bit_cast(unsigned, f); return (u + 0x7fffu + ((u >> 16) & 1u)) >> 16; }
__device__ __forceinline__ unsigned pk2(float lo, float hi) { return f2bf(lo) | (f2bf(hi) << 16); }
__device__ __forceinline__ float bflo(unsigned w) { return __uint_as_float(w << 16); }
__device__ __forceinline__ float bfhi(unsigned w) { return __uint_as_float(w & 0xffff0000u); }
__device__ __forceinline__ float wave_sum(float v) {
#pragma unroll
    for (int o = 1; o < 64; o <<= 1) v += __shfl_xor(v, o);
    return v;
}
#define XB_TMO      128
#define XB_XCNT(j)  (256  + 64 * (j))
#define XB_XSUB(j)  (1280 + 64 * (j))
#define XB_XGEN(j)  (2304 + 64 * (j))
#define XB_TOP      3328
#define XB_TOPGEN   3392
#define XCD_BAR_WORDS 3456
#define XB_SPIN_CAP (1u << 18)

__device__ __forceinline__ unsigned xb_ld(unsigned* p)              { return __hip_atomic_load(p, __ATOMIC_RELAXED, __HIP_MEMORY_SCOPE_AGENT); }
__device__ __forceinline__ unsigned xb_add(unsigned* p, unsigned v) { return __hip_atomic_fetch_add(p, v, __ATOMIC_RELAXED, __HIP_MEMORY_SCOPE_AGENT); }
__device__ __forceinline__ unsigned xb_xcc_id() { return (unsigned)__builtin_amdgcn_s_getreg((3 << 11) | 20) & 0xFu; }
#define XB_SPIN(cond, bar) do { unsigned _sp = 0; while (cond) { __builtin_amdgcn_s_sleep(1); \
    if ((++_sp & 255u) == 0u) { if (xb_ld(&(bar)[XB_TMO])) break; if (_sp > XB_SPIN_CAP) { atomicAdd(&(bar)[XB_TMO], 1u); break; } } } } while (0)

struct XcdBarrier {
    unsigned* bar; unsigned x;
    volatile LAS unsigned* st;
};

__device__ __forceinline__ XcdBarrier xcd_barrier_post(unsigned* bar, volatile LAS unsigned* st) {
    XcdBarrier b; b.bar = bar; b.x = xb_xcc_id(); b.st = st;
    if (threadIdx.x == 0) (void)xb_add(&bar[XB_XCNT(b.x)], 1u);
    return b;
}
__device__ __forceinline__ void xcd_barrier_complete(unsigned* bar, unsigned x, unsigned& nloc, unsigned& nx) {
    const unsigned G = gridDim.x * gridDim.y * gridDim.z;
    unsigned sum, cnt, mine, sp = 0u;
    for (;;) {
        sum = 0u; cnt = 0u; mine = 0u;
#pragma unroll
        for (unsigned j = 0; j < 16; ++j) { const unsigned c = xb_ld(&bar[XB_XCNT(j)]); sum += c; cnt += (c > 0u) ? 1u : 0u; mine = (j == x) ? c : mine; }
        if (sum == G) break;
        __builtin_amdgcn_s_sleep(1);
        if ((++sp & 255u) == 0u) { if (xb_ld(&bar[XB_TMO])) break; if (sp > XB_SPIN_CAP) { atomicAdd(&bar[XB_TMO], 1u); break; } }
    }
    nloc = mine > 0u ? mine : 1u; nx = cnt > 0u ? cnt : 1u;
}

__device__ __forceinline__ void xcd_barrier(const XcdBarrier& b) {
    asm volatile("s_waitcnt vmcnt(0)" ::: "memory");
    __syncthreads();
    if (threadIdx.x == 0) {
        unsigned* bar = b.bar;
        __builtin_amdgcn_s_waitcnt(0);
        unsigned nloc = b.st[0], nx = b.st[1];
        if (nloc == 0u) { xcd_barrier_complete(bar, b.x, nloc, nx); b.st[0] = nloc; b.st[1] = nx; }
        const unsigned old = xb_add(&bar[XB_XSUB(b.x)], 1u);
        const unsigned gen = old / nloc;
        if (old + 1u == (gen + 1u) * nloc) {
            __builtin_amdgcn_fence(__ATOMIC_RELEASE, "agent");
            asm volatile("s_waitcnt vmcnt(0)" ::: "memory");
            const unsigned og = xb_add(&bar[XB_TOP], 1u);
            const unsigned tg = og / nx;
            if (og + 1u == (tg + 1u) * nx) xb_add(&bar[XB_TOPGEN], 1u);
            else XB_SPIN(xb_ld(&bar[XB_TOPGEN]) == tg, bar);
            __builtin_amdgcn_fence(__ATOMIC_ACQUIRE, "agent");
            xb_add(&bar[XB_XGEN(b.x)], 1u);
            asm volatile("s_waitcnt vmcnt(0)" ::: "memory");
        } else {
            XB_SPIN(xb_ld(&bar[XB_XGEN(b.x)]) == gen, bar);
            __builtin_amdgcn_fence(__ATOMIC_ACQUIRE, "agent");
            asm volatile("s_waitcnt vmcnt(0)" ::: "memory");
        }
    }
    __syncthreads();
}
__device__ __forceinline__ void tr_item(const float* W, int ldw, int K, const float* g, bf16* WT, int dst_row0, LAS float* scr, int k0, int n0, int lane) {
    {
        f32x4 v[8]; const int kr = lane >> 3, n4 = (lane & 7) * 4;
#pragma unroll
        for (int i = 0; i < 8; ++i) v[i] = *(const GAS f32x4*)(W + (size_t)(k0 + 8 * i + kr) * ldw + n0 + n4);
        if (g) {
#pragma unroll
            for (int i = 0; i < 8; ++i) v[i] = v[i] * g[k0 + 8 * i + kr]; }
#pragma unroll
        for (int i = 0; i < 8; ++i) { LAS float* d = scr + (8 * i + kr) * 33 + n4; d[0] = v[i][0]; d[1] = v[i][1]; d[2] = v[i][2]; d[3] = v[i][3]; }
    }
    LDS_WAIT(); asm volatile("" ::: "memory");
    const int c = lane & 7;
#pragma unroll
    for (int j = 0; j < 4; ++j) { const int n = (lane >> 3) + 8 * j; const LAS float* s = scr + (8 * c) * 33 + n;
        v4u o; o.x = pk2(s[0 * 33], s[1 * 33]); o.y = pk2(s[2 * 33], s[3 * 33]); o.z = pk2(s[4 * 33], s[5 * 33]); o.w = pk2(s[6 * 33], s[7 * 33]);
        *(GAS v4u*)(WT + (size_t)(dst_row0 + n) * K + k0 + 8 * c) = o; }
    LDS_WAIT(); asm volatile("" ::: "memory");
}
__device__ __forceinline__ void hc_rows(int kd, int& r1, int& r2, float& c2) {
    if (kd < 528) { const int h = kd / 33, cp = kd - 33 * h; r1 = 64 * h + cp; if (cp == 0 || cp == 32) { r2 = r1; c2 = 0.f; } else { r2 = 64 * h + 64 - cp; c2 = 1.f; } }
    else { const int q = kd - 528, h = q / 31, cp = 1 + q - 31 * h; r1 = 64 * h + 64 - cp; r2 = 64 * h + cp; c2 = -1.f; }
}
__device__ __forceinline__ void tr_item_wofold(const float* W, bf16* WT, LAS float* scr, int k0, int n0, int lane) {
    {   f32x4 v[8], w[8]; float cc[8]; const int kr = lane >> 3, n4 = (lane & 7) * 4;
#pragma unroll
        for (int i = 0; i < 8; ++i) { int r1, r2; hc_rows(k0 + 8 * i + kr, r1, r2, cc[i]); v[i] = *(const GAS f32x4*)(W + (size_t)r1 * DM + n0 + n4); w[i] = *(const GAS f32x4*)(W + (size_t)r2 * DM + n0 + n4); }
#pragma unroll
        for (int i = 0; i < 8; ++i) { const f32x4 t = v[i] + w[i] * cc[i]; LAS float* d = scr + (8 * i + kr) * 33 + n4; d[0] = t[0]; d[1] = t[1]; d[2] = t[2]; d[3] = t[3]; }
    }
    LDS_WAIT(); asm volatile("" ::: "memory");
    const int c = lane & 7;
#pragma unroll
    for (int j = 0; j < 4; ++j) { const int n = (lane >> 3) + 8 * j; const LAS float* s = scr + (8 * c) * 33 + n;
        v4u o; o.x = pk2(s[0 * 33], s[1 * 33]); o.y = pk2(s[2 * 33], s[3 * 33]); o.z = pk2(s[4 * 33], s[5 * 33]); o.w = pk2(s[6 * 33], s[7 * 33]);
        *(GAS v4u*)(WT + (size_t)(n0 + n) * DM + k0 + 8 * c) = o; }
    LDS_WAIT(); asm volatile("" ::: "memory");
}
__device__ __forceinline__ int map_id(int n) { return n; }
__device__ __forceinline__ int map_glu(int n) { return n < DFF ? 256 * (n >> 7) + (n & 127) : 256 * ((n - DFF) >> 7) + 128 + ((n - DFF) & 127); }
__device__ __forceinline__ int map_oddin(int n) { return n < 2048 ? 4096 + n : (n < 4096 ? 256 * ((n - 2048) >> 7) + ((n - 2048) & 127) : 256 * ((n - 4096) >> 7) + 128 + ((n - 4096) & 127)); }

struct Args { const float* in[24]; float* out; unsigned char* ws; int ph_lo, ph_hi; };

__device__ __forceinline__ void p0_prologue(const Args& a, LAS unsigned char* lds, int vcu, int G, int wave, int lane, int tid) {
    unsigned char* ws = a.ws;
    LAS float* scr = (LAS float*)(lds + wave * 16384);
    const int gw = vcu * 8 + wave, NGW = G * 8;
    constexpr int I_FIN = (DM / 64) * (2 * DFF / 32), I_FOUT = (DFF / 64) * (DM / 32), I_SQ = (DM / 64) * (DM / 32), I_WP = (256 / 64) * (DM / 32);
    constexpr int I_L = 2 * I_FIN + 2 * I_FOUT + I_SQ + I_WP;
    constexpr int I_EIN = (DM / 64) * (2048 / 32), I_E = I_EIN + I_SQ;
    constexpr int I_OIN = (DM / 64) * (6144 / 32), I_O = I_OIN + I_SQ;
    constexpr int NITEMS = NLAYER * I_L + 2 * I_E + 2 * I_O;
#define TR_JOB(CNT_, W_, LDW_, K_, NCOLS_, G_, WT_, MAP_) { if (r < (CNT_)) { const int nblk = (NCOLS_) / 32, kb = r / nblk, n0 = (r % nblk) * 32; tr_item(W_, LDW_, K_, G_, WT_, MAP_(n0), scr, kb * 64, n0, lane); continue; } r -= (CNT_); }
    for (int it = gw; it < NITEMS; it += NGW) {
        int r = it;
        if (r < NLAYER * I_L) { const int L = r / I_L; r -= L * I_L; unsigned char* wl = ws + WS_W + (size_t)L * WL_SIZE;
            TR_JOB(I_FIN, a.in[5] + (size_t)L * DM * 2 * DFF, 2 * DFF, DM, 2 * DFF, a.in[4] + L * DM, (bf16*)(wl + WL_F1IN), map_glu)
            TR_JOB(I_FOUT, a.in[6] + (size_t)L * DFF * DM, DM, DFF, DM, (const float*)nullptr, (bf16*)(wl + WL_F1OUT), map_id)
            TR_JOB(I_FIN, a.in[18] + (size_t)L * DM * 2 * DFF, 2 * DFF, DM, 2 * DFF, a.in[17] + L * DM, (bf16*)(wl + WL_F2IN), map_glu)
            TR_JOB(I_FOUT, a.in[19] + (size_t)L * DFF * DM, DM, DFF, DM, (const float*)nullptr, (bf16*)(wl + WL_F2OUT), map_id)
            TR_JOB(I_SQ, a.in[21] + (size_t)L * DM * DM, DM, DM, DM, a.in[20] + L * DM, (bf16*)(wl + WL_WG), map_id)
            TR_JOB(I_WP, a.in[22] + (size_t)L * 256 * DM, DM, 256, DM, (const float*)nullptr, (bf16*)(wl + WL_WP), map_id)
            continue; }
        r -= NLAYER * I_L;
        if (r < 2 * I_E) { const int j = r / I_E; r -= j * I_E; unsigned char* we = ws + WS_WE + (size_t)j * WE_SIZE; const float* gm = a.in[7] + (2 * j) * DM;
            if (r < I_EIN) { const int nblk = 2048 / 32, kb = r / nblk, n0 = (r % nblk) * 32; const float* W = a.in[8] + (size_t)j * DM * 3072 + 1024;
                if (n0 < 1024) tr_item(W, 3072, DM, gm, (bf16*)(we + WE_WU), n0, scr, kb * 64, n0, lane);
                else tr_item(W, 3072, DM, gm, (bf16*)(we + WE_WZ), 1024 + (n0 - 1024), scr, kb * 64, n0, lane);
                continue; }
            r -= I_EIN;
            { const int nblk = DM / 32, kb = r / nblk, n0 = (r % nblk) * 32; const float* W = a.in[12] + (size_t)j * DM * DM;
              if (kb < 16) tr_item_wofold(W, (bf16*)(we + WE_WO), scr, kb * 64, n0, lane); else tr_item(W, DM, DM, (const float*)nullptr, (bf16*)(we + WE_WO), n0, scr, kb * 64, n0, lane); }
            continue; }
        r -= 2 * I_E;
        { const int j = r / I_O; r -= j * I_O; unsigned char* wo = ws + WS_WOD + (size_t)j * WO_SIZE;
            TR_JOB(I_OIN, a.in[13] + (size_t)j * DM * 6144, 6144, DM, 6144, a.in[7] + (2 * j + 1) * DM, (bf16*)(wo + WO_WC), map_oddin)
            TR_JOB(I_SQ, a.in[16] + (size_t)j * DM * DM, DM, DM, DM, (const float*)nullptr, (bf16*)(wo + WO_WOC), map_id)
        }
    }
#undef TR_JOB
    {   LAS float* tab = scr + 2200;
        tab[lane] = cospif((float)lane * (1.0f / 32.0f));
        LDS_WAIT(); asm volatile("" ::: "memory");
        const bool isq = lane >= 33; const int cp = isq ? lane - 32 : lane, toff = isq ? 48 : 0;
        for (int it = gw; it < 2 * 64 * 16; it += NGW) { const int j = it >> 10, kb = (it >> 4) & 63, h = it & 15; const int k0 = kb * 32;
            const float* W = a.in[8] + (size_t)j * DM * 3072 + h * 64; const float* gm = a.in[7] + (2 * j) * DM; bf16* WZ = (bf16*)(ws + WS_WE + (size_t)j * WE_SIZE + WE_WZ);
            const int zr = isq ? 528 + h * 31 + (lane - 33) : h * 33 + lane;
            for (int kq = 0; kq < 4; ++kq) {
                float ac[8];
#pragma unroll
                for (int q = 0; q < 8; ++q) ac[q] = 0.f;
                for (int cc = 0; cc < 64; ++cc) { const float tv = tab[((cc * cp) + toff) & 63];
#pragma unroll
                    for (int q = 0; q < 8; ++q) ac[q] += W[(size_t)(k0 + kq * 8 + q) * 3072 + cc] * tv; }
#pragma unroll
                for (int q = 0; q < 8; ++q) ac[q] *= gm[k0 + kq * 8 + q];
                v4u oc; oc.x = pk2(ac[0], ac[1]); oc.y = pk2(ac[2], ac[3]); oc.z = pk2(ac[4], ac[5]); oc.w = pk2(ac[6], ac[7]);
                *(GAS v4u*)(WZ + (size_t)zr * DM + k0 + kq * 8) = oc; }
        }
        LDS_WAIT(); asm volatile("" ::: "memory");
    }
    const size_t gt = (size_t)vcu * 512 + tid, NGT = (size_t)G * 512;
    for (size_t e = gt; e < (size_t)2 * 16 * 128 * 128 / 8; e += NGT) { const size_t j = e / (16 * 128 * 128 / 8), rem = e % (16 * 128 * 128 / 8);
        const f32x4 v0 = *(const GAS f32x4*)(a.in[10] + e * 8), v1 = *(const GAS f32x4*)(a.in[10] + e * 8 + 4);
        v4u o; o.x = pk2(v0[0], v0[1]); o.y = pk2(v0[2], v0[3]); o.z = pk2(v1[0], v1[1]); o.w = pk2(v1[2], v1[3]);
        *(GAS v4u*)((bf16*)(ws + WS_WE + j * WE_SIZE + WE_WS) + rem * 8) = o; }
#pragma unroll 1
    for (int which = 0; which < 2; ++which) { const int S = which ? 8192 : 2048, lg = which ? 13 : 11; bf16* Dm = (bf16*)(ws + (which ? WS_DS : WS_DP)); const float sc2 = 2.0f / (float)S;
        const size_t per_row = (size_t)(S / 8), per_mat = (size_t)(S / 2) * per_row, total = 2 * per_mat;
        for (size_t e = gt; e < total; e += NGT) { const bool sn = e >= per_mat; const size_t e2 = sn ? e - per_mat : e; const int k = (int)(e2 >> (lg - 3)), s0 = (int)(e2 & (per_row - 1)) * 8; float v[8];
            if (!sn) {
#pragma unroll
                for (int q = 0; q < 8; ++q) v[q] = cospif((float)((k * (s0 + q)) & (S - 1)) * sc2);
            } else {
#pragma unroll
                for (int q = 0; q < 8; ++q) v[q] = sinpif((float)((k * (s0 + q)) & (S - 1)) * sc2);
            }
            v4u o; o.x = pk2(v[0], v[1]); o.y = pk2(v[2], v[3]); o.z = pk2(v[4], v[5]); o.w = pk2(v[6], v[7]);
            *(GAS v4u*)(Dm + e * 8) = o; } }
    { pg8::stat_t* st0 = (pg8::stat_t*)(ws + WS_STATS); bf16* xb0 = (bf16*)(ws + WS_XB0);
        for (int row = gw; row < T; row += NGW) { const float* src = row < TP ? a.in[0] + (size_t)row * DM : a.in[1] + (size_t)(row - TP) * DM;
            const GAS f32x4* xr = (const GAS f32x4*)src + lane; f32x4 v[8]; float s = 0.f;
#pragma unroll
            for (int j = 0; j < 8; ++j) { v[j] = xr[64 * j]; s += (v[j][0] * v[j][0] + v[j][1] * v[j][1]) + (v[j][2] * v[j][2] + v[j][3] * v[j][3]); }
            s = wave_sum(s); if (lane == 0) st0[row] = pg8::stat_fix(s);
            GAS v2u* brow = (GAS v2u*)(xb0 + (size_t)row * DM) + lane;
#pragma unroll
            for (int j = 0; j < 8; ++j) { v2u w; w.x = pk2(v[j][0], v[j][1]); w.y = pk2(v[j][2], v[j][3]); brow[64 * j] = w; } } }
    { bf16* pb = (bf16*)(ws + WS_PB);
        for (size_t e = gt; e < (size_t)NLAYER * T * 256 / 8; e += NGT) { const size_t L = e / ((size_t)T * 32), rem = e % ((size_t)T * 32), row = rem >> 5, c8 = rem & 31;
            const float* src = row < (size_t)TP ? a.in[2] + ((size_t)L * TP + row) * 256 + c8 * 8 : a.in[3] + ((size_t)L * 8192 + (row - TP)) * 256 + c8 * 8;
            const f32x4 v0 = *(const GAS f32x4*)src, v1 = *(const GAS f32x4*)(src + 4);
            v4u o; o.x = pk2(v0[0], v0[1]); o.y = pk2(v0[2], v0[3]); o.z = pk2(v1[0], v1[1]); o.w = pk2(v1[2], v1[3]);
            *(GAS v4u*)(pb + e * 8) = o; } }
}

__device__ __forceinline__ void sgu_phase(const bf16* Wsb, const float* bs, const bf16* VT, const bf16* U, bf16* Y, int idx, int n) {
    int tid_o = threadIdx.x; asm volatile("" : "+v"(tid_o)); const int lane = tid_o & 63, wave = __builtin_amdgcn_readfirstlane(tid_o >> 6);
    const int h = idx & 15, q = idx >> 4, nq = n >> 4, ct = wave & 3, th = wave >> 2, fr = lane & 15, fq = lane >> 4;
    if (idx < 0 || idx >= n || nq == 0) return;
    bf16x8 wf[4][4];
#pragma unroll
    for (int tt = 0; tt < 4; ++tt)
#pragma unroll
        for (int ks = 0; ks < 4; ++ks) wf[tt][ks] = *(const GAS bf16x8*)(Wsb + ((size_t)h * 128 + th * 64 + tt * 16 + fr) * 128 + ks * 32 + fq * 8);
    float bias[4];
#pragma unroll
    for (int tt = 0; tt < 4; ++tt) bias[tt] = bs[h * 128 + th * 64 + tt * 16 + fr];
    for (int ch = q; ch < T / 128; ch += nq) {
        bf16x8 vf[4];
#pragma unroll
        for (int ks = 0; ks < 4; ++ks) vf[ks] = *(const GAS bf16x8*)(VT + (size_t)(h * 64 + ct * 16 + fr) * T + (size_t)ch * 128 + ks * 32 + fq * 8);
#pragma unroll
        for (int tt = 0; tt < 4; ++tt) { f32x4 acc = (f32x4){0.f, 0.f, 0.f, 0.f};
#pragma unroll
            for (int ks = 0; ks < 4; ++ks) acc = __builtin_amdgcn_mfma_f32_16x16x32_bf16(vf[ks], wf[tt][ks], acc, 0, 0, 0);
            const size_t t = (size_t)ch * 128 + th * 64 + tt * 16 + fr; const int c = h * 64 + ct * 16 + fq * 4;
            const v2u uu = *(const GAS v2u*)(U + t * 1024 + c);
            v2u o; o.x = pk2(bflo(uu.x) * (acc[0] + bias[tt]), bfhi(uu.x) * (acc[1] + bias[tt])); o.y = pk2(bflo(uu.y) * (acc[2] + bias[tt]), bfhi(uu.y) * (acc[3] + bias[tt]));
            *(GAS v2u*)(Y + t * 2048 + 1024 + c) = o; }
    }
}
__device__ __forceinline__ void conv_phase(const bf16* Z, const bf16* GB, const float* wc, const float* bc, bf16* Y, int vcu, int G) {
    int tid_o = threadIdx.x; asm volatile("" : "+v"(tid_o)); const size_t gt = (size_t)vcu * 512 + tid_o, NGT = (size_t)G * 512;
    for (size_t e = gt; e < (size_t)T * 256; e += NGT) { const int t = (int)(e >> 8), c0 = (int)(e & 255) * 8;
        const int sp = t < TP ? (t & 2047) : (t - TP), sl = t < TP ? 2048 : 8192;
        const v4u zc = *(const GAS v4u*)(Z + (size_t)t * 2048 + c0), gb = *(const GAS v4u*)(GB + (size_t)t * 2048 + c0);
        v4u zm = (v4u){0u, 0u, 0u, 0u}, zp = (v4u){0u, 0u, 0u, 0u};
        if (sp > 0) zm = *(const GAS v4u*)(Z + (size_t)(t - 1) * 2048 + c0);
        if (sp < sl - 1) zp = *(const GAS v4u*)(Z + (size_t)(t + 1) * 2048 + c0);
        const f32x4 w0a = *(const GAS f32x4*)(wc + c0), w0b = *(const GAS f32x4*)(wc + c0 + 4), w1a = *(const GAS f32x4*)(wc + 2048 + c0), w1b = *(const GAS f32x4*)(wc + 2048 + c0 + 4), w2a = *(const GAS f32x4*)(wc + 4096 + c0), w2b = *(const GAS f32x4*)(wc + 4096 + c0 + 4);
        const f32x4 ba = *(const GAS f32x4*)(bc + c0), bb = *(const GAS f32x4*)(bc + c0 + 4);
        float y[8];
#pragma unroll
        for (int p = 0; p < 4; ++p) { const unsigned m = zm[p], c = zc[p], n = zp[p], g = gb[p]; const int i0 = 2 * p, i1 = 2 * p + 1;
            const float w0l = i0 < 4 ? w0a[i0] : w0b[i0 - 4], w0h = i1 < 4 ? w0a[i1] : w0b[i1 - 4], w1l = i0 < 4 ? w1a[i0] : w1b[i0 - 4], w1h = i1 < 4 ? w1a[i1] : w1b[i1 - 4];
            const float w2l = i0 < 4 ? w2a[i0] : w2b[i0 - 4], w2h = i1 < 4 ? w2a[i1] : w2b[i1 - 4], bl = i0 < 4 ? ba[i0] : bb[i0 - 4], bh = i1 < 4 ? ba[i1] : bb[i1 - 4];
            y[i0] = bflo(g) * (w0l * bflo(m) + w1l * bflo(c) + w2l * bflo(n) + bl);
            y[i1] = bfhi(g) * (w0h * bfhi(m) + w1h * bfhi(c) + w2h * bfhi(n) + bh); }
        v4u o; o.x = pk2(y[0], y[1]); o.y = pk2(y[2], y[3]); o.z = pk2(y[4], y[5]); o.w = pk2(y[6], y[7]);
        *(GAS v4u*)(Y + (size_t)t * 2048 + c0) = o; }
}
__device__ __forceinline__ void final_phase(float* out, const bf16* XBf, const pg8::stat_t* st, const float* gf, int vcu, int G) {
    int tid_o = threadIdx.x; asm volatile("" : "+v"(tid_o)); const int lane = tid_o & 63, gw = vcu * 8 + __builtin_amdgcn_readfirstlane(tid_o >> 6), NGW = G * 8;
    f32x4 g[4][2];
#pragma unroll
    for (int j = 0; j < 4; ++j) { g[j][0] = *(const GAS f32x4*)(gf + 512 * j + 8 * lane); g[j][1] = *(const GAS f32x4*)(gf + 512 * j + 8 * lane + 4); }
    for (int row = gw; row < T; row += NGW) { const float r = pg8::rinv_of(st, row); const bf16* xr = XBf + (size_t)row * DM + 8 * lane; float* orow = out + (size_t)row * DM + 8 * lane;
#pragma unroll
        for (int j = 0; j < 4; ++j) { const v4u w = *(const GAS v4u*)(xr + 512 * j); f32x4 a, b; a[0] = bflo(w.x); a[1] = bfhi(w.x); a[2] = bflo(w.y); a[3] = bfhi(w.y); b[0] = bflo(w.z); b[1] = bfhi(w.z); b[2] = bflo(w.w); b[3] = bfhi(w.w);
            *(GAS f32x4*)(orow + 512 * j) = a * r * g[j][0]; *(GAS f32x4*)(orow + 512 * j + 4) = b * r * g[j][1]; } }
}

__device__ __forceinline__ void dft_mid_rows(const bf16* ZTP, const bf16* ZTS, bf16* Y, int idx, int n) {
    int tid_o = threadIdx.x; asm volatile("" : "+v"(tid_o)); const int lane = tid_o & 63, wave = __builtin_amdgcn_readfirstlane(tid_o >> 6);
    if (idx < 0 || idx >= n) return;
    for (int it = idx * 8 + wave; it < 17 * 529; it += n * 8) { const int b = it / 529, col = it - 529 * b; const int S = b < 16 ? 2048 : 8192; const size_t row = (b < 16 ? (size_t)b * 2048 : (size_t)TP) + S / 2;
        if (col == 528) { unsigned zz = 0u; asm volatile("" : "+v"(zz)); v4u z4; z4.x = zz; z4.y = zz; z4.z = zz; z4.w = zz;
            if (lane < 62) *(GAS v4u*)(Y + row * 2048 + 528 + 8 * lane) = z4; continue; }
        const bf16* z = b < 16 ? ZTP + ((size_t)b * 1024 + col) * 2048 : ZTS + (size_t)col * 8192; float sum = 0.f;
        for (int s0 = lane * 8; s0 < S; s0 += 512) { const v4u w = *(const GAS v4u*)(z + s0);
            sum += (bflo(w.x) - bfhi(w.x)) + (bflo(w.y) - bfhi(w.y)) + (bflo(w.z) - bfhi(w.z)) + (bflo(w.w) - bfhi(w.w)); }
        sum = wave_sum(sum);
        if (lane == 0) Y[row * 2048 + col] = (bf16)f2bf(sum * (b < 16 ? 0.0027621358640099515f : 0.0013810679320049757f)); }
}
struct DftOrder {
    int nM, ntile, tile0, nunits, n, c;
    __device__ void init(int nM_, int ntile_, int tile0_, int nbatch, int lo, int n_, int rot, int bx) { nM = nM_; ntile = ntile_; tile0 = tile0_; nunits = nM_ * ntile_ * nbatch; n = n_; c = (bx >= lo && bx < lo + n_) ? (bx - lo + rot) % n_ : 0x40000000; }
    __device__ bool next(int i, pg8::Unit& u) const { const long L = (long)i * n + c; if (L >= nunits) return false; const int l = (int)L, r = l / nM; u.pm = l - r * nM; u.pn = 4 * (r / ntile) + tile0 + r % ntile; return true; }
    __device__ __forceinline__ void a_ready(const pg8::Unit&) const {}
    __device__ __forceinline__ void done(const pg8::Unit&) const {}
};
struct DirOrder : pg8::StaticOrder {
    bool rev;
    __device__ void init_dir(int M, int N, int G_, int c_, bool rev_) { init(M, N, G_, c_); rev = rev_; }
    __device__ bool next(int i, pg8::Unit& u) const {
        const long L = (long)i * G + c; if (L >= nwg) return false;
        const int q = nwg / pg8::NXCD, r = nwg % pg8::NXCD; int wgid = (int)L; const int xcd = wgid % pg8::NXCD, off = wgid / pg8::NXCD;
        const int len = xcd < r ? q + 1 : q, base = xcd < r ? xcd * (q + 1) : r * (q + 1) + (xcd - r) * q;
        wgid = base + (rev ? len - 1 - off : off);
        const int nig = pg8::WGM * nN, gid = wgid / nig, fm = gid * pg8::WGM, gsz = (nM - fm) < pg8::WGM ? (nM - fm) : pg8::WGM;
        u.pm = fm + ((wgid % nig) % gsz); u.pn = (wgid % nig) / gsz; return true;
    }
};
struct RangeOrder : pg8::StaticOrder {
    __device__ void init_range(int M, int N, int lo, int n, int bx) { const int c_ = (bx >= lo && bx < lo + n) ? bx - lo : 0x40000000; init(M, N, n, c_); }
};

#ifndef MK_SITES
#define MK_SITES 0xFFFFFFFFu
#endif
#define SITE(n) (((MK_SITES) >> (n)) & 1u)
#ifndef MK_DUP
#define MK_DUP 0u
#endif
#define NREP(n) ((((MK_DUP) >> (n)) & 1u) ? 2 : 1)
#define DRY(n) (NREP(n) == 2 && rep == 0)
struct SameTileOrder : pg8::StaticOrder {
    __device__ bool next(int i, pg8::Unit& u) const { const bool r = pg8::StaticOrder::next(i, u); u.pm = 0; u.pn = 0; return r; }
};
#define OPAQUE_WS() unsigned char* wsl = ws; asm volatile("" : "+s"(wsl)); unsigned char* const wl = wsl + WS_W + (size_t)L * WL_SIZE; bf16* const xb = (bf16*)(wsl + ((L & 1) ? WS_XB1 : WS_XB0)); bf16* const xalt = (bf16*)(wsl + ((L & 1) ? WS_XB0 : WS_XB1)); bf16* const Hb = (bf16*)(wsl + WS_H); (void)wl; (void)xb; (void)xalt; (void)Hb
#ifndef MK_DIR
#define MK_DIR 1
#endif
#define PH_REV(k) ((MK_DIR) != 0 && ((k) & 1) != 0)
__global__ void __launch_bounds__(512, 2) mk_fwd(Args args) {
    extern __shared__ __attribute__((aligned(16))) unsigned char lds_raw[];
    LAS unsigned char* lds = (LAS unsigned char*)lds_raw;
    const int tid = threadIdx.x, lane = tid & 63, wave = __builtin_amdgcn_readfirstlane(tid >> 6);
    const int G = gridDim.x, bx = blockIdx.x;
    const int vcu = (G % 8 == 0) ? (bx % 8) * (G / 8) + bx / 8 : bx;
    unsigned char* ws = args.ws;
    volatile LAS unsigned* MISC = (volatile LAS unsigned*)(lds + LDSCTL_OFF);
    for (int u = tid; u < (LDS_BYTES - LDSCTL_OFF) / 4; u += 512) ((LAS unsigned*)(lds + LDSCTL_OFF))[u] = 0u;
    __syncthreads();
    XcdBarrier bar; bar.bar = (unsigned*)(ws + WS_CTL) + CW_BAR; bar.x = 0; bar.st = nullptr;
    if (MK_N_LAUNCHES == 1) bar = xcd_barrier_post((unsigned*)(ws + WS_CTL) + CW_BAR, MISC + 8);
    const int lo = args.ph_lo, hi = args.ph_hi;
#define IN(k) (lo <= (k) && (k) < hi)
#define SEAM(k) do { if (IN(k) && IN((k) + 1)) xcd_barrier(bar); } while (0)
    pg8::stat_t* stats = (pg8::stat_t*)(ws + WS_STATS); pg8::stat_t* st_dummy = stats + (size_t)17 * T;

    if (IN(0) && SITE(0)) for (int rep = 0; rep < NREP(0); ++rep) { p0_prologue(args, lds, vcu, G, wave, lane, tid); }
    SEAM(0);

#pragma unroll 1
    for (int L = 0; L < NLAYER; ++L) {
        const int pb0 = 1 + 8 * L, j = L >> 1; const bool odd = (L & 1) != 0;
        pg8::stat_t* st0 = stats + (size_t)(4 * L + 0) * T; pg8::stat_t* st1 = stats + (size_t)(4 * L + 1) * T; pg8::stat_t* st2 = stats + (size_t)(4 * L + 2) * T; pg8::stat_t* st3 = stats + (size_t)(4 * L + 3) * T; pg8::stat_t* st4 = stats + (size_t)(4 * L + 4) * T;
        { OPAQUE_WS();
#ifdef MK_NULLP
        if (IN(pb0 + 0) && (MK_NULLP & 4)) { pg8::Gemm g{xb, (const bf16*)(wl + WL_F1IN), T, 2 * DFF, DM}; SameTileOrder S; S.init(T, 2 * DFF, G, bx);
            pg8::EpiNull E{(float*)st_dummy}; pg8::gemm_phase<pg8::EpiNull, SameTileOrder, MK_ALIGN, MK_SP2>(lds, g, S, E); }
        if (IN(pb0 + 0) && (MK_NULLP & 1)) { pg8::Gemm g{xb, (const bf16*)(wl + WL_F1IN), T, 2 * DFF, DM}; pg8::StaticOrder S; S.init(T, 2 * DFF, G, bx);
            pg8::EpiNull E{(float*)st_dummy}; pg8::gemm_phase<pg8::EpiNull, pg8::StaticOrder, MK_ALIGN, MK_SP2>(lds, g, S, E); }
        if (IN(pb0 + 1) && (MK_NULLP & 2)) { pg8::Gemm g{(const bf16*)(wsl + WS_H), (const bf16*)(wl + WL_F1OUT), T, DM, DFF}; pg8::StaticOrder S; S.init(T, DM, G, bx);
            pg8::EpiNull E{(float*)st_dummy}; pg8::gemm_phase<pg8::EpiNull, pg8::StaticOrder, MK_ALIGN, MK_SP2>(lds, g, S, E); }
#endif
        if (IN(pb0 + 0) && SITE(1)) for (int rep = 0; rep < NREP(1); ++rep) { pg8::Gemm g{xb, (const bf16*)(wl + WL_F1IN), T, 2 * DFF, DM}; DirOrder S; S.init_dir(T, 2 * DFF, G, bx, PH_REV(0));
            pg8::EpiSwiGLU E{Hb, DFF, st0}; pg8::gemm_phase<pg8::EpiSwiGLU, DirOrder, MK_ALIGN, MK_SP2>(lds, g, S, E); }
        }
        SEAM(pb0 + 0);
        { OPAQUE_WS();
        if (IN(pb0 + 1) && SITE(2)) for (int rep = 0; rep < NREP(2); ++rep) { pg8::Gemm g{Hb, (const bf16*)(wl + WL_F1OUT), T, DM, DFF}; DirOrder S; S.init_dir(T, DM, G, bx, PH_REV(1));
            pg8::EpiRmw<0> E{xb, xb, nullptr, DRY(2) ? st_dummy : st1, DRY(2) ? 0.0f : 0.5f}; pg8::gemm_phase<pg8::EpiRmw<0>, DirOrder, MK_ALIGN, MK_SP2>(lds, g, S, E); }
        }
        SEAM(pb0 + 1);
        { OPAQUE_WS();
        if (IN(pb0 + 2)) {
            if (!odd) { unsigned char* we = wsl + WS_WE + (size_t)j * WE_SIZE;
                if (SITE(3)) for (int rep = 0; rep < NREP(3); ++rep) { pg8::Gemm g{(const bf16*)(we + WE_WZ), xb, 2048, T, DM}; DirOrder S; S.init_dir(2048, T, G, bx, PH_REV(2));
                  pg8::EpiMT E{(bf16*)(wsl + WS_ZTP), (bf16*)(wsl + WS_ZTS), (bf16*)(wsl + WS_VT), st1, args.in[9] + j * 1024};
                  pg8::gemm_phase<pg8::EpiMT, DirOrder, MK_ALIGN, MK_SP2>(lds, g, S, E); }
                if (SITE(4)) for (int rep = 0; rep < NREP(4); ++rep) { pg8::Gemm g{xb, (const bf16*)(we + WE_WU), T, 1024, DM}; DirOrder S; S.init_dir(T, 1024, G, (bx + G / 2) % G, PH_REV(2));
                  pg8::EpiRowBf16<1> E{(bf16*)(wsl + WS_U), 1024, st1}; pg8::gemm_phase<pg8::EpiRowBf16<1>, DirOrder, MK_ALIGN, MK_SP2>(lds, g, S, E); }
            } else if (SITE(5)) for (int rep = 0; rep < NREP(5); ++rep) { unsigned char* wo = wsl + WS_WOD + (size_t)j * WO_SIZE;
                pg8::Gemm g{xb, (const bf16*)(wo + WO_WC), T, 6144, DM}; DirOrder S; S.init_dir(T, 6144, G, bx, PH_REV(2));
                pg8::EpiOddIn E{(bf16*)(wsl + WS_Z), (bf16*)(wsl + WS_GB), st1}; pg8::gemm_phase<pg8::EpiOddIn, DirOrder, MK_ALIGN, MK_SP2>(lds, g, S, E); }
        }
        }
        SEAM(pb0 + 2);
        { OPAQUE_WS();
        if (IN(pb0 + 3)) {
            if (!odd) { unsigned char* we = wsl + WS_WE + (size_t)j * WE_SIZE;
                const bool tuned = (G == 256); const int s_lo = 0, sp_n = tuned ? 48 : G, sq_lo = tuned ? 48 : 0, sq_n = tuned ? 32 : G, p_lo = tuned ? 80 : 0, p_n = tuned ? 176 : G;
                const bf16* dpc = (const bf16*)(wsl + WS_DP); const bf16* dps = dpc + (size_t)1024 * 2048; const bf16* dsc = (const bf16*)(wsl + WS_DS); const bf16* dss = dsc + (size_t)4096 * 8192;
                if (SITE(7)) for (int rep = 0; rep < NREP(7); ++rep) {
                  { pg8::Gemm g{dsc, (const bf16*)(wsl + WS_ZTS), 4096, 1024, 8192}; DftOrder S; S.init(16, 3, 0, 1, s_lo, sp_n, 0, bx);
                    pg8::EpiDFT E{xalt, TP, 8192, 0.0013810679320049757f, 1.0f, 0, 528}; pg8::gemm_phase<pg8::EpiDFT, DftOrder, MK_ALIGN, MK_SP2>(lds, g, S, E); }
                  { pg8::Gemm g{dss, (const bf16*)(wsl + WS_ZTS), 4096, 1024, 8192}; DftOrder S; S.init(16, 2, 2, 1, sq_lo, sq_n, 0, bx);
                    pg8::EpiDFT E{xalt, TP, 8192, 0.0013810679320049757f, -1.0f, 528, 1024}; pg8::gemm_phase<pg8::EpiDFT, DftOrder, MK_ALIGN, MK_SP2>(lds, g, S, E); } }
                if (SITE(6)) for (int rep = 0; rep < NREP(6); ++rep) {
                  { pg8::Gemm g{dpc, (const bf16*)(wsl + WS_ZTP), 1024, 16 * 1024, 2048}; DftOrder S; S.init(4, 3, 0, 16, p_lo, p_n, 0, bx);
                    pg8::EpiDFT E{xalt, 0, 2048, 0.0027621358640099515f, 1.0f, 0, 528}; pg8::gemm_phase<pg8::EpiDFT, DftOrder, MK_ALIGN, MK_SP2>(lds, g, S, E); }
                  { pg8::Gemm g{dps, (const bf16*)(wsl + WS_ZTP), 1024, 16 * 1024, 2048}; DftOrder S; S.init(4, 2, 2, 16, p_lo, p_n, tuned ? 160 : 0, bx);
                    pg8::EpiDFT E{xalt, 0, 2048, 0.0027621358640099515f, -1.0f, 528, 1024}; pg8::gemm_phase<pg8::EpiDFT, DftOrder, MK_ALIGN, MK_SP2>(lds, g, S, E); } }
                dft_mid_rows((const bf16*)(wsl + WS_ZTP), (const bf16*)(wsl + WS_ZTS), xalt, tuned ? bx : bx, tuned ? 80 : G);
                if (SITE(8)) for (int rep = 0; rep < NREP(8); ++rep) sgu_phase((const bf16*)(we + WE_WS), args.in[11] + j * 2048, (const bf16*)(wsl + WS_VT), (const bf16*)(wsl + WS_U), xalt, bx - p_lo, p_n & ~15);
            } else if (SITE(9)) for (int rep = 0; rep < NREP(9); ++rep) {
                conv_phase((const bf16*)(wsl + WS_Z), (const bf16*)(wsl + WS_GB), args.in[14] + j * 3 * 2048, args.in[15] + j * 2048, xalt, vcu, G);
            }
        }
        }
        SEAM(pb0 + 3);
        { OPAQUE_WS();
        if (IN(pb0 + 4) && SITE(10)) for (int rep = 0; rep < NREP(10); ++rep) { const bf16* wout = odd ? (const bf16*)(wsl + WS_WOD + (size_t)j * WO_SIZE + WO_WOC) : (const bf16*)(wsl + WS_WE + (size_t)j * WE_SIZE + WE_WO);
            pg8::Gemm g{xalt, wout, T, DM, DM}; DirOrder S; S.init_dir(T, DM, G, bx, PH_REV(4));
            pg8::EpiRmw<0> E{xb, xb, nullptr, DRY(10) ? st_dummy : st2, DRY(10) ? 0.0f : 1.0f}; pg8::gemm_phase<pg8::EpiRmw<0>, DirOrder, MK_ALIGN, MK_SP2>(lds, g, S, E); }
        }
        SEAM(pb0 + 4);
        { OPAQUE_WS();
        if (IN(pb0 + 5) && SITE(11)) for (int rep = 0; rep < NREP(11); ++rep) { pg8::Gemm g{xb, (const bf16*)(wl + WL_F2IN), T, 2 * DFF, DM}; DirOrder S; S.init_dir(T, 2 * DFF, G, bx, PH_REV(5));
            pg8::EpiSwiGLU E{Hb, DFF, st2}; pg8::gemm_phase<pg8::EpiSwiGLU, DirOrder, MK_ALIGN, MK_SP2>(lds, g, S, E); }
        }
        SEAM(pb0 + 5);
        { OPAQUE_WS();
        if (IN(pb0 + 6)) {
            if (SITE(12)) for (int rep = 0; rep < NREP(12); ++rep) { pg8::Gemm g{Hb, (const bf16*)(wl + WL_F2OUT), T, DM, DFF}; DirOrder S; S.init_dir(T, DM, G, bx, PH_REV(6));
              pg8::EpiRmw<0> E{xb, xb, nullptr, DRY(12) ? st_dummy : st3, DRY(12) ? 0.0f : 0.5f}; pg8::gemm_phase<pg8::EpiRmw<0>, DirOrder, MK_ALIGN, MK_SP2>(lds, g, S, E); }
            if (SITE(13)) for (int rep = 0; rep < NREP(13); ++rep) { int kpe = 256; asm volatile("" : "+s"(kpe));
              pg8::Gemm g{(const bf16*)(wsl + WS_PB) + (size_t)L * T * 256, (const bf16*)(wl + WL_WP), T, DM, kpe}; DirOrder S; S.init_dir(T, DM, G, bx, PH_REV(6));
              pg8::EpiRowBf16<0> E{xalt, 2048, nullptr}; pg8::gemm_phase<pg8::EpiRowBf16<0>, DirOrder, MK_ALIGN, MK_SP2>(lds, g, S, E); }
        }
        }
        SEAM(pb0 + 6);
        { OPAQUE_WS();
        if (IN(pb0 + 7) && SITE(14)) for (int rep = 0; rep < NREP(14); ++rep) { pg8::Gemm g{xb, (const bf16*)(wl + WL_WG), T, DM, DM}; DirOrder S; S.init_dir(T, DM, G, bx, PH_REV(7));
            pg8::EpiRmw<1> E{xb, xalt, st3, DRY(14) ? st_dummy : st4, DRY(14) ? 0.0f : 1.0f}; pg8::gemm_phase<pg8::EpiRmw<1>, DirOrder, MK_ALIGN, MK_SP2>(lds, g, S, E); }
        }
        SEAM(pb0 + 7);
    }
    if (IN(33) && SITE(15)) final_phase(args.out, (const bf16*)(ws + WS_XB0), stats + (size_t)16 * T, args.in[23], vcu, G);
#undef IN
#undef SEAM
}

extern "C" void kernel_launch(void* const* d_in, const int* in_sizes, int n_in, void* d_out, int out_size, void* d_ws, size_t ws_size, hipStream_t stream) {
    static int grid = 0;
    if (grid == 0) {
        if (n_in != 24 || out_size != T * DM || ws_size < WS_END) { fprintf(stderr, "kernel_launch: unexpected sizes (n_in %d, out %d, ws %zu, need %zu); nothing launched\n", n_in, out_size, ws_size, (size_t)WS_END); grid = -1; return; }
        int dev = 0, cus = 0, per_cu = 0;
        if (hipGetDevice(&dev) != hipSuccess || hipDeviceGetAttribute(&cus, hipDeviceAttributeMultiprocessorCount, dev) != hipSuccess) { grid = -1; return; }
        if (hipFuncSetAttribute((const void*)mk_fwd, hipFuncAttributeMaxDynamicSharedMemorySize, LDS_BYTES) != hipSuccess) { fprintf(stderr, "kernel_launch: hipFuncSetAttribute failed\n"); grid = -1; return; }
        if (hipOccupancyMaxActiveBlocksPerMultiprocessor(&per_cu, (const void*)mk_fwd, 512, LDS_BYTES) != hipSuccess || per_cu < 1) fprintf(stderr, "kernel_launch: occupancy query reports %d workgroups per CU\n", per_cu);
        (void)hipGetLastError();
        grid = cus;
    }
    if (grid < 0) return;
#ifdef MK_POISON_WS
    if (hipMemsetAsync((char*)d_ws, 0xFF, WS_END, stream) != hipSuccess) return;
#endif
    if (hipMemsetAsync((char*)d_ws + WS_CTL, 0, CTL_BYTES, stream) != hipSuccess) return;
    Args a{};
    for (int i = 0; i < 24; ++i) a.in[i] = (const float*)d_in[i];
    a.out = (float*)d_out; a.ws = (unsigned char*)d_ws;
    if (MK_N_LAUNCHES == 1) { a.ph_lo = 0; a.ph_hi = NPHASE; hipLaunchKernelGGL(mk_fwd, dim3(grid), dim3(512), LDS_BYTES, stream, a); }
    else for (int p = 0; p < NPHASE; ++p) { a.ph_lo = p; a.ph_hi = p + 1; hipLaunchKernelGGL(mk_fwd, dim3(grid), dim3(512), LDS_BYTES, stream, a); }
}
```

```cpp
#include <hip/hip_runtime.h>
#include <cstdio>
#include <cstdint>
#ifndef MK_WGM
#define MK_WGM 4
#endif
#ifndef MK_SP2
#define MK_SP2 true
#endif
#ifndef MK_ALIGN
#define MK_ALIGN true
#endif
namespace pg8 {
#define PG8_LAS __attribute__((address_space(3)))
typedef unsigned short bf16_t;
typedef short bf16x8 __attribute__((ext_vector_type(8)));
typedef float f32x4 __attribute__((ext_vector_type(4)));
typedef unsigned u32x4 __attribute__((ext_vector_type(4)));
constexpr int BM = 256, BK = 64, HALF = 128, HTB = HALF * BK * 2  , STAGE_BYTES = 8 * HTB, NXCD = 8, WGM = MK_WGM;

__host__ __device__ __forceinline__ int lds_byte(int r, int c) { const int st = (r >> 4) * 2 + (c >> 5), rr = r & 15, cc = c & 31, ob = rr * 64 + cc * 2; return st * 1024 + (ob ^ (((ob >> 9) & 1) << 5)); }
__host__ __device__ __forceinline__ void stage_rc(int b, int& R, int& C) { const int st = b / 1024, sb = b % 1024, swz = sb ^ (((sb >> 9) & 1) << 5); R = (st >> 1) * 16 + swz / 64; C = (st & 1) * 32 + (swz % 64) / 2; }
__host__ __device__ __forceinline__ int perm32(int rho) { const int n = rho >> 4, i = rho & 15; return 8 * (i >> 2) + 4 * n + (i & 3); }

struct Unit { int pm, pn; };
struct Gemm { const bf16_t* A; const bf16_t* Bt; int M, N, K; };

struct StaticOrder {
    int nM, nN, nwg, G, c;
    __host__ __device__ __forceinline__ void init(int M, int N, int G_, int c_) { nM = M / BM; nN = N / BM; nwg = nM * nN; G = G_; c = c_; }
    __host__ __device__ __forceinline__ bool next(int i, Unit& u) const {
        const long L = (long)i * G + c; if (L >= nwg) return false;
        int wgid = (int)L; { const int q = nwg / NXCD, r = nwg % NXCD, xcd = wgid % NXCD, off = wgid / NXCD; wgid = (xcd < r ? xcd * (q + 1) : r * (q + 1) + (xcd - r) * q) + off; }
        const int nig = WGM * nN, gid = wgid / nig, fm = gid * WGM, gsz = (nM - fm) < WGM ? (nM - fm) : WGM;
        u.pm = fm + ((wgid % nig) % gsz); u.pn = (wgid % nig) / gsz; return true;
    }
    __device__ __forceinline__ void a_ready(const Unit&) const {}
    __device__ __forceinline__ void done(const Unit&) const {}
};

__device__ __forceinline__ unsigned cvt_pk_bf16(float lo, float hi) { unsigned r; asm volatile("v_cvt_pk_bf16_f32 %0, %1, %2" : "=v"(r) : "v"(lo), "v"(hi)); return r; }
typedef float f32x2 __attribute__((ext_vector_type(2)));
__device__ __forceinline__ f32x2 gelu_pk(f32x2 v) {
    const f32x2 av = __builtin_elementwise_abs(v), d = av * 0.2316418882f + 1.0f;
    f32x2 t; t.x = __builtin_amdgcn_rcpf(d.x); t.y = __builtin_amdgcn_rcpf(d.y);
    f32x2 q = t * 0.5307027145f + (-0.7265760135f); q = q * t + 0.7107068705f; q = q * t + (-0.142248368f); q = q * t + 0.127414796f; q = q * t;
    const f32x2 s = (v * v) * (-0.72134752044f);
    f32x2 e; e.x = __builtin_amdgcn_exp2f(s.x); e.y = __builtin_amdgcn_exp2f(s.y);
    const f32x2 m = v * (q * e), r = v - m;
    f32x2 o; o.x = v.x < 0.f ? m.x : r.x; o.y = v.y < 0.f ? m.y : r.y; return o;
}

template <class Epi, class Sched, bool ALIGN_EPI = false, bool SP2 = false>
__device__ __forceinline__ void gemm_phase(PG8_LAS unsigned char* lds, const Gemm g, const Sched& S, const Epi& E) {
    int tid_o = threadIdx.x; asm volatile("" : "+v"(tid_o));
    const int tid = tid_o, wid = __builtin_amdgcn_readfirstlane(tid >> 6), lane = tid & 63, wr = wid >> 2, wc = wid & 3, fr = lane & 15, fq = lane >> 4;
    const int K = g.K, nt = K / BK;
    unsigned voffA[2], voffB[2];
#pragma unroll
    for (int i = 0; i < 2; ++i) { int R, C; stage_rc(tid * 16 + i * 8192, R, C); const int Rb = Epi::PERM ? ((R & ~31) + perm32(R & 31)) : R;
        voffA[i] = (unsigned)(R * K + C) * 2u; voffB[i] = (unsigned)(Rb * K + C) * 2u; }
    const unsigned kstep = (unsigned)(BK * 2);
    const unsigned hstep = (unsigned)HALF * (unsigned)K * 2u;
    const unsigned tstep = 2u * hstep;
    const unsigned ldsw = (unsigned)wid * 1024u;
    const int aoff = lds_byte(wr * 64 + fr, fq * 8), boff = lds_byte(wc * 32 + fr, fq * 8);
#define PG8_SA(b, h) (((b) * 2 + (h)) * HTB)
#define PG8_SB(b, h) ((4 + (b) * 2 + (h)) * HTB)
    const __amdgpu_buffer_rsrc_t rs_voffA = __builtin_amdgcn_make_buffer_rsrc((void*)g.A, (short)0, -1, 0x00020000);
    const __amdgpu_buffer_rsrc_t rs_voffB = __builtin_amdgcn_make_buffer_rsrc((void*)g.Bt, (short)0, -1, 0x00020000);
#define PG8_STAGE(bufoff, gbase, voff) do { _Pragma("unroll") for (int _i = 0; _i < 2; ++_i) \
        __builtin_amdgcn_raw_ptr_buffer_load_lds(rs_##voff, (PG8_LAS void*)(lds + (bufoff) + ldsw + _i * 8192), 16, (int)(voff)[_i], (int)(gbase), 0, 0); } while (0)
#define PG8_LDA(dst, b, h) do { _Pragma("unroll") for (int m = 0; m < 4; ++m) _Pragma("unroll") for (int k = 0; k < 2; ++k) dst[m][k] = *(const PG8_LAS bf16x8*)(lds + PG8_SA(b, h) + aoff + m * 2048 + k * 1024); } while (0)
#define PG8_LDB(dst, b, h) do { _Pragma("unroll") for (int n = 0; n < 2; ++n) _Pragma("unroll") for (int k = 0; k < 2; ++k) dst[n][k] = *(const PG8_LAS bf16x8*)(lds + PG8_SB(b, h) + boff + n * 2048 + k * 1024); } while (0)
#define PG8_MMA(ai, bj, At, Bt) do { __builtin_amdgcn_s_setprio(1); _Pragma("unroll") for (int m = 0; m < 4; ++m) _Pragma("unroll") for (int n = 0; n < 2; ++n) _Pragma("unroll") for (int k = 0; k < 2; ++k) \
        acc[ai][bj][m][n] = __builtin_amdgcn_mfma_f32_16x16x32_bf16(Bt[n][k], At[m][k], acc[ai][bj][m][n], 0, 0, 0); __builtin_amdgcn_s_setprio(0); } while (0)
#define PG8_WAIT_V(n) asm volatile("s_waitcnt vmcnt(" #n ")" ::: "memory")
#define PG8_WAIT_L(n) asm volatile("s_waitcnt lgkmcnt(" #n ")" ::: "memory")
#define PG8_BAR __builtin_amdgcn_s_barrier()
#define PG8_SCHED __builtin_amdgcn_sched_barrier(0)
    Unit cur, nxt; int ui = 0;
    if (!S.next(0, cur)) return;
    f32x4 acc[2][2][4][2];
#pragma unroll
    for (int a = 0; a < 2; ++a)
#pragma unroll
        for (int b = 0; b < 2; ++b)
#pragma unroll
            for (int m = 0; m < 4; ++m)
#pragma unroll
                for (int n = 0; n < 2; ++n) acc[a][b][m][n] = (f32x4){0.f, 0.f, 0.f, 0.f};
    bf16x8 At[4][2], B0[2][2], B1[2][2];
    unsigned cA = (unsigned)cur.pm * tstep, cB = (unsigned)cur.pn * tstep;
    S.a_ready(cur);
    if constexpr (SP2) {
        PG8_STAGE(PG8_SB(0, 0), cB, voffB); PG8_STAGE(PG8_SB(0, 1), cB + hstep, voffB); PG8_STAGE(PG8_SA(0, 0), cA, voffA); PG8_STAGE(PG8_SA(0, 1), cA + hstep, voffA);
        if (wr == 1) PG8_BAR;
        PG8_WAIT_V(2); PG8_BAR;
        PG8_STAGE(PG8_SB(1, 0), cB + kstep, voffB); PG8_STAGE(PG8_SA(1, 0), cA + kstep, voffA); PG8_STAGE(PG8_SB(1, 1), cB + hstep + kstep, voffB);
        PG8_WAIT_V(6); PG8_BAR;
    } else {
        PG8_STAGE(PG8_SB(0, 0), cB, voffB); PG8_STAGE(PG8_SA(0, 0), cA, voffA); PG8_STAGE(PG8_SB(0, 1), cB + hstep, voffB); PG8_STAGE(PG8_SA(0, 1), cA + hstep, voffA);
        if (wr == 1) PG8_BAR;
        PG8_WAIT_V(4); PG8_BAR;
        PG8_STAGE(PG8_SB(1, 0), cB + kstep, voffB); PG8_STAGE(PG8_SA(1, 0), cA + kstep, voffA); PG8_STAGE(PG8_SB(1, 1), cB + hstep + kstep, voffB);
        PG8_WAIT_V(6); PG8_BAR;
    }
    for (;;) {
        const bool has_next = S.next(ui + 1, nxt);
        const unsigned nA = has_next ? (unsigned)nxt.pm * tstep : cA, nB = has_next ? (unsigned)nxt.pn * tstep : cB;
        for (int t = 0; t < nt; t += 2) {
            const bool last = (t == nt - 2);
            const unsigned a1 = cA + (unsigned)(t + 1) * kstep;
            const unsigned a2 = last ? nA : cA + (unsigned)(t + 2) * kstep, b2 = last ? nB : cB + (unsigned)(t + 2) * kstep;
            const unsigned a3 = a2 + kstep, b3 = b2 + kstep;
            if (last && has_next) S.a_ready(nxt);
            if constexpr (SP2) {
            PG8_LDB(B0, 0, 0); PG8_LDB(B1, 0, 1); PG8_SCHED; PG8_LDA(At, 0, 0); PG8_STAGE(PG8_SA(1, 1), a1 + hstep, voffA);
            PG8_WAIT_V(8); PG8_WAIT_L(0); PG8_BAR; PG8_MMA(0, 0, At, B0); PG8_MMA(0, 1, At, B1); PG8_BAR; PG8_SCHED;
            PG8_LDA(At, 0, 1); PG8_STAGE(PG8_SB(0, 0), b2, voffB); PG8_STAGE(PG8_SB(0, 1), b2 + hstep, voffB); PG8_STAGE(PG8_SA(0, 0), a2, voffA);
            PG8_WAIT_V(8); PG8_WAIT_L(0); PG8_BAR; PG8_MMA(1, 0, At, B0); PG8_MMA(1, 1, At, B1); PG8_BAR; PG8_SCHED;
            PG8_LDB(B0, 1, 0); PG8_LDB(B1, 1, 1); PG8_SCHED; PG8_LDA(At, 1, 0); PG8_STAGE(PG8_SA(0, 1), a2 + hstep, voffA);
            PG8_WAIT_V(8); PG8_WAIT_L(0); PG8_BAR; PG8_MMA(0, 0, At, B0); PG8_MMA(0, 1, At, B1); PG8_BAR; PG8_SCHED;
            PG8_LDA(At, 1, 1); PG8_STAGE(PG8_SB(1, 0), b3, voffB); PG8_STAGE(PG8_SB(1, 1), b3 + hstep, voffB); PG8_STAGE(PG8_SA(1, 0), a3, voffA);
            PG8_WAIT_V(8); PG8_WAIT_L(0); PG8_BAR; PG8_MMA(1, 0, At, B0); PG8_MMA(1, 1, At, B1); PG8_BAR; PG8_SCHED;
            } else {
            PG8_LDB(B0, 0, 0); PG8_SCHED; PG8_LDA(At, 0, 0); PG8_STAGE(PG8_SA(1, 1), a1 + hstep, voffA);
            PG8_WAIT_L(8); PG8_BAR; PG8_WAIT_L(0); PG8_MMA(0, 0, At, B0); PG8_BAR; PG8_SCHED;
            PG8_LDB(B1, 0, 1); PG8_STAGE(PG8_SB(0, 0), b2, voffB);
            PG8_BAR; PG8_WAIT_L(0); PG8_MMA(0, 1, At, B1); PG8_BAR;
            PG8_LDA(At, 0, 1); PG8_STAGE(PG8_SA(0, 0), a2, voffA);
            PG8_BAR; PG8_WAIT_L(0); PG8_MMA(1, 0, At, B0); PG8_BAR; PG8_SCHED;
            PG8_STAGE(PG8_SB(0, 1), b2 + hstep, voffB);
            PG8_WAIT_V(6); PG8_BAR; PG8_MMA(1, 1, At, B1); PG8_BAR;
            PG8_LDB(B0, 1, 0); PG8_SCHED; PG8_LDA(At, 1, 0); PG8_STAGE(PG8_SA(0, 1), a2 + hstep, voffA);
            PG8_WAIT_L(8); PG8_BAR; PG8_WAIT_L(0); PG8_MMA(0, 0, At, B0); PG8_BAR; PG8_SCHED;
            PG8_LDB(B1, 1, 1); PG8_STAGE(PG8_SB(1, 0), b3, voffB);
            PG8_BAR; PG8_WAIT_L(0); PG8_MMA(0, 1, At, B1); PG8_BAR;
            PG8_LDA(At, 1, 1); PG8_STAGE(PG8_SA(1, 0), a3, voffA);
            PG8_BAR; PG8_WAIT_L(0); PG8_MMA(1, 0, At, B0); PG8_BAR; PG8_SCHED;
            PG8_STAGE(PG8_SB(1, 1), b3 + hstep, voffB);
            PG8_WAIT_V(6); PG8_BAR; PG8_MMA(1, 1, At, B1); PG8_BAR;
            }
        }
        if constexpr (ALIGN_EPI) { if (wr == 0) PG8_BAR; }
        if constexpr (!Epi::AFTER_DRAIN) { E(acc, cur, wr, wc, fr, fq); S.done(cur); }
        if (!has_next) break;
#pragma unroll
        for (int a = 0; a < 2; ++a)
#pragma unroll
            for (int b = 0; b < 2; ++b)
#pragma unroll
                for (int m = 0; m < 4; ++m)
#pragma unroll
                    for (int n = 0; n < 2; ++n) acc[a][b][m][n] = (f32x4){0.f, 0.f, 0.f, 0.f};
        cur = nxt; cA = nA; cB = nB; ++ui;
        if constexpr (ALIGN_EPI) { if (wr == 1) PG8_BAR; }
    }
    PG8_WAIT_V(0);
    if constexpr (!ALIGN_EPI) { if (wr == 0) PG8_BAR; }
    PG8_BAR;
    if constexpr (Epi::AFTER_DRAIN) { E.fused(acc, cur, wr, wc, fr, fq, lds, wid, lane); S.done(cur); }
#undef PG8_SA
#undef PG8_SB
#undef PG8_STAGE
#undef PG8_LDA
#undef PG8_LDB
#undef PG8_MMA
#undef PG8_WAIT_V
#undef PG8_WAIT_L
#undef PG8_BAR
#undef PG8_SCHED
}
}
namespace pg8 {
#define PG8_GAS __attribute__((address_space(1)))
constexpr float RMS_EPS = 1e-6f;
typedef unsigned long long stat_t;
typedef unsigned long long u64x2 __attribute__((ext_vector_type(2)));
constexpr float STAT_SCALE = 1048576.0f;
__device__ __forceinline__ stat_t stat_fix(float ss) { return (stat_t)(ss * STAT_SCALE + 0.5f); }
__device__ __forceinline__ float msq_from(stat_t q) { const float lo = (float)(unsigned)q * (1.0f / (2048.0f * STAT_SCALE)) + RMS_EPS; return (float)(unsigned)(q >> 32) * (4294967296.0f / (2048.0f * STAT_SCALE)) + lo; }
__device__ __forceinline__ float rinv_from(stat_t q) { return __builtin_amdgcn_rsqf(msq_from(q)); }
__device__ __forceinline__ float rinv_of(const stat_t* st, int row) { return rinv_from(st[row]); }
__device__ __forceinline__ float fast_sigmoid(float v) { return __builtin_amdgcn_rcpf(1.0f + __expf(-v)); }
__device__ __forceinline__ float gelu_tanh(float v) { const float y = 1.5957691216f * (v + 0.044715f * v * v * v); return v * fast_sigmoid(y); }
__device__ __forceinline__ u32x4 pack8(const f32x4 a, const f32x4 b) { u32x4 w; w.x = cvt_pk_bf16(a[0], a[1]); w.y = cvt_pk_bf16(a[2], a[3]); w.z = cvt_pk_bf16(b[0], b[1]); w.w = cvt_pk_bf16(b[2], b[3]); return w; }
__device__ __forceinline__ void unpack8(const u32x4 w, f32x4& a, f32x4& b) {
    a[0] = __uint_as_float(w.x << 16); a[1] = __uint_as_float(w.x & 0xffff0000u); a[2] = __uint_as_float(w.y << 16); a[3] = __uint_as_float(w.y & 0xffff0000u);
    b[0] = __uint_as_float(w.z << 16); b[1] = __uint_as_float(w.z & 0xffff0000u); b[2] = __uint_as_float(w.w << 16); b[3] = __uint_as_float(w.w & 0xffff0000u); }
__device__ __forceinline__ float sumsq8(const f32x4 a, const f32x4 b) { return (a[0] * a[0] + a[1] * a[1]) + (a[2] * a[2] + a[3] * a[3]) + (b[0] * b[0] + b[1] * b[1]) + (b[2] * b[2] + b[3] * b[3]); }

struct EpiSwiGLU {
    static constexpr bool PERM = true, AFTER_DRAIN = false;
    bf16_t* H; int ldh; const stat_t* st;
    __device__ __forceinline__ void operator()(const f32x4 (&acc)[2][2][4][2], const Unit& u, int wr, int wc, int fr, int fq) const {
        const int rowu = u.pm * BM + wr * 64; const unsigned lo = (unsigned)(fr * ldh + 8 * fq);
        stat_t q[8];
#pragma unroll
        for (int g = 0; g < 8; ++g) q[g] = ((const PG8_GAS stat_t*)(st + rowu + (g >> 2) * HALF + (g & 3) * 16))[fr];
        asm volatile("" ::: "memory");
#pragma unroll
        for (int ai = 0; ai < 2; ++ai)
#pragma unroll
            for (int m = 0; m < 4; ++m) { const int ru = rowu + ai * HALF + m * 16;
                const float v = msq_from(q[ai * 4 + m]), sn = __builtin_amdgcn_rsqf(v) * -1.4426950408889634f;
                f32x4 h[2];
#pragma unroll
                for (int n = 0; n < 2; ++n) { const f32x4 g = acc[ai][0][m][n], up = acc[ai][1][m][n];
#pragma unroll
                    for (int p = 0; p < 2; ++p) { const f32x2 g2 = (f32x2){g[2 * p], g[2 * p + 1]}, u2 = (f32x2){up[2 * p], up[2 * p + 1]}; const f32x2 a2 = g2 * sn;
                        f32x2 e2; e2.x = __builtin_amdgcn_exp2f(a2.x); e2.y = __builtin_amdgcn_exp2f(a2.y);
                        const f32x2 d2 = e2 * v + v; f32x2 r2; r2.x = __builtin_amdgcn_rcpf(d2.x); r2.y = __builtin_amdgcn_rcpf(d2.y);
                        const f32x2 h2 = (g2 * u2) * r2; h[n][2 * p] = h2.x; h[n][2 * p + 1] = h2.y; } }
                bf16_t* hp = H + (size_t)ru * ldh + u.pn * HALF + wc * 32;
                *(PG8_GAS u32x4*)(hp + lo) = pack8(h[0], h[1]); }
    }
};
template <int MODE> struct EpiRmw {
    static constexpr bool PERM = true, AFTER_DRAIN = false;
    const bf16_t* XB; bf16_t* XN; const stat_t* st; stat_t* stn; float alpha;
    __device__ __forceinline__ void operator()(const f32x4 (&acc)[2][2][4][2], const Unit& u, int wr, int wc, int fr, int fq) const {
        const int rowu = u.pm * BM + wr * 64, colu = u.pn * BM + wc * 32; const unsigned lo = (unsigned)(fr * 2048 + 8 * fq);
        const bf16_t* const xbase = XB + (size_t)rowu * 2048 + colu; bf16_t* const nbase = XN + (size_t)rowu * 2048 + colu;
        u32x4 xv[2][2][2], pv[2][2][2];
        stat_t rq[2][2];
        float ss[8];
#define RMW_LOAD(k, b) do { _Pragma("unroll") for (int q = 0; q < 2; ++q) { const int g = 2 * (k) + q, ro = ((g >> 2) * HALF + (g & 3) * 16) * 2048; \
            if (MODE == 1) rq[b][q] = ((const PG8_GAS stat_t*)(st + rowu + (g >> 2) * HALF + (g & 3) * 16))[fr]; \
            _Pragma("unroll") for (int bj = 0; bj < 2; ++bj) { xv[b][q][bj] = *(const PG8_GAS u32x4*)(xbase + ro + lo + bj * HALF); \
                if (MODE == 1) pv[b][q][bj] = *(const PG8_GAS u32x4*)(nbase + ro + lo + bj * HALF); } } } while (0)
        RMW_LOAD(0, 0);
        asm volatile("" ::: "memory");
#pragma unroll
        for (int k = 0; k < 4; ++k) { const int b = k & 1; u32x4 ov[2][2];
#pragma unroll
            for (int q = 0; q < 2; ++q) { const int g = 2 * k + q, ai = g >> 2, m = g & 3; float s2 = 0.f; const float rsg = (MODE == 1) ? rinv_from(rq[b][q]) : 0.f;
#pragma unroll
                for (int bj = 0; bj < 2; ++bj) { f32x4 x0, x1; unpack8(xv[b][q][bj], x0, x1);
                    if (MODE == 0) { x0 += acc[ai][bj][m][0] * alpha; x1 += acc[ai][bj][m][1] * alpha; }
                    else { f32x4 p0, p1; unpack8(pv[b][q][bj], p0, p1);
#pragma unroll
                        for (int j = 0; j < 4; ++j) { x0[j] += alpha * fast_sigmoid(acc[ai][bj][m][0][j] * rsg) * p0[j]; x1[j] += alpha * fast_sigmoid(acc[ai][bj][m][1][j] * rsg) * p1[j]; } }
                    s2 += sumsq8(x0, x1); ov[q][bj] = pack8(x0, x1); }
                s2 += __shfl_xor(s2, 16); s2 += __shfl_xor(s2, 32); ss[g] = s2; }
            if (k < 3) { RMW_LOAD(k + 1, b ^ 1); }
            asm volatile("" ::: "memory");
#pragma unroll
            for (int q = 0; q < 2; ++q) { const int g = 2 * k + q, ro = ((g >> 2) * HALF + (g & 3) * 16) * 2048;
#pragma unroll
                for (int bj = 0; bj < 2; ++bj) if (MODE == 0 || alpha != 0.f) *(PG8_GAS u32x4*)(nbase + ro + lo + bj * HALF) = ov[q][bj]; }
            asm volatile("" ::: "memory");
        }
#undef RMW_LOAD
        if (fq == 0) {
#pragma unroll
            for (int g = 0; g < 8; ++g) __hip_atomic_fetch_add((PG8_GAS stat_t*)(stn + rowu + (g >> 2) * HALF + (g & 3) * 16 + fr), stat_fix(ss[g]), __ATOMIC_RELAXED, __HIP_MEMORY_SCOPE_AGENT);
        }
    }
};
template <int MODE> struct EpiRowBf16 {
    static constexpr bool PERM = true, AFTER_DRAIN = false;
    bf16_t* O; int ldc; const stat_t* st;
    __device__ __forceinline__ void operator()(const f32x4 (&acc)[2][2][4][2], const Unit& u, int wr, int wc, int fr, int fq) const {
        const int rowu = u.pm * BM + wr * 64, colu = u.pn * BM + wc * 32; const unsigned lo = (unsigned)(fr * ldc + 8 * fq);
        stat_t q[8];
        if (MODE == 1) {
#pragma unroll
            for (int g = 0; g < 8; ++g) q[g] = ((const PG8_GAS stat_t*)(st + rowu + (g >> 2) * HALF + (g & 3) * 16))[fr];
            asm volatile("" ::: "memory"); }
#pragma unroll
        for (int ai = 0; ai < 2; ++ai)
#pragma unroll
            for (int m = 0; m < 4; ++m) { const int ru = rowu + ai * HALF + m * 16; float s = 1.0f; if (MODE == 1) s = rinv_from(q[ai * 4 + m]);
                bf16_t* op = O + (size_t)ru * ldc + colu;
#pragma unroll
                for (int bj = 0; bj < 2; ++bj) { f32x4 v0 = acc[ai][bj][m][0] * s, v1 = acc[ai][bj][m][1] * s;
                    if (MODE == 1) {
#pragma unroll
                        for (int j = 0; j < 4; ++j) { v0[j] = gelu_tanh(v0[j]); v1[j] = gelu_tanh(v1[j]); } }
                    *(PG8_GAS u32x4*)(op + lo + bj * HALF) = pack8(v0, v1); } }
    }
};
struct EpiOddIn {
    static constexpr bool PERM = true, AFTER_DRAIN = false;
    bf16_t* Z; bf16_t* GB; const stat_t* st;
    __device__ __forceinline__ void operator()(const f32x4 (&acc)[2][2][4][2], const Unit& u, int wr, int wc, int fr, int fq) const {
        const int rowu = u.pm * BM + wr * 64; const unsigned lo = (unsigned)(fr * 2048 + 8 * fq);
        stat_t q[8];
#pragma unroll
        for (int g = 0; g < 8; ++g) q[g] = ((const PG8_GAS stat_t*)(st + rowu + (g >> 2) * HALF + (g & 3) * 16))[fr];
        asm volatile("" ::: "memory");
        if (u.pn < 16) { const int colu = u.pn * HALF + wc * 32;
#pragma unroll
            for (int ai = 0; ai < 2; ++ai)
#pragma unroll
                for (int m = 0; m < 4; ++m) { const int ru = rowu + ai * HALF + m * 16; const float s = rinv_from(q[ai * 4 + m]), s2 = s * s;
                    const f32x4 z0 = acc[ai][0][m][0] * acc[ai][1][m][0] * s2, z1 = acc[ai][0][m][1] * acc[ai][1][m][1] * s2;
                    bf16_t* zp = Z + (size_t)ru * 2048 + colu;
                    *(PG8_GAS u32x4*)(zp + lo) = pack8(z0, z1); }
        } else { const int colu = (u.pn - 16) * BM + wc * 32;
#pragma unroll
            for (int ai = 0; ai < 2; ++ai)
#pragma unroll
                for (int m = 0; m < 4; ++m) { const int ru = rowu + ai * HALF + m * 16; const float s = rinv_from(q[ai * 4 + m]);
                    bf16_t* gp = GB + (size_t)ru * 2048 + colu;
#pragma unroll
                    for (int bj = 0; bj < 2; ++bj) *(PG8_GAS u32x4*)(gp + lo + bj * HALF) = pack8(acc[ai][bj][m][0] * s, acc[ai][bj][m][1] * s); }
        }
    }
};
struct EpiMT {
    static constexpr bool PERM = true, AFTER_DRAIN = false;
    bf16_t* ZTP; bf16_t* ZTS; bf16_t* VT; const stat_t* st; const float* gv;
    __device__ __forceinline__ void operator()(const f32x4 (&acc)[2][2][4][2], const Unit& u, int wr, int wc, int fr, int fq) const {
        const int tu = u.pn * BM + wc * 32;
        f32x4 sc[2][2];
#pragma unroll
        for (int bj = 0; bj < 2; ++bj)
#pragma unroll
            for (int n = 0; n < 2; ++n) { const stat_t* sp = (st + tu + bj * HALF + 4 * n) + 8 * fq; const u64x2 a = *(const PG8_GAS u64x2*)sp, b = *(const PG8_GAS u64x2*)(sp + 2);
                sc[bj][n][0] = rinv_from(a[0]); sc[bj][n][1] = rinv_from(a[1]); sc[bj][n][2] = rinv_from(b[0]); sc[bj][n][3] = rinv_from(b[1]); }
        const int chu = u.pm * BM + wr * 64;
        if (u.pm < 4) {
            bf16_t* base; int S2;
            if (u.pn < 128) { const int tt = u.pn * BM; base = ZTP + (size_t)(tt >> 11) * (1024 * 2048) + (tt & 2047) + wc * 32; S2 = 2048; }
            else { base = ZTS + (u.pn - 128) * BM + wc * 32; S2 = 8192; }
            const unsigned lo = (unsigned)(fr * S2 + 8 * fq);
#pragma unroll
            for (int ai = 0; ai < 2; ++ai)
#pragma unroll
                for (int m = 0; m < 4; ++m) { bf16_t* rp = base + (size_t)(chu + ai * HALF + m * 16) * S2;
#pragma unroll
                    for (int bj = 0; bj < 2; ++bj) *(PG8_GAS u32x4*)(rp + lo + bj * HALF) = pack8(acc[ai][bj][m][0] * sc[bj][0], acc[ai][bj][m][1] * sc[bj][1]); }
        } else {
            const unsigned lo = (unsigned)(fr * 40960 + 8 * fq);
#pragma unroll
            for (int ai = 0; ai < 2; ++ai) {
                f32x4 q[2][2];
#pragma unroll
                for (int bj = 0; bj < 2; ++bj)
#pragma unroll
                    for (int n = 0; n < 2; ++n) { q[bj][n] = (f32x4){0.f, 0.f, 0.f, 0.f};
#pragma unroll
                        for (int m = 0; m < 4; ++m) { const f32x4 v = acc[ai][bj][m][n] * sc[bj][n];
#pragma unroll
                            for (int j = 0; j < 4; ++j) { const float y = gelu_tanh(v[j]); q[bj][n][j] += y * y; } } }
#pragma unroll
                for (int bj = 0; bj < 2; ++bj)
#pragma unroll
                    for (int n = 0; n < 2; ++n)
#pragma unroll
                        for (int j = 0; j < 4; ++j) { float s = q[bj][n][j]; s += __shfl_xor(s, 1); s += __shfl_xor(s, 2); s += __shfl_xor(s, 4); s += __shfl_xor(s, 8);
                            q[bj][n][j] = __builtin_amdgcn_rsqf(s * (1.0f / 64.0f) + RMS_EPS); }
#pragma unroll
                for (int m = 0; m < 4; ++m) { const int cu = chu - 1024 + ai * HALF + m * 16; const float gg = ((const PG8_GAS float*)(gv + cu))[fr]; bf16_t* vp = VT + (size_t)cu * 40960 + tu;
#pragma unroll
                    for (int bj = 0; bj < 2; ++bj) { f32x4 y0 = acc[ai][bj][m][0] * sc[bj][0], y1 = acc[ai][bj][m][1] * sc[bj][1];
#pragma unroll
                        for (int j = 0; j < 4; ++j) { y0[j] = gelu_tanh(y0[j]); y1[j] = gelu_tanh(y1[j]); }
                        *(PG8_GAS u32x4*)(vp + lo + bj * HALF) = pack8(y0 * q[bj][0] * gg, y1 * q[bj][1] * gg); } }
            }
        }
    }
};
struct EpiDFT {
    static constexpr bool PERM = true, AFTER_DRAIN = false;
    bf16_t* Y; int row_base, S; float scale, msign; int col_lo, col_hi;
    __device__ __forceinline__ void operator()(const f32x4 (&acc)[2][2][4][2], const Unit& u, int wr, int wc, int fr, int fq) const {
        const int ku = u.pm * BM + wr * 64, rb = row_base + (u.pn >> 2) * S, colu = (u.pn & 3) * BM + wc * 32;
        const int lo = fr * 2048 + 8 * fq, lom = -fr * 2048 + 8 * fq; const float ms = scale * msign;
#pragma unroll
        for (int bj = 0; bj < 2; ++bj) { const int col = colu + bj * HALF + 8 * fq; if (col >= col_lo && col < col_hi) {
#pragma unroll
            for (int ai = 0; ai < 2; ++ai)
#pragma unroll
                for (int m = 0; m < 4; ++m) { const int k0 = ku + ai * HALF + m * 16;
                    bf16_t* yp = Y + (size_t)(rb + k0) * 2048 + colu + bj * HALF; bf16_t* ym = Y + (size_t)(rb + S - k0) * 2048 + colu + bj * HALF;
                    *(PG8_GAS u32x4*)(yp + lo) = pack8(acc[ai][bj][m][0] * scale, acc[ai][bj][m][1] * scale);
                    if (k0 + fr != 0) *(PG8_GAS u32x4*)(ym + lom) = pack8(acc[ai][bj][m][0] * ms, acc[ai][bj][m][1] * ms); } } }
    }
};
struct EpiNull {
    static constexpr bool PERM = true, AFTER_DRAIN = false;
    float* sink;
    __device__ __forceinline__ void operator()(const f32x4 (&acc)[2][2][4][2], const Unit& u, int wr, int wc, int fr, int fq) const {
        float s = 0.f;
#pragma unroll
        for (int ai = 0; ai < 2; ++ai)
#pragma unroll
            for (int bj = 0; bj < 2; ++bj)
#pragma unroll
                for (int m = 0; m < 4; ++m)
#pragma unroll
                    for (int n = 0; n < 2; ++n) s += acc[ai][bj][m][n][0] + acc[ai][bj][m][n][1] + acc[ai][bj][m][n][2] + acc[ai][bj][m][n][3];
        if (s == 1.2345e-30f) sink[u.pm + fr] = s;
    }
};
}
#ifndef MK_N_LAUNCHES
#define MK_N_LAUNCHES 1
#endif
constexpr int NPHASE = 34;
constexpr int T = 40960, TP = 32768, DM = 2048, DFF = 5632, NLAYER = 4;
typedef unsigned short bf16;
#define GAS __attribute__((address_space(1)))
#define LAS __attribute__((address_space(3)))
typedef unsigned v4u __attribute__((ext_vector_type(4)));
typedef unsigned v2u __attribute__((ext_vector_type(2)));
typedef float f32x4 __attribute__((ext_vector_type(4)));
typedef short bf16x8 __attribute__((ext_vector_type(8)));
typedef GAS unsigned gu32;

constexpr size_t MiB = 1u << 20;
constexpr size_t WS_CTL = 0, CTL_BYTES = 6 * MiB;
constexpr int CW_BAR = 4096;
constexpr size_t WS_STATS = 65536;
constexpr size_t WS_W = 6 * MiB;
constexpr size_t SZ_FIN = (size_t)2 * DFF * DM * 2, SZ_FOUT = (size_t)DM * DFF * 2, SZ_SQ = (size_t)DM * DM * 2, SZ_WP = (size_t)DM * 256 * 2;
constexpr size_t WL_F1IN = 0, WL_F1OUT = SZ_FIN, WL_F2IN = SZ_FIN + SZ_FOUT, WL_F2OUT = 2 * SZ_FIN + SZ_FOUT, WL_WG = 2 * SZ_FIN + 2 * SZ_FOUT, WL_WP = WL_WG + SZ_SQ, WL_SIZE = WL_WP + SZ_WP;
constexpr size_t WS_WE = WS_W + NLAYER * WL_SIZE;
constexpr size_t WE_WZ = 0, WE_WU = (size_t)3072 * DM * 2, WE_WO = WE_WU + (size_t)1024 * DM * 2, WE_WS = WE_WO + SZ_SQ, WE_SIZE = WE_WS + (size_t)16 * 128 * 128 * 2;
constexpr size_t WS_WOD = WS_WE + 2 * WE_SIZE;
constexpr size_t WO_WC = 0, WO_WOC = (size_t)6144 * DM * 2, WO_SIZE = WO_WOC + SZ_SQ;
constexpr size_t WS_DP = WS_WOD + 2 * WO_SIZE, SZ_DP = (size_t)2 * 1024 * 2048 * 2;
constexpr size_t WS_DS = WS_DP + SZ_DP, SZ_DS = (size_t)2 * 4096 * 8192 * 2;
constexpr size_t WS_XB0 = WS_DS + SZ_DS, SZ_XB = (size_t)T * DM * 2;
constexpr size_t WS_XB1 = WS_XB0 + SZ_XB;
constexpr size_t WS_H = WS_XB1 + SZ_XB, SZ_H = (size_t)T * DFF * 2;
constexpr size_t WS_ZTP = WS_H, WS_ZTS = WS_ZTP + (size_t)16 * 1024 * 2048 * 2, WS_VT = WS_ZTS + (size_t)1024 * 8192 * 2, WS_U = WS_VT + (size_t)1024 * T * 2;
constexpr size_t WS_Z = WS_H, WS_GB = WS_H + SZ_XB;
constexpr size_t WS_PB = WS_H + SZ_H, SZ_PB = (size_t)NLAYER * T * 256 * 2;
constexpr size_t WS_END = WS_PB + SZ_PB;
static_assert(WS_U + (size_t)T * 1024 * 2 <= WS_H + SZ_H && WS_GB + SZ_XB <= WS_H + SZ_H, "mixer buffers overlay the FFN hidden buffer");
static_assert(WS_STATS + (size_t)18 * T * 8 <= CTL_BYTES && (CW_BAR + 3456) * 4 <= (int)WS_STATS, "control region");
static_assert(WS_END < 1800000000ull, "d_ws map");

constexpr int LDS_BYTES = 147456;
constexpr int LDSCTL_OFF = 131072;

#define LDS_WAIT() asm volatile("s_waitcnt lgkmcnt(0)" ::: "memory")
__device__ __forceinline__ unsigned f2bf(float f) { unsigned u = __builtin_bit_cast(unsigned, f); return (u + 0x7fffu + ((u >> 16) & 1u)) >> 16; }
__device__ __forceinline__ unsigned pk2(float lo, float hi) { return f2bf(lo) | (f2bf(hi) << 16); }
__device__ __forceinline__ float bflo(unsigned w) { return __uint_as_float(w << 16); }
__device__ __forceinline__ float bfhi(unsigned w) { return __uint_as_float(w & 0xffff0000u); }
__device__ __forceinline__ float wave_sum(float v) {
#pragma unroll
    for (int o = 1; o < 64; o <<= 1) v += __shfl_xor(v, o);
    return v;
}
#define XB_TMO      128
#define XB_XCNT(j)  (256  + 64 * (j))
#define XB_XSUB(j)  (1280 + 64 * (j))
#define XB_XGEN(j)  (2304 + 64 * (j))
#define XB_TOP      3328
#define XB_TOPGEN   3392
#define XCD_BAR_WORDS 3456
#define XB_SPIN_CAP (1u << 18)

__device__ __forceinline__ unsigned xb_ld(unsigned* p)              { return __hip_atomic_load(p, __ATOMIC_RELAXED, __HIP_MEMORY_SCOPE_AGENT); }
__device__ __forceinline__ unsigned xb_add(unsigned* p, unsigned v) { return __hip_atomic_fetch_add(p, v, __ATOMIC_RELAXED, __HIP_MEMORY_SCOPE_AGENT); }
__device__ __forceinline__ unsigned xb_xcc_id() { return (unsigned)__builtin_amdgcn_s_getreg((3 << 11) | 20) & 0xFu; }
#define XB_SPIN(cond, bar) do { unsigned _sp = 0; while (cond) { __builtin_amdgcn_s_sleep(1); \
    if ((++_sp & 255u) == 0u) { if (xb_ld(&(bar)[XB_TMO])) break; if (_sp > XB_SPIN_CAP) { atomicAdd(&(bar)[XB_TMO], 1u); break; } } } } while (0)

struct XcdBarrier {
    unsigned* bar; unsigned x;
    volatile LAS unsigned* st;
};

__device__ __forceinline__ XcdBarrier xcd_barrier_post(unsigned* bar, volatile LAS unsigned* st) {
    XcdBarrier b; b.bar = bar; b.x = xb_xcc_id(); b.st = st;
    if (threadIdx.x == 0) (void)xb_add(&bar[XB_XCNT(b.x)], 1u);
    return b;
}
__device__ __forceinline__ void xcd_barrier_complete(unsigned* bar, unsigned x, unsigned& nloc, unsigned& nx) {
    const unsigned G = gridDim.x * gridDim.y * gridDim.z;
    unsigned sum, cnt, mine, sp = 0u;
    for (;;) {
        sum = 0u; cnt = 0u; mine = 0u;
#pragma unroll
        for (unsigned j = 0; j < 16; ++j) { const unsigned c = xb_ld(&bar[XB_XCNT(j)]); sum += c; cnt += (c > 0u) ? 1u : 0u; mine = (j == x) ? c : mine; }
        if (sum == G) break;
        __builtin_amdgcn_s_sleep(1);
        if ((++sp & 255u) == 0u) { if (xb_ld(&bar[XB_TMO])) break; if (sp > XB_SPIN_CAP) { atomicAdd(&bar[XB_TMO], 1u); break; } }
    }
    nloc = mine > 0u ? mine : 1u; nx = cnt > 0u ? cnt : 1u;
}

__device__ __forceinline__ void xcd_barrier(const XcdBarrier& b) {
    asm volatile("s_waitcnt vmcnt(0)" ::: "memory");
    __syncthreads();
    if (threadIdx.x == 0) {
        unsigned* bar = b.bar;
        __builtin_amdgcn_s_waitcnt(0);
        unsigned nloc = b.st[0], nx = b.st[1];
        if (nloc == 0u) { xcd_barrier_complete(bar, b.x, nloc, nx); b.st[0] = nloc; b.st[1] = nx; }
        const unsigned old = xb_add(&bar[XB_XSUB(b.x)], 1u);
        const unsigned gen = old / nloc;
        if (old + 1u == (gen + 1u) * nloc) {
            __builtin_amdgcn_fence(__ATOMIC_RELEASE, "agent");
            asm volatile("s_waitcnt vmcnt(0)" ::: "memory");
            const unsigned og = xb_add(&bar[XB_TOP], 1u);
            const unsigned tg = og / nx;
            if (og + 1u == (tg + 1u) * nx) xb_add(&bar[XB_TOPGEN], 1u);
            else XB_SPIN(xb_ld(&bar[XB_TOPGEN]) == tg, bar);
            __builtin_amdgcn_fence(__ATOMIC_ACQUIRE, "agent");
            xb_add(&bar[XB_XGEN(b.x)], 1u);
            asm volatile("s_waitcnt vmcnt(0)" ::: "memory");
        } else {
            XB_SPIN(xb_ld(&bar[XB_XGEN(b.x)]) == gen, bar);
            __builtin_amdgcn_fence(__ATOMIC_ACQUIRE, "agent");
            asm volatile("s_waitcnt vmcnt(0)" ::: "memory");
        }
    }
    __syncthreads();
}
__device__ __forceinline__ void tr_item(const float* W, int ldw, int K, const float* g, bf16* WT, int dst_row0, LAS float* scr, int k0, int n0, int lane) {
    {
        f32x4 v[8]; const int kr = lane >> 3, n4 = (lane & 7) * 4;
#pragma unroll
        for (int i = 0; i < 8; ++i) v[i] = *(const GAS f32x4*)(W + (size_t)(k0 + 8 * i + kr) * ldw + n0 + n4);
        if (g) {
#pragma unroll
            for (int i = 0; i < 8; ++i) v[i] = v[i] * g[k0 + 8 * i + kr]; }
#pragma unroll
        for (int i = 0; i < 8; ++i) { LAS float* d = scr + (8 * i + kr) * 33 + n4; d[0] = v[i][0]; d[1] = v[i][1]; d[2] = v[i][2]; d[3] = v[i][3]; }
    }
    LDS_WAIT(); asm volatile("" ::: "memory");
    const int c = lane & 7;
#pragma unroll
    for (int j = 0; j < 4; ++j) { const int n = (lane >> 3) + 8 * j; const LAS float* s = scr + (8 * c) * 33 + n;
        v4u o; o.x = pk2(s[0 * 33], s[1 * 33]); o.y = pk2(s[2 * 33], s[3 * 33]); o.z = pk2(s[4 * 33], s[5 * 33]); o.w = pk2(s[6 * 33], s[7 * 33]);
        *(GAS v4u*)(WT + (size_t)(dst_row0 + n) * K + k0 + 8 * c) = o; }
    LDS_WAIT(); asm volatile("" ::: "memory");
}
__device__ __forceinline__ void hc_rows(int kd, int& r1, int& r2, float& c2) {
    if (kd < 528) { const int h = kd / 33, cp = kd - 33 * h; r1 = 64 * h + cp; if (cp == 0 || cp == 32) { r2 = r1; c2 = 0.f; } else { r2 = 64 * h + 64 - cp; c2 = 1.f; } }
    else { const int q = kd - 528, h = q / 31, cp = 1 + q - 31 * h; r1 = 64 * h + 64 - cp; r2 = 64 * h + cp; c2 = -1.f; }
}
__device__ __forceinline__ void tr_item_wofold(const float* W, bf16* WT, LAS float* scr, int k0, int n0, int lane) {
    {   f32x4 v[8], w[8]; float cc[8]; const int kr = lane >> 3, n4 = (lane & 7) * 4;
#pragma unroll
        for (int i = 0; i < 8; ++i) { int r1, r2; hc_rows(k0 + 8 * i + kr, r1, r2, cc[i]); v[i] = *(const GAS f32x4*)(W + (size_t)r1 * DM + n0 + n4); w[i] = *(const GAS f32x4*)(W + (size_t)r2 * DM + n0 + n4); }
#pragma unroll
        for (int i = 0; i < 8; ++i) { const f32x4 t = v[i] + w[i] * cc[i]; LAS float* d = scr + (8 * i + kr) * 33 + n4; d[0] = t[0]; d[1] = t[1]; d[2] = t[2]; d[3] = t[3]; }
    }
    LDS_WAIT(); asm volatile("" ::: "memory");
    const int c = lane & 7;
#pragma unroll
    for (int j = 0; j < 4; ++j) { const int n = (lane >> 3) + 8 * j; const LAS float* s = scr + (8 * c) * 33 + n;
        v4u o; o.x = pk2(s[0 * 33], s[1 * 33]); o.y = pk2(s[2 * 33], s[3 * 33]); o.z = pk2(s[4 * 33], s[5 * 33]); o.w = pk2(s[6 * 33], s[7 * 33]);
        *(GAS v4u*)(WT + (size_t)(n0 + n) * DM + k0 + 8 * c) = o; }
    LDS_WAIT(); asm volatile("" ::: "memory");
}
__device__ __forceinline__ int map_id(int n) { return n; }
__device__ __forceinline__ int map_glu(int n) { return n < DFF ? 256 * (n >> 7) + (n & 127) : 256 * ((n - DFF) >> 7) + 128 + ((n - DFF) & 127); }
__device__ __forceinline__ int map_oddin(int n) { return n < 2048 ? 4096 + n : (n < 4096 ? 256 * ((n - 2048) >> 7) + ((n - 2048) & 127) : 256 * ((n - 4096) >> 7) + 128 + ((n - 4096) & 127)); }

struct Args { const float* in[24]; float* out; unsigned char* ws; int ph_lo, ph_hi; };

constexpr int CW_POOL = 8192;
constexpr int I_FIN = (DM / 64) * (2 * DFF / 32), I_FOUT = (DFF / 64) * (DM / 32), I_SQ = (DM / 64) * (DM / 32), I_WP = (256 / 64) * (DM / 32);
constexpr int I_EIN = (DM / 64) * (2048 / 32), I_FOLD = 64 * 16, I_OIN = (DM / 64) * (6144 / 32);
constexpr int I_X = T / 4, I_P = T * 256 / 8 / 512, I_WS = 16 * 128 * 128 / 8 / 512, I_DGS = 2 * 4096 * 1024 / 512, I_DGP = 2 * 1024 * 256 / 512, I_DG = I_DGS + I_DGP;
constexpr int POOL_NA = I_X + I_FIN;
__host__ __device__ constexpr int pool_seg(int L, int s) {
    return s == 0 ? I_FOUT : s == 1 ? ((L & 1) ? I_OIN : I_EIN + I_FOLD) : s == 2 ? ((L & 1) ? 0 : (L == 0 ? I_DG + I_WS : I_WS)) : s == 3 ? I_SQ : s == 4 ? I_FIN : s == 5 ? I_FOUT + I_WP + I_P : s == 6 ? I_SQ : (L < NLAYER - 1 ? I_FIN : 0);
}
__host__ __device__ constexpr int pool_blk(int L) { return pool_seg(L, 0) + pool_seg(L, 1) + pool_seg(L, 2) + pool_seg(L, 3) + pool_seg(L, 4) + pool_seg(L, 5) + pool_seg(L, 6) + pool_seg(L, 7); }
constexpr unsigned POOL_NTOTAL = POOL_NA + pool_blk(0) + pool_blk(1) + pool_blk(2) + pool_blk(3);
__device__ __forceinline__ unsigned pool_target(int L, int k) {
    unsigned n = POOL_NA;
#pragma unroll
    for (int l = 0; l < NLAYER; ++l) if (l < L) n += pool_blk(l);
#pragma unroll
    for (int s = 0; s < 8; ++s) if (s <= k) n += pool_seg(L, s);
    return n;
}

__device__ __forceinline__ void cv_x_item(const float* xp, const float* xs, unsigned char* ws, int r, int lane) {
    pg8::stat_t* st0 = (pg8::stat_t*)(ws + WS_STATS); bf16* xb0 = (bf16*)(ws + WS_XB0);
#pragma unroll 1
    for (int i = 0; i < 4; ++i) { const int row = 4 * r + i; const float* src = row < TP ? xp + (size_t)row * DM : xs + (size_t)(row - TP) * DM;
        const GAS f32x4* xr = (const GAS f32x4*)src + lane; f32x4 v[8]; float s = 0.f;
#pragma unroll
        for (int j = 0; j < 8; ++j) { v[j] = xr[64 * j]; s += (v[j][0] * v[j][0] + v[j][1] * v[j][1]) + (v[j][2] * v[j][2] + v[j][3] * v[j][3]); }
        s = wave_sum(s); if (lane == 0) *(GAS pg8::stat_t*)(st0 + row) = pg8::stat_fix(s);
        GAS v2u* brow = (GAS v2u*)(xb0 + (size_t)row * DM) + lane;
#pragma unroll
        for (int j = 0; j < 8; ++j) { v2u w; w.x = pk2(v[j][0], v[j][1]); w.y = pk2(v[j][2], v[j][3]); brow[64 * j] = w; } }
}
__device__ __forceinline__ void cv_p_item(const float* pp, const float* ps, unsigned char* ws, int L, int r, int lane) {
    bf16* pb = (bf16*)(ws + WS_PB) + (size_t)L * T * 256; f32x4 v0[8], v1[8];
#pragma unroll
    for (int i = 0; i < 8; ++i) { const int e = r * 512 + i * 64 + lane, row = e >> 5, c8 = e & 31;
        const float* src = row < TP ? pp + ((size_t)L * TP + row) * 256 + c8 * 8 : ps + ((size_t)L * 8192 + (row - TP)) * 256 + c8 * 8;
        v0[i] = *(const GAS f32x4*)src; v1[i] = *(const GAS f32x4*)(src + 4); }
#pragma unroll
    for (int i = 0; i < 8; ++i) { const int e = r * 512 + i * 64 + lane;
        v4u o; o.x = pk2(v0[i][0], v0[i][1]); o.y = pk2(v0[i][2], v0[i][3]); o.z = pk2(v1[i][0], v1[i][1]); o.w = pk2(v1[i][2], v1[i][3]);
        *(GAS v4u*)(pb + (size_t)e * 8) = o; }
}
__device__ __forceinline__ void cv_ws_item(const float* wsrc, unsigned char* ws, int j, int r, int lane) {
    const float* src = wsrc + (size_t)j * 16 * 128 * 128; bf16* dst = (bf16*)(ws + WS_WE + (size_t)j * WE_SIZE + WE_WS); f32x4 v0[8], v1[8];
#pragma unroll
    for (int i = 0; i < 8; ++i) { const int e = r * 512 + i * 64 + lane; v0[i] = *(const GAS f32x4*)(src + (size_t)e * 8); v1[i] = *(const GAS f32x4*)(src + (size_t)e * 8 + 4); }
#pragma unroll
    for (int i = 0; i < 8; ++i) { const int e = r * 512 + i * 64 + lane;
        v4u o; o.x = pk2(v0[i][0], v0[i][1]); o.y = pk2(v0[i][2], v0[i][3]); o.z = pk2(v1[i][0], v1[i][1]); o.w = pk2(v1[i][2], v1[i][3]);
        *(GAS v4u*)(dst + (size_t)e * 8) = o; }
}
__device__ __forceinline__ void cv_dft_item(unsigned char* ws, int r, int lane) {
    const bool smp = r < I_DGS; const int S = smp ? 8192 : 2048, lg = smp ? 13 : 11; bf16* Dm = (bf16*)(ws + (smp ? WS_DS : WS_DP)); const float sc2 = 2.0f / (float)S;
    const int rr = smp ? r : r - I_DGS, per_mat = (S / 2) * (S / 8); const bool sn = rr * 512 >= per_mat;
#pragma unroll 1
    for (int i = 0; i < 8; ++i) { const int e = rr * 512 + i * 64 + lane, e2 = sn ? e - per_mat : e; const int k = e2 >> (lg - 3), s0 = (e2 & (S / 8 - 1)) * 8; float v[8];
        if (!sn) {
#pragma unroll
            for (int q = 0; q < 8; ++q) v[q] = cospif((float)((k * (s0 + q)) & (S - 1)) * sc2);
        } else {
#pragma unroll
            for (int q = 0; q < 8; ++q) v[q] = sinpif((float)((k * (s0 + q)) & (S - 1)) * sc2);
        }
        v4u o; o.x = pk2(v[0], v[1]); o.y = pk2(v[2], v[3]); o.z = pk2(v[4], v[5]); o.w = pk2(v[6], v[7]);
        *(GAS v4u*)(Dm + (size_t)e * 8) = o; }
}
__device__ __forceinline__ void cv_fold_item(const float* win, const float* gmix, unsigned char* ws, int j, int r, LAS float* scr, int lane) {
    LAS float* tab = scr + 2200;
    tab[lane] = cospif((float)lane * (1.0f / 32.0f));
    LDS_WAIT(); asm volatile("" ::: "memory");
    const bool isq = lane >= 33; const int cp = isq ? lane - 32 : lane, toff = isq ? 48 : 0;
    const int kb = (r >> 4) & 63, h = r & 15, k0 = kb * 32;
    const float* W = win + (size_t)j * DM * 3072 + h * 64; const float* gm = gmix + (2 * j) * DM; bf16* WZ = (bf16*)(ws + WS_WE + (size_t)j * WE_SIZE + WE_WZ);
    const int zr = isq ? 528 + h * 31 + (lane - 33) : h * 33 + lane;
    for (int kq = 0; kq < 4; ++kq) {
        float ac[8];
#pragma unroll
        for (int q = 0; q < 8; ++q) ac[q] = 0.f;
        for (int cc = 0; cc < 64; ++cc) { const float tv = tab[((cc * cp) + toff) & 63];
#pragma unroll
            for (int q = 0; q < 8; ++q) ac[q] += W[(size_t)(k0 + kq * 8 + q) * 3072 + cc] * tv; }
#pragma unroll
        for (int q = 0; q < 8; ++q) ac[q] *= gm[k0 + kq * 8 + q];
        v4u oc; oc.x = pk2(ac[0], ac[1]); oc.y = pk2(ac[2], ac[3]); oc.z = pk2(ac[4], ac[5]); oc.w = pk2(ac[6], ac[7]);
        *(GAS v4u*)(WZ + (size_t)zr * DM + k0 + kq * 8) = oc; }
    LDS_WAIT(); asm volatile("" ::: "memory");
}

typedef const __attribute__((address_space(4))) Args CArgs;
__device__ __forceinline__ void pool_item(CArgs* ap, LAS unsigned char* lds, int wave, int lane, unsigned it) {
    unsigned char* ws = ap->ws;
    LAS float* scr = (LAS float*)(lds + wave * 16384);
    int r = (int)it;
    if (r < I_X) { cv_x_item(ap->in[0], ap->in[1], ws, r, lane); return; }
    r -= I_X;
    int L = 0, s = 7, Lw = 0;
    if (r >= I_FIN) { r -= I_FIN; s = 0;
#pragma unroll
        for (int l = 0; l < NLAYER - 1; ++l) { const int bs = pool_blk(l); if (L == l && r >= bs) { r -= bs; L = l + 1; } }
#pragma unroll
        for (int q = 0; q < 7; ++q) { const int c = pool_seg(L, q); if (s == q && r >= c) { r -= c; s = q + 1; } }
        Lw = L + 1; }
    const int j = L >> 1; const bool odd = (L & 1) != 0;
    int wi = 0, gi = -1, goff = 0, ldw = DM, K = DM, nblk = 64, mapk = 0; size_t woff = 0, toff = 0;
    const size_t wlo = WS_W + (size_t)(s == 7 ? Lw : L) * WL_SIZE;
    if (s == 7) { wi = 5; woff = (size_t)Lw * DM * 2 * DFF; ldw = 2 * DFF; gi = 4; goff = Lw * DM; toff = wlo + WL_F1IN; nblk = 352; mapk = 1; }
    else if (s == 0) { wi = 6; woff = (size_t)L * DFF * DM; K = DFF; toff = wlo + WL_F1OUT; }
    else if (s == 1) {
        if (odd) { wi = 13; woff = (size_t)j * DM * 6144; ldw = 6144; gi = 7; goff = (2 * j + 1) * DM; toff = WS_WOD + (size_t)j * WO_SIZE + WO_WC; nblk = 192; mapk = 2; }
        else if (r < I_EIN) { wi = 8; woff = (size_t)j * DM * 3072 + 1024; ldw = 3072; gi = 7; goff = (2 * j) * DM;
            toff = WS_WE + (size_t)j * WE_SIZE + (((r & 63) * 32 < 1024) ? WE_WU : WE_WZ); }
        else { cv_fold_item(ap->in[8], ap->in[7], ws, j, r - I_EIN, scr, lane); return; } }
    else if (s == 2) { if (L == 0 && r < I_DG) { cv_dft_item(ws, r, lane); return; } cv_ws_item(ap->in[10], ws, j, L == 0 ? r - I_DG : r, lane); return; }
    else if (s == 3) {
        if (odd) { wi = 16; woff = (size_t)j * DM * DM; toff = WS_WOD + (size_t)j * WO_SIZE + WO_WOC; }
        else { wi = 12; woff = (size_t)j * DM * DM; toff = WS_WE + (size_t)j * WE_SIZE + WE_WO;
            if ((r >> 6) < 16) { tr_item_wofold(ap->in[12] + woff, (bf16*)(ws + toff), scr, (r >> 6) * 64, (r & 63) * 32, lane); return; } } }
    else if (s == 4) { wi = 18; woff = (size_t)L * DM * 2 * DFF; ldw = 2 * DFF; gi = 17; goff = L * DM; toff = wlo + WL_F2IN; nblk = 352; mapk = 1; }
    else if (s == 5) {
        if (r < I_FOUT) { wi = 19; woff = (size_t)L * DFF * DM; K = DFF; toff = wlo + WL_F2OUT; }
        else if (r < I_FOUT + I_WP) { r -= I_FOUT; wi = 22; woff = (size_t)L * 256 * DM; K = 256; toff = wlo + WL_WP; }
        else { cv_p_item(ap->in[2], ap->in[3], ws, L, r - I_FOUT - I_WP, lane); return; } }
    else { wi = 21; woff = (size_t)L * DM * DM; gi = 20; goff = L * DM; toff = wlo + WL_WG; }
    const int kb = nblk == 352 ? r / 352 : (nblk == 192 ? r / 192 : r >> 6), n0 = (r - kb * nblk) * 32;
    const int drow = mapk == 1 ? map_glu(n0) : (mapk == 2 ? map_oddin(n0) : n0);
    const float* W = ap->in[wi] + woff; const float* g = gi >= 0 ? ap->in[gi] + goff : (const float*)nullptr;
    tr_item(W, ldw, K, g, (bf16*)(ws + toff), drow, scr, kb * 64, n0, lane);
}

#ifndef MK_POOLWAIT
#define MK_POOLWAIT 1
#endif
__device__ __forceinline__ void pool_seam(const XcdBarrier& b, LAS unsigned char* lds, volatile LAS unsigned* ctl, unsigned target, bool do_barrier) {
    int tid_o = threadIdx.x; asm volatile("" : "+v"(tid_o)); const int lane = tid_o & 63, wave = __builtin_amdgcn_readfirstlane(tid_o >> 6);
    CArgs* ap = (CArgs*)__builtin_amdgcn_kernarg_segment_ptr(); asm volatile("" : "+s"(ap));
    constexpr unsigned EXIT = 0xFFFFFFFFu;
    unsigned slot = 0u;
    asm volatile("s_waitcnt vmcnt(0)" ::: "memory");
    __syncthreads();
    for (;;) {
        if (tid_o == 0) {
            unsigned* pool = (unsigned*)(ap->ws + WS_CTL) + CW_POOL; unsigned* bar = b.bar;
            unsigned bb = EXIT, st = ctl[2];
            if (st == 0u) {
                unsigned seen = ctl[0];
                if (seen < target) { seen = xb_ld(pool); if (seen < target) { bb = xb_add(pool, 8u); seen = bb + 8u; } ctl[0] = seen; }
                if (bb == EXIT && do_barrier) {
                    __builtin_amdgcn_s_waitcnt(0);
                    unsigned nloc = b.st[0], nx = b.st[1];
                    if (nloc == 0u) { xcd_barrier_complete(bar, b.x, nloc, nx); b.st[0] = nloc; b.st[1] = nx; }
                    const unsigned old = xb_add(&bar[XB_XSUB(b.x)], 1u);
                    const unsigned gen = old / nloc;
                    if (old + 1u == (gen + 1u) * nloc) {
                        __builtin_amdgcn_fence(__ATOMIC_RELEASE, "agent");
                        asm volatile("s_waitcnt vmcnt(0)" ::: "memory");
                        const unsigned og = xb_add(&bar[XB_TOP], 1u);
                        const unsigned tg = og / nx;
                        if (og + 1u == (tg + 1u) * nx) xb_add(&bar[XB_TOPGEN], 1u);
                        else XB_SPIN(xb_ld(&bar[XB_TOPGEN]) == tg, bar);
                        __builtin_amdgcn_fence(__ATOMIC_ACQUIRE, "agent");
                        xb_add(&bar[XB_XGEN(b.x)], 1u);
                        asm volatile("s_waitcnt vmcnt(0)" ::: "memory");
                    } else { st = gen + 1u; ctl[2] = st; }
                }
            }
            if (st != 0u) {
                if (MK_POOLWAIT && ctl[0] < POOL_NTOTAL && xb_ld(&bar[XB_XGEN(b.x)]) == st - 1u) { bb = xb_add(pool, 8u); ctl[0] = bb + 8u; }
                else bb = EXIT;
            }
            ctl[4 + slot] = bb;
        }
        __syncthreads();
        const unsigned bb = __builtin_amdgcn_readfirstlane(ctl[4 + slot]); slot ^= 1u;
        if (bb == EXIT) break;
        const unsigned it = bb + (unsigned)wave; if (it < POOL_NTOTAL) pool_item(ap, lds, wave, lane, it);
        asm volatile("s_waitcnt vmcnt(0)" ::: "memory");
        __syncthreads();
    }
    if (tid_o == 0) { const unsigned st = ctl[2];
        if (st != 0u) {
            XB_SPIN(xb_ld(&b.bar[XB_XGEN(b.x)]) == st - 1u, b.bar);
            __builtin_amdgcn_fence(__ATOMIC_ACQUIRE, "agent");
            asm volatile("s_waitcnt vmcnt(0)" ::: "memory");
            ctl[2] = 0u; } }
    __syncthreads();
}

__device__ __forceinline__ void sgu_phase(const bf16* Wsb, const float* bs, const bf16* VT, const bf16* U, bf16* Y, int idx, int n) {
    int tid_o = threadIdx.x; asm volatile("" : "+v"(tid_o)); const int lane = tid_o & 63, wave = __builtin_amdgcn_readfirstlane(tid_o >> 6);
    const int h = idx & 15, q = idx >> 4, nq = n >> 4, ct = wave & 3, th = wave >> 2, fr = lane & 15, fq = lane >> 4;
    if (idx < 0 || idx >= n || nq == 0) return;
    bf16x8 wf[4][4];
#pragma unroll
    for (int tt = 0; tt < 4; ++tt)
#pragma unroll
        for (int ks = 0; ks < 4; ++ks) wf[tt][ks] = *(const GAS bf16x8*)(Wsb + ((size_t)h * 128 + th * 64 + tt * 16 + fr) * 128 + ks * 32 + fq * 8);
    float bias[4];
#pragma unroll
    for (int tt = 0; tt < 4; ++tt) bias[tt] = bs[h * 128 + th * 64 + tt * 16 + fr];
    for (int ch = q; ch < T / 128; ch += nq) {
        bf16x8 vf[4];
#pragma unroll
        for (int ks = 0; ks < 4; ++ks) vf[ks] = *(const GAS bf16x8*)(VT + (size_t)(h * 64 + ct * 16 + fr) * T + (size_t)ch * 128 + ks * 32 + fq * 8);
#pragma unroll
        for (int tt = 0; tt < 4; ++tt) { f32x4 acc = (f32x4){0.f, 0.f, 0.f, 0.f};
#pragma unroll
            for (int ks = 0; ks < 4; ++ks) acc = __builtin_amdgcn_mfma_f32_16x16x32_bf16(vf[ks], wf[tt][ks], acc, 0, 0, 0);
            const size_t t = (size_t)ch * 128 + th * 64 + tt * 16 + fr; const int c = h * 64 + ct * 16 + fq * 4;
            const v2u uu = *(const GAS v2u*)(U + t * 1024 + c);
            v2u o; o.x = pk2(bflo(uu.x) * (acc[0] + bias[tt]), bfhi(uu.x) * (acc[1] + bias[tt])); o.y = pk2(bflo(uu.y) * (acc[2] + bias[tt]), bfhi(uu.y) * (acc[3] + bias[tt]));
            *(GAS v2u*)(Y + t * 2048 + 1024 + c) = o; }
    }
}
__device__ __forceinline__ void conv_phase(const bf16* Z, const bf16* GB, const float* wc, const float* bc, bf16* Y, int vcu, int G) {
    int tid_o = threadIdx.x; asm volatile("" : "+v"(tid_o)); const size_t gt = (size_t)vcu * 512 + tid_o, NGT = (size_t)G * 512;
    for (size_t e = gt; e < (size_t)T * 256; e += NGT) { const int t = (int)(e >> 8), c0 = (int)(e & 255) * 8;
        const int sp = t < TP ? (t & 2047) : (t - TP), sl = t < TP ? 2048 : 8192;
        const v4u zc = *(const GAS v4u*)(Z + (size_t)t * 2048 + c0), gb = *(const GAS v4u*)(GB + (size_t)t * 2048 + c0);
        v4u zm = (v4u){0u, 0u, 0u, 0u}, zp = (v4u){0u, 0u, 0u, 0u};
        if (sp > 0) zm = *(const GAS v4u*)(Z + (size_t)(t - 1) * 2048 + c0);
        if (sp < sl - 1) zp = *(const GAS v4u*)(Z + (size_t)(t + 1) * 2048 + c0);
        const f32x4 w0a = *(const GAS f32x4*)(wc + c0), w0b = *(const GAS f32x4*)(wc + c0 + 4), w1a = *(const GAS f32x4*)(wc + 2048 + c0), w1b = *(const GAS f32x4*)(wc + 2048 + c0 + 4), w2a = *(const GAS f32x4*)(wc + 4096 + c0), w2b = *(const GAS f32x4*)(wc + 4096 + c0 + 4);
        const f32x4 ba = *(const GAS f32x4*)(bc + c0), bb = *(const GAS f32x4*)(bc + c0 + 4);
        float y[8];
#pragma unroll
        for (int p = 0; p < 4; ++p) { const unsigned m = zm[p], c = zc[p], n = zp[p], g = gb[p]; const int i0 = 2 * p, i1 = 2 * p + 1;
            const float w0l = i0 < 4 ? w0a[i0] : w0b[i0 - 4], w0h = i1 < 4 ? w0a[i1] : w0b[i1 - 4], w1l = i0 < 4 ? w1a[i0] : w1b[i0 - 4], w1h = i1 < 4 ? w1a[i1] : w1b[i1 - 4];
            const float w2l = i0 < 4 ? w2a[i0] : w2b[i0 - 4], w2h = i1 < 4 ? w2a[i1] : w2b[i1 - 4], bl = i0 < 4 ? ba[i0] : bb[i0 - 4], bh = i1 < 4 ? ba[i1] : bb[i1 - 4];
            y[i0] = bflo(g) * (w0l * bflo(m) + w1l * bflo(c) + w2l * bflo(n) + bl);
            y[i1] = bfhi(g) * (w0h * bfhi(m) + w1h * bfhi(c) + w2h * bfhi(n) + bh); }
        v4u o; o.x = pk2(y[0], y[1]); o.y = pk2(y[2], y[3]); o.z = pk2(y[4], y[5]); o.w = pk2(y[6], y[7]);
        *(GAS v4u*)(Y + (size_t)t * 2048 + c0) = o; }
}
__device__ __forceinline__ void final_phase(float* out, const bf16* XBf, const pg8::stat_t* st, const float* gf, int vcu, int G) {
    int tid_o = threadIdx.x; asm volatile("" : "+v"(tid_o)); const int lane = tid_o & 63, gw = vcu * 8 + __builtin_amdgcn_readfirstlane(tid_o >> 6), NGW = G * 8;
    f32x4 g[4][2];
#pragma unroll
    for (int j = 0; j < 4; ++j) { g[j][0] = *(const GAS f32x4*)(gf + 512 * j + 8 * lane); g[j][1] = *(const GAS f32x4*)(gf + 512 * j + 8 * lane + 4); }
    for (int row = gw; row < T; row += NGW) { const float r = pg8::rinv_of(st, row); const bf16* xr = XBf + (size_t)row * DM + 8 * lane; float* orow = out + (size_t)row * DM + 8 * lane;
#pragma unroll
        for (int j = 0; j < 4; ++j) { const v4u w = *(const GAS v4u*)(xr + 512 * j); f32x4 a, b; a[0] = bflo(w.x); a[1] = bfhi(w.x); a[2] = bflo(w.y); a[3] = bfhi(w.y); b[0] = bflo(w.z); b[1] = bfhi(w.z); b[2] = bflo(w.w); b[3] = bfhi(w.w);
            *(GAS f32x4*)(orow + 512 * j) = a * r * g[j][0]; *(GAS f32x4*)(orow + 512 * j + 4) = b * r * g[j][1]; } }
}

__device__ __forceinline__ void dft_mid_rows(const bf16* ZTP, const bf16* ZTS, bf16* Y, int idx, int n) {
    int tid_o = threadIdx.x; asm volatile("" : "+v"(tid_o)); const int lane = tid_o & 63, wave = __builtin_amdgcn_readfirstlane(tid_o >> 6);
    if (idx < 0 || idx >= n) return;
    for (int it = idx * 8 + wave; it < 17 * 529; it += n * 8) { const int b = it / 529, col = it - 529 * b; const int S = b < 16 ? 2048 : 8192; const size_t row = (b < 16 ? (size_t)b * 2048 : (size_t)TP) + S / 2;
        if (col == 528) { unsigned zz = 0u; asm volatile("" : "+v"(zz)); v4u z4; z4.x = zz; z4.y = zz; z4.z = zz; z4.w = zz;
            if (lane < 62) *(GAS v4u*)(Y + row * 2048 + 528 + 8 * lane) = z4; continue; }
        const bf16* z = b < 16 ? ZTP + ((size_t)b * 1024 + col) * 2048 : ZTS + (size_t)col * 8192; float sum = 0.f;
        for (int s0 = lane * 8; s0 < S; s0 += 512) { const v4u w = *(const GAS v4u*)(z + s0);
            sum += (bflo(w.x) - bfhi(w.x)) + (bflo(w.y) - bfhi(w.y)) + (bflo(w.z) - bfhi(w.z)) + (bflo(w.w) - bfhi(w.w)); }
        sum = wave_sum(sum);
        if (lane == 0) Y[row * 2048 + col] = (bf16)f2bf(sum * (b < 16 ? 0.0027621358640099515f : 0.0013810679320049757f)); }
}
struct DftOrder {
    int nM, ntile, tile0, nunits, n, c;
    __device__ __forceinline__ void init(int nM_, int ntile_, int tile0_, int nbatch, int lo, int n_, int rot, int bx) { nM = nM_; ntile = ntile_; tile0 = tile0_; nunits = nM_ * ntile_ * nbatch; n = n_; c = (bx >= lo && bx < lo + n_) ? (bx - lo + rot) % n_ : 0x40000000; }
    __device__ __forceinline__ bool next(int i, pg8::Unit& u) const { const long L = (long)i * n + c; if (L >= nunits) return false; const int l = (int)L, r = l / nM; u.pm = l - r * nM; u.pn = 4 * (r / ntile) + tile0 + r % ntile; return true; }
    __device__ __forceinline__ void a_ready(const pg8::Unit&) const {}
    __device__ __forceinline__ void done(const pg8::Unit&) const {}
};
struct DirOrder : pg8::StaticOrder {
    bool rev;
    __device__ __forceinline__ void init_dir(int M, int N, int G_, int c_, bool rev_) { init(M, N, G_, c_); rev = rev_; }
    __device__ __forceinline__ bool next(int i, pg8::Unit& u) const {
        const long L = (long)i * G + c; if (L >= nwg) return false;
        const int q = nwg / pg8::NXCD, r = nwg % pg8::NXCD; int wgid = (int)L; const int xcd = wgid % pg8::NXCD, off = wgid / pg8::NXCD;
        const int len = xcd < r ? q + 1 : q, base = xcd < r ? xcd * (q + 1) : r * (q + 1) + (xcd - r) * q;
        wgid = base + (rev ? len - 1 - off : off);
        const int nig = pg8::WGM * nN, gid = wgid / nig, fm = gid * pg8::WGM, gsz = (nM - fm) < pg8::WGM ? (nM - fm) : pg8::WGM;
        u.pm = fm + ((wgid % nig) % gsz); u.pn = (wgid % nig) / gsz; return true;
    }
};
struct RangeOrder : pg8::StaticOrder {
    __device__ __forceinline__ void init_range(int M, int N, int lo, int n, int bx) { const int c_ = (bx >= lo && bx < lo + n) ? bx - lo : 0x40000000; init(M, N, n, c_); }
};

#ifndef MK_SITES
#define MK_SITES 0xFFFFFFFFu
#endif
#define SITE(n) (((MK_SITES) >> (n)) & 1u)
#ifndef MK_DUP
#define MK_DUP 0u
#endif
#define NREP(n) ((((MK_DUP) >> (n)) & 1u) ? 2 : 1)
#define DRY(n) (NREP(n) == 2 && rep == 0)
struct SameTileOrder : pg8::StaticOrder {
    __device__ bool next(int i, pg8::Unit& u) const { const bool r = pg8::StaticOrder::next(i, u); u.pm = 0; u.pn = 0; return r; }
};
#define OPAQUE_WS() unsigned char* wsl = ws; asm volatile("" : "+s"(wsl)); unsigned char* const wl = wsl + WS_W + (size_t)L * WL_SIZE; bf16* const xb = (bf16*)(wsl + ((L & 1) ? WS_XB1 : WS_XB0)); bf16* const xalt = (bf16*)(wsl + ((L & 1) ? WS_XB0 : WS_XB1)); bf16* const Hb = (bf16*)(wsl + WS_H); (void)wl; (void)xb; (void)xalt; (void)Hb
#ifndef MK_DIR
#define MK_DIR 1
#endif
#define PH_REV(k) ((MK_DIR) != 0 && ((k) & 1) != 0)
__global__ void __launch_bounds__(512, 2) mk_fwd(Args args) {
    extern __shared__ __attribute__((aligned(16))) unsigned char lds_raw[];
    LAS unsigned char* lds = (LAS unsigned char*)lds_raw;
    const int tid = threadIdx.x, lane = tid & 63, wave = __builtin_amdgcn_readfirstlane(tid >> 6);
    const int G = gridDim.x, bx = blockIdx.x;
    const int vcu = (G % 8 == 0) ? (bx % 8) * (G / 8) + bx / 8 : bx;
    unsigned char* ws = args.ws;
    volatile LAS unsigned* MISC = (volatile LAS unsigned*)(lds + LDSCTL_OFF);
    for (int u = tid; u < (LDS_BYTES - LDSCTL_OFF) / 4; u += 512) ((LAS unsigned*)(lds + LDSCTL_OFF))[u] = 0u;
    __syncthreads();
    XcdBarrier bar; bar.bar = (unsigned*)(ws + WS_CTL) + CW_BAR; bar.x = 0; bar.st = nullptr;
    if (MK_N_LAUNCHES == 1) bar = xcd_barrier_post((unsigned*)(ws + WS_CTL) + CW_BAR, MISC + 8);
    const int lo = args.ph_lo, hi = args.ph_hi;
#define IN(k) (lo <= (k) && (k) < hi)
    volatile LAS unsigned* pctl = MISC + 16;
#define SEAMT(k, tgt) do { if (IN(k) && IN((k) + 1)) pool_seam(bar, lds, pctl, (tgt), true); } while (0)
#define SEAM(k) SEAMT(pb0 + (k), pool_target(L, (k)))
    pg8::stat_t* stats = (pg8::stat_t*)(ws + WS_STATS); pg8::stat_t* st_dummy = stats + (size_t)17 * T;

    if (IN(0) && MK_N_LAUNCHES != 1) pool_seam(bar, lds, pctl, POOL_NTOTAL, false);
    SEAMT(0, (unsigned)POOL_NA);

#pragma unroll 1
    for (int L = 0; L < NLAYER; ++L) {
        const int pb0 = 1 + 8 * L, j = L >> 1; const bool odd = (L & 1) != 0;
        pg8::stat_t* st0 = stats + (size_t)(4 * L + 0) * T; pg8::stat_t* st1 = stats + (size_t)(4 * L + 1) * T; pg8::stat_t* st2 = stats + (size_t)(4 * L + 2) * T; pg8::stat_t* st3 = stats + (size_t)(4 * L + 3) * T; pg8::stat_t* st4 = stats + (size_t)(4 * L + 4) * T;
        { OPAQUE_WS();
#ifdef MK_NULLP
        if (IN(pb0 + 0) && (MK_NULLP & 4)) { pg8::Gemm g{xb, (const bf16*)(wl + WL_F1IN), T, 2 * DFF, DM}; SameTileOrder S; S.init(T, 2 * DFF, G, bx);
            pg8::EpiNull E{(float*)st_dummy}; pg8::gemm_phase<pg8::EpiNull, SameTileOrder, MK_ALIGN, MK_SP2>(lds, g, S, E); }
        if (IN(pb0 + 0) && (MK_NULLP & 1)) { pg8::Gemm g{xb, (const bf16*)(wl + WL_F1IN), T, 2 * DFF, DM}; pg8::StaticOrder S; S.init(T, 2 * DFF, G, bx);
            pg8::EpiNull E{(float*)st_dummy}; pg8::gemm_phase<pg8::EpiNull, pg8::StaticOrder, MK_ALIGN, MK_SP2>(lds, g, S, E); }
        if (IN(pb0 + 1) && (MK_NULLP & 2)) { pg8::Gemm g{(const bf16*)(wsl + WS_H), (const bf16*)(wl + WL_F1OUT), T, DM, DFF}; pg8::StaticOrder S; S.init(T, DM, G, bx);
            pg8::EpiNull E{(float*)st_dummy}; pg8::gemm_phase<pg8::EpiNull, pg8::StaticOrder, MK_ALIGN, MK_SP2>(lds, g, S, E); }
#endif
        if (IN(pb0 + 0) && SITE(1)) for (int rep = 0; rep < NREP(1); ++rep) { pg8::Gemm g{xb, (const bf16*)(wl + WL_F1IN), T, 2 * DFF, DM}; DirOrder S; S.init_dir(T, 2 * DFF, G, bx, PH_REV(0));
            pg8::EpiSwiGLU E{Hb, DFF, st0}; pg8::gemm_phase<pg8::EpiSwiGLU, DirOrder, MK_ALIGN, MK_SP2>(lds, g, S, E); }
        }
        SEAM(0);
        { OPAQUE_WS();
        if (IN(pb0 + 1) && SITE(2)) for (int rep = 0; rep < NREP(2); ++rep) { pg8::Gemm g{Hb, (const bf16*)(wl + WL_F1OUT), T, DM, DFF}; DirOrder S; S.init_dir(T, DM, G, bx, PH_REV(1));
            pg8::EpiRmw<0> E{xb, xb, nullptr, DRY(2) ? st_dummy : st1, DRY(2) ? 0.0f : 0.5f}; pg8::gemm_phase<pg8::EpiRmw<0>, DirOrder, MK_ALIGN, MK_SP2>(lds, g, S, E); }
        }
        SEAM(1);
        { OPAQUE_WS();
        if (IN(pb0 + 2)) {
            if (!odd) { unsigned char* we = wsl + WS_WE + (size_t)j * WE_SIZE;
                if (SITE(3)) for (int rep = 0; rep < NREP(3); ++rep) { pg8::Gemm g{(const bf16*)(we + WE_WZ), xb, 2048, T, DM}; DirOrder S; S.init_dir(2048, T, G, bx, PH_REV(2));
                  pg8::EpiMT E{(bf16*)(wsl + WS_ZTP), (bf16*)(wsl + WS_ZTS), (bf16*)(wsl + WS_VT), st1, args.in[9] + j * 1024};
                  pg8::gemm_phase<pg8::EpiMT, DirOrder, MK_ALIGN, MK_SP2>(lds, g, S, E); }
                if (SITE(4)) for (int rep = 0; rep < NREP(4); ++rep) { pg8::Gemm g{xb, (const bf16*)(we + WE_WU), T, 1024, DM}; DirOrder S; S.init_dir(T, 1024, G, (bx + G / 2) % G, PH_REV(2));
                  pg8::EpiRowBf16<1> E{(bf16*)(wsl + WS_U), 1024, st1}; pg8::gemm_phase<pg8::EpiRowBf16<1>, DirOrder, MK_ALIGN, MK_SP2>(lds, g, S, E); }
            } else if (SITE(5)) for (int rep = 0; rep < NREP(5); ++rep) { unsigned char* wo = wsl + WS_WOD + (size_t)j * WO_SIZE;
                pg8::Gemm g{xb, (const bf16*)(wo + WO_WC), T, 6144, DM}; DirOrder S; S.init_dir(T, 6144, G, bx, PH_REV(2));
                pg8::EpiOddIn E{(bf16*)(wsl + WS_Z), (bf16*)(wsl + WS_GB), st1}; pg8::gemm_phase<pg8::EpiOddIn, DirOrder, MK_ALIGN, MK_SP2>(lds, g, S, E); }
        }
        }
        SEAM(2);
        { OPAQUE_WS();
        if (IN(pb0 + 3)) {
            if (!odd) { unsigned char* we = wsl + WS_WE + (size_t)j * WE_SIZE;
                const bool tuned = (G == 256); const int s_lo = 0, sp_n = tuned ? 48 : G, sq_lo = tuned ? 48 : 0, sq_n = tuned ? 32 : G, p_lo = tuned ? 80 : 0, p_n = tuned ? 176 : G;
                const bf16* dpc = (const bf16*)(wsl + WS_DP); const bf16* dps = dpc + (size_t)1024 * 2048; const bf16* dsc = (const bf16*)(wsl + WS_DS); const bf16* dss = dsc + (size_t)4096 * 8192;
                if (SITE(7)) for (int rep = 0; rep < NREP(7); ++rep) {
                  { pg8::Gemm g{dsc, (const bf16*)(wsl + WS_ZTS), 4096, 1024, 8192}; DftOrder S; S.init(16, 3, 0, 1, s_lo, sp_n, 0, bx);
                    pg8::EpiDFT E{xalt, TP, 8192, 0.0013810679320049757f, 1.0f, 0, 528}; pg8::gemm_phase<pg8::EpiDFT, DftOrder, MK_ALIGN, MK_SP2>(lds, g, S, E); }
                  { pg8::Gemm g{dss, (const bf16*)(wsl + WS_ZTS), 4096, 1024, 8192}; DftOrder S; S.init(16, 2, 2, 1, sq_lo, sq_n, 0, bx);
                    pg8::EpiDFT E{xalt, TP, 8192, 0.0013810679320049757f, -1.0f, 528, 1024}; pg8::gemm_phase<pg8::EpiDFT, DftOrder, MK_ALIGN, MK_SP2>(lds, g, S, E); } }
                if (SITE(6)) for (int rep = 0; rep < NREP(6); ++rep) {
                  { pg8::Gemm g{dpc, (const bf16*)(wsl + WS_ZTP), 1024, 16 * 1024, 2048}; DftOrder S; S.init(4, 3, 0, 16, p_lo, p_n, 0, bx);
                    pg8::EpiDFT E{xalt, 0, 2048, 0.0027621358640099515f, 1.0f, 0, 528}; pg8::gemm_phase<pg8::EpiDFT, DftOrder, MK_ALIGN, MK_SP2>(lds, g, S, E); }
                  { pg8::Gemm g{dps, (const bf16*)(wsl + WS_ZTP), 1024, 16 * 1024, 2048}; DftOrder S; S.init(4, 2, 2, 16, p_lo, p_n, tuned ? 160 : 0, bx);
                    pg8::EpiDFT E{xalt, 0, 2048, 0.0027621358640099515f, -1.0f, 528, 1024}; pg8::gemm_phase<pg8::EpiDFT, DftOrder, MK_ALIGN, MK_SP2>(lds, g, S, E); } }
                dft_mid_rows((const bf16*)(wsl + WS_ZTP), (const bf16*)(wsl + WS_ZTS), xalt, tuned ? bx : bx, tuned ? 80 : G);
                if (SITE(8)) for (int rep = 0; rep < NREP(8); ++rep) sgu_phase((const bf16*)(we + WE_WS), args.in[11] + j * 2048, (const bf16*)(wsl + WS_VT), (const bf16*)(wsl + WS_U), xalt, bx - p_lo, p_n & ~15);
            } else if (SITE(9)) for (int rep = 0; rep < NREP(9); ++rep) {
                conv_phase((const bf16*)(wsl + WS_Z), (const bf16*)(wsl + WS_GB), args.in[14] + j * 3 * 2048, args.in[15] + j * 2048, xalt, vcu, G);
            }
        }
        }
        SEAM(3);
        { OPAQUE_WS();
        if (IN(pb0 + 4) && SITE(10)) for (int rep = 0; rep < NREP(10); ++rep) { const bf16* wout = odd ? (const bf16*)(wsl + WS_WOD + (size_t)j * WO_SIZE + WO_WOC) : (const bf16*)(wsl + WS_WE + (size_t)j * WE_SIZE + WE_WO);
            pg8::Gemm g{xalt, wout, T, DM, DM}; DirOrder S; S.init_dir(T, DM, G, bx, PH_REV(4));
            pg8::EpiRmw<0> E{xb, xb, nullptr, DRY(10) ? st_dummy : st2, DRY(10) ? 0.0f : 1.0f}; pg8::gemm_phase<pg8::EpiRmw<0>, DirOrder, MK_ALIGN, MK_SP2>(lds, g, S, E); }
        }
        SEAM(4);
        { OPAQUE_WS();
        if (IN(pb0 + 5) && SITE(11)) for (int rep = 0; rep < NREP(11); ++rep) { pg8::Gemm g{xb, (const bf16*)(wl + WL_F2IN), T, 2 * DFF, DM}; DirOrder S; S.init_dir(T, 2 * DFF, G, bx, PH_REV(5));
            pg8::EpiSwiGLU E{Hb, DFF, st2}; pg8::gemm_phase<pg8::EpiSwiGLU, DirOrder, MK_ALIGN, MK_SP2>(lds, g, S, E); }
        }
        SEAM(5);
        { OPAQUE_WS();
        if (IN(pb0 + 6)) {
            if (SITE(12)) for (int rep = 0; rep < NREP(12); ++rep) { pg8::Gemm g{Hb, (const bf16*)(wl + WL_F2OUT), T, DM, DFF}; DirOrder S; S.init_dir(T, DM, G, bx, PH_REV(6));
              pg8::EpiRmw<0> E{xb, xb, nullptr, DRY(12) ? st_dummy : st3, DRY(12) ? 0.0f : 0.5f}; pg8::gemm_phase<pg8::EpiRmw<0>, DirOrder, MK_ALIGN, MK_SP2>(lds, g, S, E); }
            if (SITE(13)) for (int rep = 0; rep < NREP(13); ++rep) { int kpe = 256; asm volatile("" : "+s"(kpe));
              pg8::Gemm g{(const bf16*)(wsl + WS_PB) + (size_t)L * T * 256, (const bf16*)(wl + WL_WP), T, DM, kpe}; DirOrder S; S.init_dir(T, DM, G, bx, PH_REV(6));
              pg8::EpiRowBf16<0> E{xalt, 2048, nullptr}; pg8::gemm_phase<pg8::EpiRowBf16<0>, DirOrder, MK_ALIGN, MK_SP2>(lds, g, S, E); }
        }
        }
        SEAM(6);
        { OPAQUE_WS();
        if (IN(pb0 + 7) && SITE(14)) for (int rep = 0; rep < NREP(14); ++rep) { pg8::Gemm g{xb, (const bf16*)(wl + WL_WG), T, DM, DM}; DirOrder S; S.init_dir(T, DM, G, bx, PH_REV(7));
            pg8::EpiRmw<1> E{xb, xalt, st3, DRY(14) ? st_dummy : st4, DRY(14) ? 0.0f : 1.0f}; pg8::gemm_phase<pg8::EpiRmw<1>, DirOrder, MK_ALIGN, MK_SP2>(lds, g, S, E); }
        }
        SEAM(7);
    }
    if (IN(33) && SITE(15)) final_phase(args.out, (const bf16*)(ws + WS_XB0), stats + (size_t)16 * T, args.in[23], vcu, G);
#undef IN
#undef SEAM
#undef SEAMT
}

extern "C" void kernel_launch(void* const* d_in, const int* in_sizes, int n_in, void* d_out, int out_size, void* d_ws, size_t ws_size, hipStream_t stream) {
    static int grid = 0;
    if (grid == 0) {
        if (n_in != 24 || out_size != T * DM || ws_size < WS_END) { fprintf(stderr, "kernel_launch: unexpected sizes (n_in %d, out %d, ws %zu, need %zu); nothing launched\n", n_in, out_size, ws_size, (size_t)WS_END); grid = -1; return; }
        int dev = 0, cus = 0, per_cu = 0;
        if (hipGetDevice(&dev) != hipSuccess || hipDeviceGetAttribute(&cus, hipDeviceAttributeMultiprocessorCount, dev) != hipSuccess) { grid = -1; return; }
        if (hipFuncSetAttribute((const void*)mk_fwd, hipFuncAttributeMaxDynamicSharedMemorySize, LDS_BYTES) != hipSuccess) { fprintf(stderr, "kernel_launch: hipFuncSetAttribute failed\n"); grid = -1; return; }
        if (hipOccupancyMaxActiveBlocksPerMultiprocessor(&per_cu, (const void*)mk_fwd, 512, LDS_BYTES) != hipSuccess || per_cu < 1) fprintf(stderr, "kernel_launch: occupancy query reports %d workgroups per CU\n", per_cu);
        (void)hipGetLastError();
        grid = cus;
    }
    if (grid < 0) return;
#ifdef MK_POISON_WS
    if (hipMemsetAsync((char*)d_ws, 0xFF, WS_END, stream) != hipSuccess) return;
#endif
    if (hipMemsetAsync((char*)d_ws + WS_CTL, 0, CTL_BYTES, stream) != hipSuccess) return;
    Args a{};
    for (int i = 0; i < 24; ++i) a.in[i] = (const float*)d_in[i];
    a.out = (float*)d_out; a.ws = (unsigned char*)d_ws;
    if (MK_N_LAUNCHES == 1) { a.ph_lo = 0; a.ph_hi = NPHASE; hipLaunchKernelGGL(mk_fwd, dim3(grid), dim3(512), LDS_BYTES, stream, a); }
    else for (int p = 0; p < NPHASE; ++p) { a.ph_lo = p; a.ph_hi = p + 1; hipLaunchKernelGGL(mk_fwd, dim3(grid), dim3(512), LDS_BYTES, stream, a); }
}
```

```cpp
#include <hip/hip_runtime.h>
#include <cstdio>
#include <cstdint>
#ifndef MK_WGM
#define MK_WGM 4
#endif
#ifndef MK_SP2
#define MK_SP2 true
#endif
#ifndef MK_ALIGN
#define MK_ALIGN true
#endif
namespace pg8 {
#define PG8_LAS __attribute__((address_space(3)))
typedef unsigned short bf16_t;
typedef short bf16x8 __attribute__((ext_vector_type(8)));
typedef float f32x4 __attribute__((ext_vector_type(4)));
typedef unsigned u32x4 __attribute__((ext_vector_type(4)));
constexpr int BM = 256, BK = 64, HALF = 128, HTB = HALF * BK * 2  , STAGE_BYTES = 8 * HTB, NXCD = 8, WGM = MK_WGM;

__host__ __device__ __forceinline__ int lds_byte(int r, int c) { const int st = (r >> 4) * 2 + (c >> 5), rr = r & 15, cc = c & 31, ob = rr * 64 + cc * 2; return st * 1024 + (ob ^ (((ob >> 9) & 1) << 5)); }
__host__ __device__ __forceinline__ void stage_rc(int b, int& R, int& C) { const int st = b / 1024, sb = b % 1024, swz = sb ^ (((sb >> 9) & 1) << 5); R = (st >> 1) * 16 + swz / 64; C = (st & 1) * 32 + (swz % 64) / 2; }
__host__ __device__ __forceinline__ int perm32(int rho) { const int n = rho >> 4, i = rho & 15; return 8 * (i >> 2) + 4 * n + (i & 3); }

struct Unit { int pm, pn; };
struct Gemm { const bf16_t* A; const bf16_t* Bt; int M, N, K; };

struct StaticOrder {
    int nM, nN, nwg, G, c;
    __host__ __device__ __forceinline__ void init(int M, int N, int G_, int c_) { nM = M / BM; nN = N / BM; nwg = nM * nN; G = G_; c = c_; }
    __host__ __device__ __forceinline__ bool next(int i, Unit& u) const {
        const long L = (long)i * G + c; if (L >= nwg) return false;
        int wgid = (int)L; { const int q = nwg / NXCD, r = nwg % NXCD, xcd = wgid % NXCD, off = wgid / NXCD; wgid = (xcd < r ? xcd * (q + 1) : r * (q + 1) + (xcd - r) * q) + off; }
        const int nig = WGM * nN, gid = wgid / nig, fm = gid * WGM, gsz = (nM - fm) < WGM ? (nM - fm) : WGM;
        u.pm = fm + ((wgid % nig) % gsz); u.pn = (wgid % nig) / gsz; return true;
    }
    __device__ __forceinline__ void a_ready(const Unit&) const {}
    __device__ __forceinline__ void done(const Unit&) const {}
};

__device__ __forceinline__ unsigned cvt_pk_bf16(float lo, float hi) { unsigned r; asm volatile("v_cvt_pk_bf16_f32 %0, %1, %2" : "=v"(r) : "v"(lo), "v"(hi)); return r; }
typedef float f32x2 __attribute__((ext_vector_type(2)));
__device__ __forceinline__ f32x2 gelu_pk(f32x2 v) {
    const f32x2 av = __builtin_elementwise_abs(v), d = av * 0.2316418882f + 1.0f;
    f32x2 t; t.x = __builtin_amdgcn_rcpf(d.x); t.y = __builtin_amdgcn_rcpf(d.y);
    f32x2 q = t * 0.5307027145f + (-0.7265760135f); q = q * t + 0.7107068705f; q = q * t + (-0.142248368f); q = q * t + 0.127414796f; q = q * t;
    const f32x2 s = (v * v) * (-0.72134752044f);
    f32x2 e; e.x = __builtin_amdgcn_exp2f(s.x); e.y = __builtin_amdgcn_exp2f(s.y);
    const f32x2 m = v * (q * e), r = v - m;
    f32x2 o; o.x = v.x < 0.f ? m.x : r.x; o.y = v.y < 0.f ? m.y : r.y; return o;
}

template <class Epi, class Sched, bool ALIGN_EPI = false, bool SP2 = false>
__device__ __forceinline__ void gemm_phase(PG8_LAS unsigned char* lds, const Gemm g, const Sched& S, const Epi& E) {
    int tid_o = threadIdx.x; asm volatile("" : "+v"(tid_o));
    const int tid = tid_o, wid = __builtin_amdgcn_readfirstlane(tid >> 6), lane = tid & 63, wr = wid >> 2, wc = wid & 3, fr = lane & 15, fq = lane >> 4;
    const int K = g.K, nt = K / BK;
    unsigned voffA[2], voffB[2];
#pragma unroll
    for (int i = 0; i < 2; ++i) { int R, C; stage_rc(tid * 16 + i * 8192, R, C); const int Rb = Epi::PERM ? ((R & ~31) + perm32(R & 31)) : R;
        voffA[i] = (unsigned)(R * K + C) * 2u; voffB[i] = (unsigned)(Rb * K + C) * 2u; }
    const unsigned kstep = (unsigned)(BK * 2);
    const unsigned hstep = (unsigned)HALF * (unsigned)K * 2u;
    const unsigned tstep = 2u * hstep;
    const unsigned ldsw = (unsigned)wid * 1024u;
    const int aoff = lds_byte(wr * 64 + fr, fq * 8), boff = lds_byte(wc * 32 + fr, fq * 8);
#define PG8_SA(b, h) (((b) * 2 + (h)) * HTB)
#define PG8_SB(b, h) ((4 + (b) * 2 + (h)) * HTB)
    const __amdgpu_buffer_rsrc_t rs_voffA = __builtin_amdgcn_make_buffer_rsrc((void*)g.A, (short)0, -1, 0x00020000);
    const __amdgpu_buffer_rsrc_t rs_voffB = __builtin_amdgcn_make_buffer_rsrc((void*)g.Bt, (short)0, -1, 0x00020000);
#define PG8_STAGE(bufoff, gbase, voff) do { _Pragma("unroll") for (int _i = 0; _i < 2; ++_i) \
        __builtin_amdgcn_raw_ptr_buffer_load_lds(rs_##voff, (PG8_LAS void*)(lds + (bufoff) + ldsw + _i * 8192), 16, (int)(voff)[_i], (int)(gbase), 0, 0); } while (0)
#define PG8_LDA(dst, b, h) do { _Pragma("unroll") for (int m = 0; m < 4; ++m) _Pragma("unroll") for (int k = 0; k < 2; ++k) dst[m][k] = *(const PG8_LAS bf16x8*)(lds + PG8_SA(b, h) + aoff + m * 2048 + k * 1024); } while (0)
#define PG8_LDB(dst, b, h) do { _Pragma("unroll") for (int n = 0; n < 2; ++n) _Pragma("unroll") for (int k = 0; k < 2; ++k) dst[n][k] = *(const PG8_LAS bf16x8*)(lds + PG8_SB(b, h) + boff + n * 2048 + k * 1024); } while (0)
#define PG8_MMA(ai, bj, At, Bt) do { __builtin_amdgcn_s_setprio(1); _Pragma("unroll") for (int m = 0; m < 4; ++m) _Pragma("unroll") for (int n = 0; n < 2; ++n) _Pragma("unroll") for (int k = 0; k < 2; ++k) \
        acc[ai][bj][m][n] = __builtin_amdgcn_mfma_f32_16x16x32_bf16(Bt[n][k], At[m][k], acc[ai][bj][m][n], 0, 0, 0); __builtin_amdgcn_s_setprio(0); } while (0)
#define PG8_WAIT_V(n) asm volatile("s_waitcnt vmcnt(" #n ")" ::: "memory")
#define PG8_WAIT_L(n) asm volatile("s_waitcnt lgkmcnt(" #n ")" ::: "memory")
#define PG8_BAR __builtin_amdgcn_s_barrier()
#define PG8_SCHED __builtin_amdgcn_sched_barrier(0)
    Unit cur, nxt; int ui = 0;
    if (!S.next(0, cur)) return;
    f32x4 acc[2][2][4][2];
#pragma unroll
    for (int a = 0; a < 2; ++a)
#pragma unroll
        for (int b = 0; b < 2; ++b)
#pragma unroll
            for (int m = 0; m < 4; ++m)
#pragma unroll
                for (int n = 0; n < 2; ++n) acc[a][b][m][n] = (f32x4){0.f, 0.f, 0.f, 0.f};
    bf16x8 At[4][2], B0[2][2], B1[2][2];
    unsigned cA = (unsigned)cur.pm * tstep, cB = (unsigned)cur.pn * tstep;
    S.a_ready(cur);
    if constexpr (SP2) {
        PG8_STAGE(PG8_SB(0, 0), cB, voffB); PG8_STAGE(PG8_SB(0, 1), cB + hstep, voffB); PG8_STAGE(PG8_SA(0, 0), cA, voffA); PG8_STAGE(PG8_SA(0, 1), cA + hstep, voffA);
        if (wr == 1) PG8_BAR;
        PG8_WAIT_V(2); PG8_BAR;
        PG8_STAGE(PG8_SB(1, 0), cB + kstep, voffB); PG8_STAGE(PG8_SA(1, 0), cA + kstep, voffA); PG8_STAGE(PG8_SB(1, 1), cB + hstep + kstep, voffB);
        PG8_WAIT_V(6); PG8_BAR;
    } else {
        PG8_STAGE(PG8_SB(0, 0), cB, voffB); PG8_STAGE(PG8_SA(0, 0), cA, voffA); PG8_STAGE(PG8_SB(0, 1), cB + hstep, voffB); PG8_STAGE(PG8_SA(0, 1), cA + hstep, voffA);
        if (wr == 1) PG8_BAR;
        PG8_WAIT_V(4); PG8_BAR;
        PG8_STAGE(PG8_SB(1, 0), cB + kstep, voffB); PG8_STAGE(PG8_SA(1, 0), cA + kstep, voffA); PG8_STAGE(PG8_SB(1, 1), cB + hstep + kstep, voffB);
        PG8_WAIT_V(6); PG8_BAR;
    }
    for (;;) {
        const bool has_next = S.next(ui + 1, nxt);
        const unsigned nA = has_next ? (unsigned)nxt.pm * tstep : cA, nB = has_next ? (unsigned)nxt.pn * tstep : cB;
        for (int t = 0; t < nt; t += 2) {
            const bool last = (t == nt - 2);
            const unsigned a1 = cA + (unsigned)(t + 1) * kstep;
            const unsigned a2 = last ? nA : cA + (unsigned)(t + 2) * kstep, b2 = last ? nB : cB + (unsigned)(t + 2) * kstep;
            const unsigned a3 = a2 + kstep, b3 = b2 + kstep;
            if (last && has_next) S.a_ready(nxt);
            if constexpr (SP2) {
            PG8_LDB(B0, 0, 0); PG8_LDB(B1, 0, 1); PG8_SCHED; PG8_LDA(At, 0, 0); PG8_STAGE(PG8_SA(1, 1), a1 + hstep, voffA);
            PG8_WAIT_V(8); PG8_WAIT_L(0); PG8_BAR; PG8_MMA(0, 0, At, B0); PG8_MMA(0, 1, At, B1); PG8_BAR; PG8_SCHED;
            PG8_LDA(At, 0, 1); PG8_STAGE(PG8_SB(0, 0), b2, voffB); PG8_STAGE(PG8_SB(0, 1), b2 + hstep, voffB); PG8_STAGE(PG8_SA(0, 0), a2, voffA);
            PG8_WAIT_V(8); PG8_WAIT_L(0); PG8_BAR; PG8_MMA(1, 0, At, B0); PG8_MMA(1, 1, At, B1); PG8_BAR; PG8_SCHED;
            PG8_LDB(B0, 1, 0); PG8_LDB(B1, 1, 1); PG8_SCHED; PG8_LDA(At, 1, 0); PG8_STAGE(PG8_SA(0, 1), a2 + hstep, voffA);
            PG8_WAIT_V(8); PG8_WAIT_L(0); PG8_BAR; PG8_MMA(0, 0, At, B0); PG8_MMA(0, 1, At, B1); PG8_BAR; PG8_SCHED;
            PG8_LDA(At, 1, 1); PG8_STAGE(PG8_SB(1, 0), b3, voffB); PG8_STAGE(PG8_SB(1, 1), b3 + hstep, voffB); PG8_STAGE(PG8_SA(1, 0), a3, voffA);
            PG8_WAIT_V(8); PG8_WAIT_L(0); PG8_BAR; PG8_MMA(1, 0, At, B0); PG8_MMA(1, 1, At, B1); PG8_BAR; PG8_SCHED;
            } else {
            PG8_LDB(B0, 0, 0); PG8_SCHED; PG8_LDA(At, 0, 0); PG8_STAGE(PG8_SA(1, 1), a1 + hstep, voffA);
            PG8_WAIT_L(8); PG8_BAR; PG8_WAIT_L(0); PG8_MMA(0, 0, At, B0); PG8_BAR; PG8_SCHED;
            PG8_LDB(B1, 0, 1); PG8_STAGE(PG8_SB(0, 0), b2, voffB);
            PG8_BAR; PG8_WAIT_L(0); PG8_MMA(0, 1, At, B1); PG8_BAR;
            PG8_LDA(At, 0, 1); PG8_STAGE(PG8_SA(0, 0), a2, voffA);
            PG8_BAR; PG8_WAIT_L(0); PG8_MMA(1, 0, At, B0); PG8_BAR; PG8_SCHED;
            PG8_STAGE(PG8_SB(0, 1), b2 + hstep, voffB);
            PG8_WAIT_V(6); PG8_BAR; PG8_MMA(1, 1, At, B1); PG8_BAR;
            PG8_LDB(B0, 1, 0); PG8_SCHED; PG8_LDA(At, 1, 0); PG8_STAGE(PG8_SA(0, 1), a2 + hstep, voffA);
            PG8_WAIT_L(8); PG8_BAR; PG8_WAIT_L(0); PG8_MMA(0, 0, At, B0); PG8_BAR; PG8_SCHED;
            PG8_LDB(B1, 1, 1); PG8_STAGE(PG8_SB(1, 0), b3, voffB);
            PG8_BAR; PG8_WAIT_L(0); PG8_MMA(0, 1, At, B1); PG8_BAR;
            PG8_LDA(At, 1, 1); PG8_STAGE(PG8_SA(1, 0), a3, voffA);
            PG8_BAR; PG8_WAIT_L(0); PG8_MMA(1, 0, At, B0); PG8_BAR; PG8_SCHED;
            PG8_STAGE(PG8_SB(1, 1), b3 + hstep, voffB);
            PG8_WAIT_V(6); PG8_BAR; PG8_MMA(1, 1, At, B1); PG8_BAR;
            }
        }
        if constexpr (ALIGN_EPI) { if (wr == 0) PG8_BAR; }
        if constexpr (!Epi::AFTER_DRAIN) { E(acc, cur, wr, wc, fr, fq); S.done(cur); }
        if (!has_next) break;
#pragma unroll
        for (int a = 0; a < 2; ++a)
#pragma unroll
            for (int b = 0; b < 2; ++b)
#pragma unroll
                for (int m = 0; m < 4; ++m)
#pragma unroll
                    for (int n = 0; n < 2; ++n) acc[a][b][m][n] = (f32x4){0.f, 0.f, 0.f, 0.f};
        cur = nxt; cA = nA; cB = nB; ++ui;
        if constexpr (ALIGN_EPI) { if (wr == 1) PG8_BAR; }
    }
    PG8_WAIT_V(0);
    if constexpr (!ALIGN_EPI) { if (wr == 0) PG8_BAR; }
    PG8_BAR;
    if constexpr (Epi::AFTER_DRAIN) { E.fused(acc, cur, wr, wc, fr, fq, lds, wid, lane); S.done(cur); }
#undef PG8_SA
#undef PG8_SB
#undef PG8_STAGE
#undef PG8_LDA
#undef PG8_LDB
#undef PG8_MMA
#undef PG8_WAIT_V
#undef PG8_WAIT_L
#undef PG8_BAR
#undef PG8_SCHED
}
}
namespace pg8 {
#define PG8_GAS __attribute__((address_space(1)))
constexpr float RMS_EPS = 1e-6f;
typedef unsigned long long stat_t;
typedef unsigned long long u64x2 __attribute__((ext_vector_type(2)));
constexpr float STAT_SCALE = 1048576.0f;
__device__ __forceinline__ stat_t stat_fix(float ss) { return (stat_t)(ss * STAT_SCALE + 0.5f); }
__device__ __forceinline__ float msq_from(stat_t q) { const float lo = (float)(unsigned)q * (1.0f / (2048.0f * STAT_SCALE)) + RMS_EPS; return (float)(unsigned)(q >> 32) * (4294967296.0f / (2048.0f * STAT_SCALE)) + lo; }
__device__ __forceinline__ float rinv_from(stat_t q) { return __builtin_amdgcn_rsqf(msq_from(q)); }
__device__ __forceinline__ float rinv_of(const stat_t* st, int row) { return rinv_from(st[row]); }
__device__ __forceinline__ float fast_sigmoid(float v) { return __builtin_amdgcn_rcpf(1.0f + __expf(-v)); }
__device__ __forceinline__ float gelu_tanh(float v) { const float y = 1.5957691216f * (v + 0.044715f * v * v * v); return v * fast_sigmoid(y); }
__device__ __forceinline__ u32x4 pack8(const f32x4 a, const f32x4 b) { u32x4 w; w.x = cvt_pk_bf16(a[0], a[1]); w.y = cvt_pk_bf16(a[2], a[3]); w.z = cvt_pk_bf16(b[0], b[1]); w.w = cvt_pk_bf16(b[2], b[3]); return w; }
__device__ __forceinline__ void unpack8(const u32x4 w, f32x4& a, f32x4& b) {
    a[0] = __uint_as_float(w.x << 16); a[1] = __uint_as_float(w.x & 0xffff0000u); a[2] = __uint_as_float(w.y << 16); a[3] = __uint_as_float(w.y & 0xffff0000u);
    b[0] = __uint_as_float(w.z << 16); b[1] = __uint_as_float(w.z & 0xffff0000u); b[2] = __uint_as_float(w.w << 16); b[3] = __uint_as_float(w.w & 0xffff0000u); }
__device__ __forceinline__ float sumsq8(const f32x4 a, const f32x4 b) { return (a[0] * a[0] + a[1] * a[1]) + (a[2] * a[2] + a[3] * a[3]) + (b[0] * b[0] + b[1] * b[1]) + (b[2] * b[2] + b[3] * b[3]); }

struct EpiSwiGLU {
    static constexpr bool PERM = true, AFTER_DRAIN = false;
    bf16_t* H; int ldh; const stat_t* st;
    __device__ __forceinline__ void operator()(const f32x4 (&acc)[2][2][4][2], const Unit& u, int wr, int wc, int fr, int fq) const {
        const int rowu = u.pm * BM + wr * 64; const unsigned lo = (unsigned)(fr * ldh + 8 * fq);
        stat_t q[8];
#pragma unroll
        for (int g = 0; g < 8; ++g) q[g] = ((const PG8_GAS stat_t*)(st + rowu + (g >> 2) * HALF + (g & 3) * 16))[fr];
        asm volatile("" ::: "memory");
#pragma unroll
        for (int ai = 0; ai < 2; ++ai)
#pragma unroll
            for (int m = 0; m < 4; ++m) { const int ru = rowu + ai * HALF + m * 16;
                const float v = msq_from(q[ai * 4 + m]), sn = __builtin_amdgcn_rsqf(v) * -1.4426950408889634f;
                f32x4 h[2];
#pragma unroll
                for (int n = 0; n < 2; ++n) { const f32x4 g = acc[ai][0][m][n], up = acc[ai][1][m][n];
#pragma unroll
                    for (int p = 0; p < 2; ++p) { const f32x2 g2 = (f32x2){g[2 * p], g[2 * p + 1]}, u2 = (f32x2){up[2 * p], up[2 * p + 1]}; const f32x2 a2 = g2 * sn;
                        f32x2 e2; e2.x = __builtin_amdgcn_exp2f(a2.x); e2.y = __builtin_amdgcn_exp2f(a2.y);
                        const f32x2 d2 = e2 * v + v; f32x2 r2; r2.x = __builtin_amdgcn_rcpf(d2.x); r2.y = __builtin_amdgcn_rcpf(d2.y);
                        const f32x2 h2 = (g2 * u2) * r2; h[n][2 * p] = h2.x; h[n][2 * p + 1] = h2.y; } }
                bf16_t* hp = H + (size_t)ru * ldh + u.pn * HALF + wc * 32;
                *(PG8_GAS u32x4*)(hp + lo) = pack8(h[0], h[1]); }
    }
};
template <int MODE> struct EpiRmw {
    static constexpr bool PERM = true, AFTER_DRAIN = false;
    const bf16_t* XB; bf16_t* XN; const stat_t* st; stat_t* stn; float alpha;
    __device__ __forceinline__ void operator()(const f32x4 (&acc)[2][2][4][2], const Unit& u, int wr, int wc, int fr, int fq) const {
        const int rowu = u.pm * BM + wr * 64, colu = u.pn * BM + wc * 32; const unsigned lo = (unsigned)(fr * 2048 + 8 * fq);
        const bf16_t* const xbase = XB + (size_t)rowu * 2048 + colu; bf16_t* const nbase = XN + (size_t)rowu * 2048 + colu;
        u32x4 xv[2][2][2], pv[2][2][2];
        stat_t rq[2][2];
        float ss[8];
#define RMW_LOAD(k, b) do { _Pragma("unroll") for (int q = 0; q < 2; ++q) { const int g = 2 * (k) + q, ro = ((g >> 2) * HALF + (g & 3) * 16) * 2048; \
            if (MODE == 1) rq[b][q] = ((const PG8_GAS stat_t*)(st + rowu + (g >> 2) * HALF + (g & 3) * 16))[fr]; \
            _Pragma("unroll") for (int bj = 0; bj < 2; ++bj) { xv[b][q][bj] = *(const PG8_GAS u32x4*)(xbase + ro + lo + bj * HALF); \
                if (MODE == 1) pv[b][q][bj] = *(const PG8_GAS u32x4*)(nbase + ro + lo + bj * HALF); } } } while (0)
        RMW_LOAD(0, 0);
        asm volatile("" ::: "memory");
#pragma unroll
        for (int k = 0; k < 4; ++k) { const int b = k & 1; u32x4 ov[2][2];
#pragma unroll
            for (int q = 0; q < 2; ++q) { const int g = 2 * k + q, ai = g >> 2, m = g & 3; float s2 = 0.f; const float rsg = (MODE == 1) ? rinv_from(rq[b][q]) : 0.f;
#pragma unroll
                for (int bj = 0; bj < 2; ++bj) { f32x4 x0, x1; unpack8(xv[b][q][bj], x0, x1);
                    if (MODE == 0) { x0 += acc[ai][bj][m][0] * alpha; x1 += acc[ai][bj][m][1] * alpha; }
                    else { f32x4 p0, p1; unpack8(pv[b][q][bj], p0, p1);
#pragma unroll
                        for (int j = 0; j < 4; ++j) { x0[j] += alpha * fast_sigmoid(acc[ai][bj][m][0][j] * rsg) * p0[j]; x1[j] += alpha * fast_sigmoid(acc[ai][bj][m][1][j] * rsg) * p1[j]; } }
                    s2 += sumsq8(x0, x1); ov[q][bj] = pack8(x0, x1); }
                s2 += __shfl_xor(s2, 16); s2 += __shfl_xor(s2, 32); ss[g] = s2; }
            if (k < 3) { RMW_LOAD(k + 1, b ^ 1); }
            asm volatile("" ::: "memory");
#pragma unroll
            for (int q = 0; q < 2; ++q) { const int g = 2 * k + q, ro = ((g >> 2) * HALF + (g & 3) * 16) * 2048;
#pragma unroll
                for (int bj = 0; bj < 2; ++bj) if (MODE == 0 || alpha != 0.f) *(PG8_GAS u32x4*)(nbase + ro + lo + bj * HALF) = ov[q][bj]; }
            asm volatile("" ::: "memory");
        }
#undef RMW_LOAD
        if (fq == 0) {
#pragma unroll
            for (int g = 0; g < 8; ++g) __hip_atomic_fetch_add((PG8_GAS stat_t*)(stn + rowu + (g >> 2) * HALF + (g & 3) * 16 + fr), stat_fix(ss[g]), __ATOMIC_RELAXED, __HIP_MEMORY_SCOPE_AGENT);
        }
    }
};
template <int MODE> struct EpiRowBf16 {
    static constexpr bool PERM = true, AFTER_DRAIN = false;
    bf16_t* O; int ldc; const stat_t* st;
    __device__ __forceinline__ void operator()(const f32x4 (&acc)[2][2][4][2], const Unit& u, int wr, int wc, int fr, int fq) const {
        const int rowu = u.pm * BM + wr * 64, colu = u.pn * BM + wc * 32; const unsigned lo = (unsigned)(fr * ldc + 8 * fq);
        stat_t q[8];
        if (MODE == 1) {
#pragma unroll
            for (int g = 0; g < 8; ++g) q[g] = ((const PG8_GAS stat_t*)(st + rowu + (g >> 2) * HALF + (g & 3) * 16))[fr];
            asm volatile("" ::: "memory"); }
#pragma unroll
        for (int ai = 0; ai < 2; ++ai)
#pragma unroll
            for (int m = 0; m < 4; ++m) { const int ru = rowu + ai * HALF + m * 16; float s = 1.0f; if (MODE == 1) s = rinv_from(q[ai * 4 + m]);
                bf16_t* op = O + (size_t)ru * ldc + colu;
#pragma unroll
                for (int bj = 0; bj < 2; ++bj) { f32x4 v0 = acc[ai][bj][m][0] * s, v1 = acc[ai][bj][m][1] * s;
                    if (MODE == 1) {
#pragma unroll
                        for (int j = 0; j < 4; ++j) { v0[j] = gelu_tanh(v0[j]); v1[j] = gelu_tanh(v1[j]); } }
                    *(PG8_GAS u32x4*)(op + lo + bj * HALF) = pack8(v0, v1); } }
    }
};
struct EpiOddIn {
    static constexpr bool PERM = true, AFTER_DRAIN = false;
    bf16_t* Z; bf16_t* GB; const stat_t* st;
    __device__ __forceinline__ void operator()(const f32x4 (&acc)[2][2][4][2], const Unit& u, int wr, int wc, int fr, int fq) const {
        const int rowu = u.pm * BM + wr * 64; const unsigned lo = (unsigned)(fr * 2048 + 8 * fq);
        stat_t q[8];
#pragma unroll
        for (int g = 0; g < 8; ++g) q[g] = ((const PG8_GAS stat_t*)(st + rowu + (g >> 2) * HALF + (g & 3) * 16))[fr];
        asm volatile("" ::: "memory");
        if (u.pn < 16) { const int colu = u.pn * HALF + wc * 32;
#pragma unroll
            for (int ai = 0; ai < 2; ++ai)
#pragma unroll
                for (int m = 0; m < 4; ++m) { const int ru = rowu + ai * HALF + m * 16; const float s = rinv_from(q[ai * 4 + m]), s2 = s * s;
                    const f32x4 z0 = acc[ai][0][m][0] * acc[ai][1][m][0] * s2, z1 = acc[ai][0][m][1] * acc[ai][1][m][1] * s2;
                    bf16_t* zp = Z + (size_t)ru * 2048 + colu;
                    *(PG8_GAS u32x4*)(zp + lo) = pack8(z0, z1); }
        } else { const int colu = (u.pn - 16) * BM + wc * 32;
#pragma unroll
            for (int ai = 0; ai < 2; ++ai)
#pragma unroll
                for (int m = 0; m < 4; ++m) { const int ru = rowu + ai * HALF + m * 16; const float s = rinv_from(q[ai * 4 + m]);
                    bf16_t* gp = GB + (size_t)ru * 2048 + colu;
#pragma unroll
                    for (int bj = 0; bj < 2; ++bj) *(PG8_GAS u32x4*)(gp + lo + bj * HALF) = pack8(acc[ai][bj][m][0] * s, acc[ai][bj][m][1] * s); }
        }
    }
};
struct EpiMT {
    static constexpr bool PERM = true, AFTER_DRAIN = false;
    bf16_t* ZTP; bf16_t* ZTS; bf16_t* VT; const stat_t* st; const float* gv;
    __device__ __forceinline__ void operator()(const f32x4 (&acc)[2][2][4][2], const Unit& u, int wr, int wc, int fr, int fq) const {
        const int tu = u.pn * BM + wc * 32;
        f32x4 sc[2][2];
#pragma unroll
        for (int bj = 0; bj < 2; ++bj)
#pragma unroll
            for (int n = 0; n < 2; ++n) { const stat_t* sp = (st + tu + bj * HALF + 4 * n) + 8 * fq; const u64x2 a = *(const PG8_GAS u64x2*)sp, b = *(const PG8_GAS u64x2*)(sp + 2);
                sc[bj][n][0] = rinv_from(a[0]); sc[bj][n][1] = rinv_from(a[1]); sc[bj][n][2] = rinv_from(b[0]); sc[bj][n][3] = rinv_from(b[1]); }
        const int chu = u.pm * BM + wr * 64;
        if (u.pm < 4) {
            bf16_t* base; int S2;
            if (u.pn < 128) { const int tt = u.pn * BM; base = ZTP + (size_t)(tt >> 11) * (1024 * 2048) + (tt & 2047) + wc * 32; S2 = 2048; }
            else { base = ZTS + (u.pn - 128) * BM + wc * 32; S2 = 8192; }
            const unsigned lo = (unsigned)(fr * S2 + 8 * fq);
#pragma unroll
            for (int ai = 0; ai < 2; ++ai)
#pragma unroll
                for (int m = 0; m < 4; ++m) { bf16_t* rp = base + (size_t)(chu + ai * HALF + m * 16) * S2;
#pragma unroll
                    for (int bj = 0; bj < 2; ++bj) *(PG8_GAS u32x4*)(rp + lo + bj * HALF) = pack8(acc[ai][bj][m][0] * sc[bj][0], acc[ai][bj][m][1] * sc[bj][1]); }
        } else {
            const unsigned lo = (unsigned)(fr * 40960 + 8 * fq);
#pragma unroll
            for (int ai = 0; ai < 2; ++ai) {
                f32x4 q[2][2];
#pragma unroll
                for (int bj = 0; bj < 2; ++bj)
#pragma unroll
                    for (int n = 0; n < 2; ++n) { q[bj][n] = (f32x4){0.f, 0.f, 0.f, 0.f};
#pragma unroll
                        for (int m = 0; m < 4; ++m) { const f32x4 v = acc[ai][bj][m][n] * sc[bj][n];
#pragma unroll
                            for (int j = 0; j < 4; ++j) { const float y = gelu_tanh(v[j]); q[bj][n][j] += y * y; } } }
#pragma unroll
                for (int bj = 0; bj < 2; ++bj)
#pragma unroll
                    for (int n = 0; n < 2; ++n)
#pragma unroll
                        for (int j = 0; j < 4; ++j) { float s = q[bj][n][j]; s += __shfl_xor(s, 1); s += __shfl_xor(s, 2); s += __shfl_xor(s, 4); s += __shfl_xor(s, 8);
                            q[bj][n][j] = __builtin_amdgcn_rsqf(s * (1.0f / 64.0f) + RMS_EPS); }
#pragma unroll
                for (int m = 0; m < 4; ++m) { const int cu = chu - 1024 + ai * HALF + m * 16; const float gg = ((const PG8_GAS float*)(gv + cu))[fr]; bf16_t* vp = VT + (size_t)cu * 40960 + tu;
#pragma unroll
                    for (int bj = 0; bj < 2; ++bj) { f32x4 y0 = acc[ai][bj][m][0] * sc[bj][0], y1 = acc[ai][bj][m][1] * sc[bj][1];
#pragma unroll
                        for (int j = 0; j < 4; ++j) { y0[j] = gelu_tanh(y0[j]); y1[j] = gelu_tanh(y1[j]); }
                        *(PG8_GAS u32x4*)(vp + lo + bj * HALF) = pack8(y0 * q[bj][0] * gg, y1 * q[bj][1] * gg); } }
            }
        }
    }
};
struct EpiDFT {
    static constexpr bool PERM = true, AFTER_DRAIN = false;
    bf16_t* Y; int row_base, S; float scale, msign; int col_lo, col_hi;
    __device__ __forceinline__ void operator()(const f32x4 (&acc)[2][2][4][2], const Unit& u, int wr, int wc, int fr, int fq) const {
        const int ku = u.pm * BM + wr * 64, rb = row_base + (u.pn >> 2) * S, colu = (u.pn & 3) * BM + wc * 32;
        const int lo = fr * 2048 + 8 * fq, lom = -fr * 2048 + 8 * fq; const float ms = scale * msign;
#pragma unroll
        for (int bj = 0; bj < 2; ++bj) { const int col = colu + bj * HALF + 8 * fq; if (col >= col_lo && col < col_hi) {
#pragma unroll
            for (int ai = 0; ai < 2; ++ai)
#pragma unroll
                for (int m = 0; m < 4; ++m) { const int k0 = ku + ai * HALF + m * 16;
                    bf16_t* yp = Y + (size_t)(rb + k0) * 2048 + colu + bj * HALF; bf16_t* ym = Y + (size_t)(rb + S - k0) * 2048 + colu + bj * HALF;
                    *(PG8_GAS u32x4*)(yp + lo) = pack8(acc[ai][bj][m][0] * scale, acc[ai][bj][m][1] * scale);
                    if (k0 + fr != 0) *(PG8_GAS u32x4*)(ym + lom) = pack8(acc[ai][bj][m][0] * ms, acc[ai][bj][m][1] * ms); } } }
    }
};
struct EpiNull {
    static constexpr bool PERM = true, AFTER_DRAIN = false;
    float* sink;
    __device__ __forceinline__ void operator()(const f32x4 (&acc)[2][2][4][2], const Unit& u, int wr, int wc, int fr, int fq) const {
        float s = 0.f;
#pragma unroll
        for (int ai = 0; ai < 2; ++ai)
#pragma unroll
            for (int bj = 0; bj < 2; ++bj)
#pragma unroll
                for (int m = 0; m < 4; ++m)
#pragma unroll
                    for (int n = 0; n < 2; ++n) s += acc[ai][bj][m][n][0] + acc[ai][bj][m][n][1] + acc[ai][bj][m][n][2] + acc[ai][bj][m][n][3];
        if (s == 1.2345e-30f) sink[u.pm + fr] = s;
    }
};
}
#ifndef MK_N_LAUNCHES
#define MK_N_LAUNCHES 1
#endif
constexpr int NPHASE = 34;
constexpr int T = 40960, TP = 32768, DM = 2048, DFF = 5632, NLAYER = 4;
typedef unsigned short bf16;
#define GAS __attribute__((address_space(1)))
#define LAS __attribute__((address_space(3)))
typedef unsigned v4u __attribute__((ext_vector_type(4)));
typedef unsigned v2u __attribute__((ext_vector_type(2)));
typedef float f32x4 __attribute__((ext_vector_type(4)));
typedef short bf16x8 __attribute__((ext_vector_type(8)));
typedef GAS unsigned gu32;

constexpr size_t MiB = 1u << 20;
constexpr size_t WS_CTL = 0, CTL_BYTES = 6 * MiB;
constexpr int CW_BAR = 4096;
constexpr size_t WS_STATS = 65536;
constexpr size_t WS_W = 6 * MiB;
constexpr size_t SZ_FIN = (size_t)2 * DFF * DM * 2, SZ_FOUT = (size_t)DM * DFF * 2, SZ_SQ = (size_t)DM * DM * 2, SZ_WP = (size_t)DM * 256 * 2;
constexpr size_t WL_F1IN = 0, WL_F1OUT = SZ_FIN, WL_F2IN = SZ_FIN + SZ_FOUT, WL_F2OUT = 2 * SZ_FIN + SZ_FOUT, WL_WG = 2 * SZ_FIN + 2 * SZ_FOUT, WL_WP = WL_WG + SZ_SQ, WL_SIZE = WL_WP + SZ_WP;
constexpr size_t WS_WE = WS_W + NLAYER * WL_SIZE;
constexpr size_t WE_WZ = 0, WE_WU = (size_t)3072 * DM * 2, WE_WO = WE_WU + (size_t)1024 * DM * 2, WE_WS = WE_WO + SZ_SQ, WE_SIZE = WE_WS + (size_t)16 * 128 * 128 * 2;
constexpr size_t WS_WOD = WS_WE + 2 * WE_SIZE;
constexpr size_t WO_WC = 0, WO_WOC = (size_t)6144 * DM * 2, WO_SIZE = WO_WOC + SZ_SQ;
constexpr size_t WS_DP = WS_WOD + 2 * WO_SIZE, SZ_DP = (size_t)2 * 1024 * 2048 * 2;
constexpr size_t WS_DS = WS_DP + SZ_DP, SZ_DS = (size_t)2 * 4096 * 8192 * 2;
constexpr size_t WS_XB0 = WS_DS + SZ_DS, SZ_XB = (size_t)T * DM * 2;
constexpr size_t WS_XB1 = WS_XB0 + SZ_XB;
constexpr size_t WS_H = WS_XB1 + SZ_XB, SZ_H = (size_t)T * DFF * 2;
constexpr size_t WS_ZTP = WS_H, WS_ZTS = WS_ZTP + (size_t)16 * 1024 * 2048 * 2, WS_VT = WS_ZTS + (size_t)1024 * 8192 * 2, WS_U = WS_VT + (size_t)1024 * T * 2;
constexpr size_t WS_Z = WS_H, WS_GB = WS_H + SZ_XB;
constexpr size_t WS_PB = WS_H + SZ_H, SZ_PB = (size_t)NLAYER * T * 256 * 2;
constexpr size_t WS_END = WS_PB + SZ_PB;
static_assert(WS_U + (size_t)T * 1024 * 2 <= WS_H + SZ_H && WS_GB + SZ_XB <= WS_H + SZ_H, "mixer buffers overlay the FFN hidden buffer");
static_assert(WS_STATS + (size_t)18 * T * 8 <= CTL_BYTES && (CW_BAR + 3456) * 4 <= (int)WS_STATS, "control region");
static_assert(WS_END < 1800000000ull, "d_ws map");

constexpr int LDS_BYTES = 147456;
constexpr int LDSCTL_OFF = 131072;

#define LDS_WAIT() asm volatile("s_waitcnt lgkmcnt(0)" ::: "memory")
__device__ __forceinline__ unsigned f2bf(float f) { unsigned u = __builtin_bit_cast(unsigned, f); return (u + 0x7fffu + ((u >> 16) & 1u)) >> 16; }
__device__ __forceinline__ unsigned pk2(float lo, float hi) { return f2bf(lo) | (f2bf(hi) << 16); }
__device__ __forceinline__ float bflo(unsigned w) { return __uint_as_float(w << 16); }
__device__ __forceinline__ float bfhi(unsigned w) { return __uint_as_float(w & 0xffff0000u); }
__device__ __forceinline__ float wave_sum(float v) {
#pragma unroll
    for (int o = 1; o < 64; o <<= 1) v += __shfl_xor(v, o);
    return v;
}
#define XB_TMO      128
#define XB_XCNT(j)  (256  + 64 * (j))
#define XB_XSUB(j)  (1280 + 64 * (j))
#define XB_XGEN(j)  (2304 + 64 * (j))
#define XB_TOP      3328
#define XB_TOPGEN   3392
#define XCD_BAR_WORDS 3456
#define XB_SPIN_CAP (1u << 18)

__device__ __forceinline__ unsigned xb_ld(unsigned* p)              { return __hip_atomic_load(p, __ATOMIC_RELAXED, __HIP_MEMORY_SCOPE_AGENT); }
__device__ __forceinline__ unsigned xb_add(unsigned* p, unsigned v) { return __hip_atomic_fetch_add(p, v, __ATOMIC_RELAXED, __HIP_MEMORY_SCOPE_AGENT); }
__device__ __forceinline__ unsigned xb_xcc_id() { return (unsigned)__builtin_amdgcn_s_getreg((3 << 11) | 20) & 0xFu; }
#define XB_SPIN(cond, bar) do { unsigned _sp = 0; while (cond) { __builtin_amdgcn_s_sleep(1); \
    if ((++_sp & 255u) == 0u) { if (xb_ld(&(bar)[XB_TMO])) break; if (_sp > XB_SPIN_CAP) { atomicAdd(&(bar)[XB_TMO], 1u); break; } } } } while (0)

struct XcdBarrier {
    unsigned* bar; unsigned x;
    volatile LAS unsigned* st;
};

__device__ __forceinline__ XcdBarrier xcd_barrier_post(unsigned* bar, volatile LAS unsigned* st) {
    XcdBarrier b; b.bar = bar; b.x = xb_xcc_id(); b.st = st;
    if (threadIdx.x == 0) (void)xb_add(&bar[XB_XCNT(b.x)], 1u);
    return b;
}
__device__ __forceinline__ void xcd_barrier_complete(unsigned* bar, unsigned x, unsigned& nloc, unsigned& nx) {
    const unsigned G = gridDim.x * gridDim.y * gridDim.z;
    unsigned sum, cnt, mine, sp = 0u;
    for (;;) {
        sum = 0u; cnt = 0u; mine = 0u;
#pragma unroll
        for (unsigned j = 0; j < 16; ++j) { const unsigned c = xb_ld(&bar[XB_XCNT(j)]); sum += c; cnt += (c > 0u) ? 1u : 0u; mine = (j == x) ? c : mine; }
        if (sum == G) break;
        __builtin_amdgcn_s_sleep(1);
        if ((++sp & 255u) == 0u) { if (xb_ld(&bar[XB_TMO])) break; if (sp > XB_SPIN_CAP) { atomicAdd(&bar[XB_TMO], 1u); break; } }
    }
    nloc = mine > 0u ? mine : 1u; nx = cnt > 0u ? cnt : 1u;
}

__device__ __forceinline__ void xcd_barrier(const XcdBarrier& b) {
    asm volatile("s_waitcnt vmcnt(0)" ::: "memory");
    __syncthreads();
    if (threadIdx.x == 0) {
        unsigned* bar = b.bar;
        __builtin_amdgcn_s_waitcnt(0);
        unsigned nloc = b.st[0], nx = b.st[1];
        if (nloc == 0u) { xcd_barrier_complete(bar, b.x, nloc, nx); b.st[0] = nloc; b.st[1] = nx; }
        const unsigned old = xb_add(&bar[XB_XSUB(b.x)], 1u);
        const unsigned gen = old / nloc;
        if (old + 1u == (gen + 1u) * nloc) {
            __builtin_amdgcn_fence(__ATOMIC_RELEASE, "agent");
            asm volatile("s_waitcnt vmcnt(0)" ::: "memory");
            const unsigned og = xb_add(&bar[XB_TOP], 1u);
            const unsigned tg = og / nx;
            if (og + 1u == (tg + 1u) * nx) xb_add(&bar[XB_TOPGEN], 1u);
            else XB_SPIN(xb_ld(&bar[XB_TOPGEN]) == tg, bar);
            __builtin_amdgcn_fence(__ATOMIC_ACQUIRE, "agent");
            xb_add(&bar[XB_XGEN(b.x)], 1u);
            asm volatile("s_waitcnt vmcnt(0)" ::: "memory");
        } else {
            XB_SPIN(xb_ld(&bar[XB_XGEN(b.x)]) == gen, bar);
            __builtin_amdgcn_fence(__ATOMIC_ACQUIRE, "agent");
            asm volatile("s_waitcnt vmcnt(0)" ::: "memory");
        }
    }
    __syncthreads();
}
#ifndef MK_CVNT
#define MK_CVNT 3
#endif
template<class V> __device__ __forceinline__ V cv_ld(const GAS V* p) { if (MK_CVNT & 1) return __builtin_nontemporal_load(p); else return *p; }
template<class V> __device__ __forceinline__ void cv_st(GAS V* p, V v) { if (MK_CVNT & 2) __builtin_nontemporal_store(v, p); else *p = v; }
__device__ __forceinline__ void tr_item(const float* W, int ldw, int K, const float* g, bf16* WT, int dst_row0, LAS float* scr, int k0, int n0, int lane) {
    {
        f32x4 v[8]; const int kr = lane >> 3, n4 = (lane & 7) * 4;
#pragma unroll
        for (int i = 0; i < 8; ++i) v[i] = cv_ld((const GAS f32x4*)(W + (size_t)(k0 + 8 * i + kr) * ldw + n0 + n4));
        if (g) {
#pragma unroll
            for (int i = 0; i < 8; ++i) v[i] = v[i] * g[k0 + 8 * i + kr]; }
#pragma unroll
        for (int i = 0; i < 8; ++i) { LAS float* d = scr + (8 * i + kr) * 33 + n4; d[0] = v[i][0]; d[1] = v[i][1]; d[2] = v[i][2]; d[3] = v[i][3]; }
    }
    LDS_WAIT(); asm volatile("" ::: "memory");
    const int c = lane & 7;
#pragma unroll
    for (int j = 0; j < 4; ++j) { const int n = (lane >> 3) + 8 * j; const LAS float* s = scr + (8 * c) * 33 + n;
        v4u o; o.x = pk2(s[0 * 33], s[1 * 33]); o.y = pk2(s[2 * 33], s[3 * 33]); o.z = pk2(s[4 * 33], s[5 * 33]); o.w = pk2(s[6 * 33], s[7 * 33]);
        cv_st((GAS v4u*)(WT + (size_t)(dst_row0 + n) * K + k0 + 8 * c), o); }
    LDS_WAIT(); asm volatile("" ::: "memory");
}
__device__ __forceinline__ void hc_rows(int kd, int& r1, int& r2, float& c2) {
    if (kd < 528) { const int h = kd / 33, cp = kd - 33 * h; r1 = 64 * h + cp; if (cp == 0 || cp == 32) { r2 = r1; c2 = 0.f; } else { r2 = 64 * h + 64 - cp; c2 = 1.f; } }
    else { const int q = kd - 528, h = q / 31, cp = 1 + q - 31 * h; r1 = 64 * h + 64 - cp; r2 = 64 * h + cp; c2 = -1.f; }
}
__device__ __forceinline__ void tr_item_wofold(const float* W, bf16* WT, LAS float* scr, int k0, int n0, int lane) {
    {   f32x4 v[8], w[8]; float cc[8]; const int kr = lane >> 3, n4 = (lane & 7) * 4;
#pragma unroll
        for (int i = 0; i < 8; ++i) { int r1, r2; hc_rows(k0 + 8 * i + kr, r1, r2, cc[i]); v[i] = *(const GAS f32x4*)(W + (size_t)r1 * DM + n0 + n4); w[i] = *(const GAS f32x4*)(W + (size_t)r2 * DM + n0 + n4); }
#pragma unroll
        for (int i = 0; i < 8; ++i) { const f32x4 t = v[i] + w[i] * cc[i]; LAS float* d = scr + (8 * i + kr) * 33 + n4; d[0] = t[0]; d[1] = t[1]; d[2] = t[2]; d[3] = t[3]; }
    }
    LDS_WAIT(); asm volatile("" ::: "memory");
    const int c = lane & 7;
#pragma unroll
    for (int j = 0; j < 4; ++j) { const int n = (lane >> 3) + 8 * j; const LAS float* s = scr + (8 * c) * 33 + n;
        v4u o; o.x = pk2(s[0 * 33], s[1 * 33]); o.y = pk2(s[2 * 33], s[3 * 33]); o.z = pk2(s[4 * 33], s[5 * 33]); o.w = pk2(s[6 * 33], s[7 * 33]);
        *(GAS v4u*)(WT + (size_t)(n0 + n) * DM + k0 + 8 * c) = o; }
    LDS_WAIT(); asm volatile("" ::: "memory");
}
__device__ __forceinline__ int map_id(int n) { return n; }
__device__ __forceinline__ int map_glu(int n) { return n < DFF ? 256 * (n >> 7) + (n & 127) : 256 * ((n - DFF) >> 7) + 128 + ((n - DFF) & 127); }
__device__ __forceinline__ int map_oddin(int n) { return n < 2048 ? 4096 + n : (n < 4096 ? 256 * ((n - 2048) >> 7) + ((n - 2048) & 127) : 256 * ((n - 4096) >> 7) + 128 + ((n - 4096) & 127)); }

struct Args { const float* in[24]; float* out; unsigned char* ws; int ph_lo, ph_hi; };

constexpr int CW_POOL = 8192;
constexpr int I_FIN = (DM / 64) * (2 * DFF / 32), I_FOUT = (DFF / 64) * (DM / 32), I_SQ = (DM / 64) * (DM / 32), I_WP = (256 / 64) * (DM / 32);
constexpr int I_EIN = (DM / 64) * (2048 / 32), I_FOLD = 64 * 16, I_OIN = (DM / 64) * (6144 / 32);
constexpr int I_X = T / 4, I_P = T * 256 / 8 / 512, I_WS = 16 * 128 * 128 / 8 / 512, I_DGS = 2 * 4096 * 1024 / 512, I_DGP = 2 * 1024 * 256 / 512, I_DG = I_DGS + I_DGP;
constexpr int POOL_NA = I_X + I_FIN;
__host__ __device__ constexpr int pool_seg(int L, int s) {
    return s == 0 ? I_FOUT : s == 1 ? ((L & 1) ? I_OIN : I_EIN + I_FOLD) : s == 2 ? ((L & 1) ? 0 : (L == 0 ? I_DG + I_WS : I_WS)) : s == 3 ? I_SQ : s == 4 ? I_FIN : s == 5 ? I_FOUT + I_WP + I_P : s == 6 ? I_SQ : (L < NLAYER - 1 ? I_FIN : 0);
}
__host__ __device__ constexpr int pool_blk(int L) { return pool_seg(L, 0) + pool_seg(L, 1) + pool_seg(L, 2) + pool_seg(L, 3) + pool_seg(L, 4) + pool_seg(L, 5) + pool_seg(L, 6) + pool_seg(L, 7); }
constexpr unsigned POOL_NTOTAL = POOL_NA + pool_blk(0) + pool_blk(1) + pool_blk(2) + pool_blk(3);
__device__ __forceinline__ unsigned pool_target(int L, int k) {
    unsigned n = POOL_NA;
#pragma unroll
    for (int l = 0; l < NLAYER; ++l) if (l < L) n += pool_blk(l);
#pragma unroll
    for (int s = 0; s < 8; ++s) if (s <= k) n += pool_seg(L, s);
    return n;
}

__device__ __forceinline__ void cv_x_item(const float* xp, const float* xs, unsigned char* ws, int r, int lane) {
    pg8::stat_t* st0 = (pg8::stat_t*)(ws + WS_STATS); bf16* xb0 = (bf16*)(ws + WS_XB0);
#pragma unroll 1
    for (int i = 0; i < 4; ++i) { const int row = 4 * r + i; const float* src = row < TP ? xp + (size_t)row * DM : xs + (size_t)(row - TP) * DM;
        const GAS f32x4* xr = (const GAS f32x4*)src + lane; f32x4 v[8]; float s = 0.f;
#pragma unroll
        for (int j = 0; j < 8; ++j) { v[j] = cv_ld(xr + 64 * j); s += (v[j][0] * v[j][0] + v[j][1] * v[j][1]) + (v[j][2] * v[j][2] + v[j][3] * v[j][3]); }
        s = wave_sum(s); if (lane == 0) *(GAS pg8::stat_t*)(st0 + row) = pg8::stat_fix(s);
        GAS v2u* brow = (GAS v2u*)(xb0 + (size_t)row * DM) + lane;
#pragma unroll
        for (int j = 0; j < 8; ++j) { v2u w; w.x = pk2(v[j][0], v[j][1]); w.y = pk2(v[j][2], v[j][3]); brow[64 * j] = w; } }
}
__device__ __forceinline__ void cv_p_item(const float* pp, const float* ps, unsigned char* ws, int L, int r, int lane) {
    bf16* pb = (bf16*)(ws + WS_PB) + (size_t)L * T * 256; f32x4 v0[8], v1[8];
#pragma unroll
    for (int i = 0; i < 8; ++i) { const int e = r * 512 + i * 64 + lane, row = e >> 5, c8 = e & 31;
        const float* src = row < TP ? pp + ((size_t)L * TP + row) * 256 + c8 * 8 : ps + ((size_t)L * 8192 + (row - TP)) * 256 + c8 * 8;
        v0[i] = cv_ld((const GAS f32x4*)src); v1[i] = cv_ld((const GAS f32x4*)(src + 4)); }
#pragma unroll
    for (int i = 0; i < 8; ++i) { const int e = r * 512 + i * 64 + lane;
        v4u o; o.x = pk2(v0[i][0], v0[i][1]); o.y = pk2(v0[i][2], v0[i][3]); o.z = pk2(v1[i][0], v1[i][1]); o.w = pk2(v1[i][2], v1[i][3]);
        cv_st((GAS v4u*)(pb + (size_t)e * 8), o); }
}
__device__ __forceinline__ void cv_ws_item(const float* wsrc, unsigned char* ws, int j, int r, int lane) {
    const float* src = wsrc + (size_t)j * 16 * 128 * 128; bf16* dst = (bf16*)(ws + WS_WE + (size_t)j * WE_SIZE + WE_WS); f32x4 v0[8], v1[8];
#pragma unroll
    for (int i = 0; i < 8; ++i) { const int e = r * 512 + i * 64 + lane; v0[i] = *(const GAS f32x4*)(src + (size_t)e * 8); v1[i] = *(const GAS f32x4*)(src + (size_t)e * 8 + 4); }
#pragma unroll
    for (int i = 0; i < 8; ++i) { const int e = r * 512 + i * 64 + lane;
        v4u o; o.x = pk2(v0[i][0], v0[i][1]); o.y = pk2(v0[i][2], v0[i][3]); o.z = pk2(v1[i][0], v1[i][1]); o.w = pk2(v1[i][2], v1[i][3]);
        *(GAS v4u*)(dst + (size_t)e * 8) = o; }
}
__device__ __forceinline__ void cv_dft_item(unsigned char* ws, int r, int lane) {
    const bool smp = r < I_DGS; const int S = smp ? 8192 : 2048, lg = smp ? 13 : 11; bf16* Dm = (bf16*)(ws + (smp ? WS_DS : WS_DP)); const float sc2 = 2.0f / (float)S;
    const int rr = smp ? r : r - I_DGS, per_mat = (S / 2) * (S / 8); const bool sn = rr * 512 >= per_mat;
#pragma unroll 1
    for (int i = 0; i < 8; ++i) { const int e = rr * 512 + i * 64 + lane, e2 = sn ? e - per_mat : e; const int k = e2 >> (lg - 3), s0 = (e2 & (S / 8 - 1)) * 8; float v[8];
        if (!sn) {
#pragma unroll
            for (int q = 0; q < 8; ++q) v[q] = cospif((float)((k * (s0 + q)) & (S - 1)) * sc2);
        } else {
#pragma unroll
            for (int q = 0; q < 8; ++q) v[q] = sinpif((float)((k * (s0 + q)) & (S - 1)) * sc2);
        }
        v4u o; o.x = pk2(v[0], v[1]); o.y = pk2(v[2], v[3]); o.z = pk2(v[4], v[5]); o.w = pk2(v[6], v[7]);
        cv_st((GAS v4u*)(Dm + (size_t)e * 8), o); }
}
__device__ __forceinline__ void cv_fold_item(const float* win, const float* gmix, unsigned char* ws, int j, int r, LAS float* scr, int lane) {
    LAS float* tab = scr + 2200;
    tab[lane] = cospif((float)lane * (1.0f / 32.0f));
    LDS_WAIT(); asm volatile("" ::: "memory");
    const bool isq = lane >= 33; const int cp = isq ? lane - 32 : lane, toff = isq ? 48 : 0;
    const int kb = (r >> 4) & 63, h = r & 15, k0 = kb * 32;
    const float* W = win + (size_t)j * DM * 3072 + h * 64; const float* gm = gmix + (2 * j) * DM; bf16* WZ = (bf16*)(ws + WS_WE + (size_t)j * WE_SIZE + WE_WZ);
    const int zr = isq ? 528 + h * 31 + (lane - 33) : h * 33 + lane;
    for (int kq = 0; kq < 4; ++kq) {
        float ac[8];
#pragma unroll
        for (int q = 0; q < 8; ++q) ac[q] = 0.f;
        for (int cc = 0; cc < 64; ++cc) { const float tv = tab[((cc * cp) + toff) & 63];
#pragma unroll
            for (int q = 0; q < 8; ++q) ac[q] += W[(size_t)(k0 + kq * 8 + q) * 3072 + cc] * tv; }
#pragma unroll
        for (int q = 0; q < 8; ++q) ac[q] *= gm[k0 + kq * 8 + q];
        v4u oc; oc.x = pk2(ac[0], ac[1]); oc.y = pk2(ac[2], ac[3]); oc.z = pk2(ac[4], ac[5]); oc.w = pk2(ac[6], ac[7]);
        *(GAS v4u*)(WZ + (size_t)zr * DM + k0 + kq * 8) = oc; }
    LDS_WAIT(); asm volatile("" ::: "memory");
}

typedef const __attribute__((address_space(4))) Args CArgs;
__device__ __forceinline__ void pool_item(CArgs* ap, LAS unsigned char* lds, int wave, int lane, unsigned it) {
    unsigned char* ws = ap->ws;
    LAS float* scr = (LAS float*)(lds + wave * 16384);
    int r = (int)it;
    if (r < I_X) { cv_x_item(ap->in[0], ap->in[1], ws, r, lane); return; }
    r -= I_X;
    int L = 0, s = 7, Lw = 0;
    if (r >= I_FIN) { r -= I_FIN; s = 0;
#pragma unroll
        for (int l = 0; l < NLAYER - 1; ++l) { const int bs = pool_blk(l); if (L == l && r >= bs) { r -= bs; L = l + 1; } }
#pragma unroll
        for (int q = 0; q < 7; ++q) { const int c = pool_seg(L, q); if (s == q && r >= c) { r -= c; s = q + 1; } }
        Lw = L + 1; }
    const int j = L >> 1; const bool odd = (L & 1) != 0;
    int wi = 0, gi = -1, goff = 0, ldw = DM, K = DM, nblk = 64, mapk = 0; size_t woff = 0, toff = 0;
    const size_t wlo = WS_W + (size_t)(s == 7 ? Lw : L) * WL_SIZE;
    if (s == 7) { wi = 5; woff = (size_t)Lw * DM * 2 * DFF; ldw = 2 * DFF; gi = 4; goff = Lw * DM; toff = wlo + WL_F1IN; nblk = 352; mapk = 1; }
    else if (s == 0) { wi = 6; woff = (size_t)L * DFF * DM; K = DFF; toff = wlo + WL_F1OUT; }
    else if (s == 1) {
        if (odd) { wi = 13; woff = (size_t)j * DM * 6144; ldw = 6144; gi = 7; goff = (2 * j + 1) * DM; toff = WS_WOD + (size_t)j * WO_SIZE + WO_WC; nblk = 192; mapk = 2; }
        else if (r < I_EIN) { wi = 8; woff = (size_t)j * DM * 3072 + 1024; ldw = 3072; gi = 7; goff = (2 * j) * DM;
            toff = WS_WE + (size_t)j * WE_SIZE + (((r & 63) * 32 < 1024) ? WE_WU : WE_WZ); }
        else { cv_fold_item(ap->in[8], ap->in[7], ws, j, r - I_EIN, scr, lane); return; } }
    else if (s == 2) { if (L == 0 && r < I_DG) { cv_dft_item(ws, r, lane); return; } cv_ws_item(ap->in[10], ws, j, L == 0 ? r - I_DG : r, lane); return; }
    else if (s == 3) {
        if (odd) { wi = 16; woff = (size_t)j * DM * DM; toff = WS_WOD + (size_t)j * WO_SIZE + WO_WOC; }
        else { wi = 12; woff = (size_t)j * DM * DM; toff = WS_WE + (size_t)j * WE_SIZE + WE_WO;
            if ((r >> 6) < 16) { tr_item_wofold(ap->in[12] + woff, (bf16*)(ws + toff), scr, (r >> 6) * 64, (r & 63) * 32, lane); return; } } }
    else if (s == 4) { wi = 18; woff = (size_t)L * DM * 2 * DFF; ldw = 2 * DFF; gi = 17; goff = L * DM; toff = wlo + WL_F2IN; nblk = 352; mapk = 1; }
    else if (s == 5) {
        if (r < I_FOUT) { wi = 19; woff = (size_t)L * DFF * DM; K = DFF; toff = wlo + WL_F2OUT; }
        else if (r < I_FOUT + I_WP) { r -= I_FOUT; wi = 22; woff = (size_t)L * 256 * DM; K = 256; toff = wlo + WL_WP; }
        else { cv_p_item(ap->in[2], ap->in[3], ws, L, r - I_FOUT - I_WP, lane); return; } }
    else { wi = 21; woff = (size_t)L * DM * DM; gi = 20; goff = L * DM; toff = wlo + WL_WG; }
    const int kb = nblk == 352 ? r / 352 : (nblk == 192 ? r / 192 : r >> 6), n0 = (r - kb * nblk) * 32;
    const int drow = mapk == 1 ? map_glu(n0) : (mapk == 2 ? map_oddin(n0) : n0);
    const float* W = ap->in[wi] + woff; const float* g = gi >= 0 ? ap->in[gi] + goff : (const float*)nullptr;
    tr_item(W, ldw, K, g, (bf16*)(ws + toff), drow, scr, kb * 64, n0, lane);
}

#ifndef MK_POOLWAIT
#define MK_POOLWAIT 1
#endif
#ifndef MK_POOLWAVES
#define MK_POOLWAVES 3
#endif
__device__ __forceinline__ void pool_seam(const XcdBarrier& b, LAS unsigned char* lds, volatile LAS unsigned* ctl, unsigned target, bool do_barrier) {
    int tid_o = threadIdx.x; asm volatile("" : "+v"(tid_o)); const int lane = tid_o & 63, wave = __builtin_amdgcn_readfirstlane(tid_o >> 6);
    CArgs* ap = (CArgs*)__builtin_amdgcn_kernarg_segment_ptr(); asm volatile("" : "+s"(ap));
    constexpr unsigned EXIT = 0xFFFFFFFFu;
    unsigned slot = 0u;
    asm volatile("s_waitcnt vmcnt(0)" ::: "memory");
    __syncthreads();
    for (;;) {
        if (tid_o == 0) {
            unsigned* pool = (unsigned*)(ap->ws + WS_CTL) + CW_POOL; unsigned* bar = b.bar;
            unsigned bb = EXIT, st = ctl[2]; ctl[1] = 8u;
            if (st == 0u) {
                unsigned seen = ctl[0];
                if (seen < target) { seen = (unsigned)POOL_NA + xb_ld(pool); if (seen < target) { bb = (unsigned)POOL_NA + xb_add(pool, 8u); seen = bb + 8u;
#ifdef MK_POOLPROBE
                    if (bb >= (unsigned)POOL_NA && bb < POOL_NTOTAL) xb_add(pool + 64, 8u);
#endif
                    } ctl[0] = seen; }
                if (bb == EXIT && do_barrier) {
                    __builtin_amdgcn_s_waitcnt(0);
                    unsigned nloc = b.st[0], nx = b.st[1];
                    if (nloc == 0u) { xcd_barrier_complete(bar, b.x, nloc, nx); b.st[0] = nloc; b.st[1] = nx; }
                    const unsigned old = xb_add(&bar[XB_XSUB(b.x)], 1u);
                    const unsigned gen = old / nloc;
                    if (old + 1u == (gen + 1u) * nloc) {
                        __builtin_amdgcn_fence(__ATOMIC_RELEASE, "agent");
                        asm volatile("s_waitcnt vmcnt(0)" ::: "memory");
                        const unsigned og = xb_add(&bar[XB_TOP], 1u);
                        const unsigned tg = og / nx;
                        if (og + 1u == (tg + 1u) * nx) xb_add(&bar[XB_TOPGEN], 1u);
                        else XB_SPIN(xb_ld(&bar[XB_TOPGEN]) == tg, bar);
                        __builtin_amdgcn_fence(__ATOMIC_ACQUIRE, "agent");
                        xb_add(&bar[XB_XGEN(b.x)], 1u);
                        asm volatile("s_waitcnt vmcnt(0)" ::: "memory");
                    } else { st = gen + 1u; ctl[2] = st; }
                }
            }
            if (st != 0u) {
#ifdef MK_FAKEWAIT
                if (xb_ld(&bar[XB_XGEN(b.x)]) == st - 1u) bb = 0xFFFFFFFEu; else bb = EXIT;
#else
                if (MK_POOLWAIT && ctl[0] < POOL_NTOTAL && xb_ld(&bar[XB_XGEN(b.x)]) == st - 1u) { bb = (unsigned)POOL_NA + xb_add(pool, (unsigned)MK_POOLWAVES); ctl[0] = bb + (unsigned)MK_POOLWAVES; ctl[1] = (unsigned)MK_POOLWAVES; }
                else bb = EXIT;
#endif
            }
            ctl[4 + slot] = bb;
        }
        __syncthreads();
        const unsigned bb = __builtin_amdgcn_readfirstlane(ctl[4 + slot]); slot ^= 1u;
        if (bb == EXIT) break;
#ifdef MK_FAKEWAIT
        if (bb == 0xFFFFFFFEu) { for (int q = 0; q < MK_FAKEWAIT; ++q) __builtin_amdgcn_s_sleep(20); }
#endif
        const unsigned it = bb + (unsigned)wave; if (bb < POOL_NTOTAL && it < POOL_NTOTAL && (MK_POOLWAVES == 8 || (unsigned)wave < __builtin_amdgcn_readfirstlane(ctl[1]))) pool_item(ap, lds, wave, lane, it);
        asm volatile("s_waitcnt vmcnt(0)" ::: "memory");
        __syncthreads();
    }
    if (tid_o == 0) { const unsigned st = ctl[2];
        if (st != 0u) {
            XB_SPIN(xb_ld(&b.bar[XB_XGEN(b.x)]) == st - 1u, b.bar);
            __builtin_amdgcn_fence(__ATOMIC_ACQUIRE, "agent");
            asm volatile("s_waitcnt vmcnt(0)" ::: "memory");
            ctl[2] = 0u; } }
    __syncthreads();
}

__device__ __forceinline__ void sgu_phase(const bf16* Wsb, const float* bs, const bf16* VT, const bf16* U, bf16* Y, int idx, int n) {
    int tid_o = threadIdx.x; asm volatile("" : "+v"(tid_o)); const int lane = tid_o & 63, wave = __builtin_amdgcn_readfirstlane(tid_o >> 6);
    const int h = idx & 15, q = idx >> 4, nq = n >> 4, ct = wave & 3, th = wave >> 2, fr = lane & 15, fq = lane >> 4;
    if (idx < 0 || idx >= n || nq == 0) return;
    bf16x8 wf[4][4];
#pragma unroll
    for (int tt = 0; tt < 4; ++tt)
#pragma unroll
        for (int ks = 0; ks < 4; ++ks) wf[tt][ks] = *(const GAS bf16x8*)(Wsb + ((size_t)h * 128 + th * 64 + tt * 16 + fr) * 128 + ks * 32 + fq * 8);
    float bias[4];
#pragma unroll
    for (int tt = 0; tt < 4; ++tt) bias[tt] = bs[h * 128 + th * 64 + tt * 16 + fr];
    for (int ch = q; ch < T / 128; ch += nq) {
        bf16x8 vf[4];
#pragma unroll
        for (int ks = 0; ks < 4; ++ks) vf[ks] = *(const GAS bf16x8*)(VT + (size_t)(h * 64 + ct * 16 + fr) * T + (size_t)ch * 128 + ks * 32 + fq * 8);
#pragma unroll
        for (int tt = 0; tt < 4; ++tt) { f32x4 acc = (f32x4){0.f, 0.f, 0.f, 0.f};
#pragma unroll
            for (int ks = 0; ks < 4; ++ks) acc = __builtin_amdgcn_mfma_f32_16x16x32_bf16(vf[ks], wf[tt][ks], acc, 0, 0, 0);
            const size_t t = (size_t)ch * 128 + th * 64 + tt * 16 + fr; const int c = h * 64 + ct * 16 + fq * 4;
            const v2u uu = *(const GAS v2u*)(U + t * 1024 + c);
            v2u o; o.x = pk2(bflo(uu.x) * (acc[0] + bias[tt]), bfhi(uu.x) * (acc[1] + bias[tt])); o.y = pk2(bflo(uu.y) * (acc[2] + bias[tt]), bfhi(uu.y) * (acc[3] + bias[tt]));
            *(GAS v2u*)(Y + t * 2048 + 1024 + c) = o; }
    }
}
#ifndef MK_CONVR
#define MK_CONVR 8
#endif
__device__ __forceinline__ void conv_phase(const bf16* Z, const bf16* GB, const float* wc, const float* bc, bf16* Y, int vcu, int G) {
    constexpr int R = MK_CONVR;
    int tid_o = threadIdx.x; asm volatile("" : "+v"(tid_o)); const int c0 = (tid_o & 255) * 8, rg = tid_o >> 8;
    float w0[8], w1[8], w2[8], bb[8];
    { const f32x4 a0 = *(const GAS f32x4*)(wc + c0), a1 = *(const GAS f32x4*)(wc + c0 + 4), b0 = *(const GAS f32x4*)(wc + 2048 + c0), b1 = *(const GAS f32x4*)(wc + 2048 + c0 + 4);
      const f32x4 d0 = *(const GAS f32x4*)(wc + 4096 + c0), d1 = *(const GAS f32x4*)(wc + 4096 + c0 + 4), e0 = *(const GAS f32x4*)(bc + c0), e1 = *(const GAS f32x4*)(bc + c0 + 4);
#pragma unroll
      for (int i = 0; i < 4; ++i) { w0[i] = a0[i]; w0[4 + i] = a1[i]; w1[i] = b0[i]; w1[4 + i] = b1[i]; w2[i] = d0[i]; w2[4 + i] = d1[i]; bb[i] = e0[i]; bb[4 + i] = e1[i]; } }
    for (int run = vcu * 2 + rg; run < T / R; run += G * 2) { const int t0 = run * R;
        const int sp0 = t0 < TP ? (t0 & 2047) : (t0 - TP), sl = t0 < TP ? 2048 : 8192;
        const GAS v4u* zp = (const GAS v4u*)(Z + (size_t)t0 * 2048 + c0); const GAS v4u* gp = (const GAS v4u*)(GB + (size_t)t0 * 2048 + c0);
        v4u z[R + 2], g[R];
#pragma unroll
        for (int i = 0; i < R; ++i) { z[i + 1] = zp[i * 256]; g[i] = gp[i * 256]; }
        z[0] = (v4u){0u, 0u, 0u, 0u}; z[R + 1] = (v4u){0u, 0u, 0u, 0u};
        if (sp0 > 0) z[0] = *(zp - 256);
        if (sp0 + R < sl) z[R + 1] = zp[R * 256];
        GAS v4u* yp = (GAS v4u*)(Y + (size_t)t0 * 2048 + c0);
#pragma unroll
        for (int i = 0; i < R; ++i) { float y[8];
#pragma unroll
            for (int p = 0; p < 4; ++p) { const unsigned m = z[i][p], c = z[i + 1][p], n = z[i + 2][p], gg = g[i][p]; const int i0 = 2 * p, i1 = 2 * p + 1;
                y[i0] = bflo(gg) * (w0[i0] * bflo(m) + w1[i0] * bflo(c) + w2[i0] * bflo(n) + bb[i0]);
                y[i1] = bfhi(gg) * (w0[i1] * bfhi(m) + w1[i1] * bfhi(c) + w2[i1] * bfhi(n) + bb[i1]); }
            v4u o; o.x = pk2(y[0], y[1]); o.y = pk2(y[2], y[3]); o.z = pk2(y[4], y[5]); o.w = pk2(y[6], y[7]);
            yp[i * 256] = o; }
    }
}
__device__ __forceinline__ void final_phase(float* out, const bf16* XBf, const pg8::stat_t* st, const float* gf, int vcu, int G) {
    int tid_o = threadIdx.x; asm volatile("" : "+v"(tid_o)); const int lane = tid_o & 63, gw = vcu * 8 + __builtin_amdgcn_readfirstlane(tid_o >> 6), NGW = G * 8;
    f32x4 g[4][2];
#pragma unroll
    for (int j = 0; j < 4; ++j) { g[j][0] = *(const GAS f32x4*)(gf + 512 * j + 8 * lane); g[j][1] = *(const GAS f32x4*)(gf + 512 * j + 8 * lane + 4); }
    for (int row = gw; row < T; row += NGW) { const float r = pg8::rinv_of(st, row); const bf16* xr = XBf + (size_t)row * DM + 8 * lane; float* orow = out + (size_t)row * DM + 8 * lane;
#pragma unroll
        for (int j = 0; j < 4; ++j) { const v4u w = *(const GAS v4u*)(xr + 512 * j); f32x4 a, b; a[0] = bflo(w.x); a[1] = bfhi(w.x); a[2] = bflo(w.y); a[3] = bfhi(w.y); b[0] = bflo(w.z); b[1] = bfhi(w.z); b[2] = bflo(w.w); b[3] = bfhi(w.w);
            __builtin_nontemporal_store(a * r * g[j][0], (GAS f32x4*)(orow + 512 * j)); __builtin_nontemporal_store(b * r * g[j][1], (GAS f32x4*)(orow + 512 * j + 4)); } }
}

__device__ __forceinline__ void dft_mid_rows(const bf16* ZTP, const bf16* ZTS, bf16* Y, int idx, int n) {
    int tid_o = threadIdx.x; asm volatile("" : "+v"(tid_o)); const int lane = tid_o & 63, wave = __builtin_amdgcn_readfirstlane(tid_o >> 6);
    if (idx < 0 || idx >= n) return;
    for (int it = idx * 8 + wave; it < 17 * 529; it += n * 8) { const int b = it / 529, col = it - 529 * b; const int S = b < 16 ? 2048 : 8192; const size_t row = (b < 16 ? (size_t)b * 2048 : (size_t)TP) + S / 2;
        if (col == 528) { unsigned zz = 0u; asm volatile("" : "+v"(zz)); v4u z4; z4.x = zz; z4.y = zz; z4.z = zz; z4.w = zz;
            if (lane < 62) *(GAS v4u*)(Y + row * 2048 + 528 + 8 * lane) = z4; continue; }
        const bf16* z = b < 16 ? ZTP + ((size_t)b * 1024 + col) * 2048 : ZTS + (size_t)col * 8192; float sum = 0.f;
        for (int s0 = lane * 8; s0 < S; s0 += 512) { const v4u w = *(const GAS v4u*)(z + s0);
            sum += (bflo(w.x) - bfhi(w.x)) + (bflo(w.y) - bfhi(w.y)) + (bflo(w.z) - bfhi(w.z)) + (bflo(w.w) - bfhi(w.w)); }
        sum = wave_sum(sum);
        if (lane == 0) Y[row * 2048 + col] = (bf16)f2bf(sum * (b < 16 ? 0.0027621358640099515f : 0.0013810679320049757f)); }
}
struct DftOrder {
    int nM, ntile, tile0, nunits, n, c;
    __device__ __forceinline__ void init(int nM_, int ntile_, int tile0_, int nbatch, int lo, int n_, int rot, int bx) { nM = nM_; ntile = ntile_; tile0 = tile0_; nunits = nM_ * ntile_ * nbatch; n = n_; c = (bx >= lo && bx < lo + n_) ? (bx - lo + rot) % n_ : 0x40000000; }
    __device__ __forceinline__ bool next(int i, pg8::Unit& u) const { const long L = (long)i * n + c; if (L >= nunits) return false; const int l = (int)L, r = l / nM; u.pm = l - r * nM; u.pn = 4 * (r / ntile) + tile0 + r % ntile; return true; }
    __device__ __forceinline__ void a_ready(const pg8::Unit&) const {}
    __device__ __forceinline__ void done(const pg8::Unit&) const {}
};
struct DirOrder : pg8::StaticOrder {
    bool rev;
    __device__ __forceinline__ void init_dir(int M, int N, int G_, int c_, bool rev_) { init(M, N, G_, c_); rev = rev_; }
    __device__ __forceinline__ bool next(int i, pg8::Unit& u) const {
        const long L = (long)i * G + c; if (L >= nwg) return false;
        const int q = nwg / pg8::NXCD, r = nwg % pg8::NXCD; int wgid = (int)L; const int xcd = wgid % pg8::NXCD, off = wgid / pg8::NXCD;
        const int len = xcd < r ? q + 1 : q, base = xcd < r ? xcd * (q + 1) : r * (q + 1) + (xcd - r) * q;
        wgid = base + (rev ? len - 1 - off : off);
        const int nig = pg8::WGM * nN, gid = wgid / nig, fm = gid * pg8::WGM, gsz = (nM - fm) < pg8::WGM ? (nM - fm) : pg8::WGM;
        u.pm = fm + ((wgid % nig) % gsz); u.pn = (wgid % nig) / gsz; return true;
    }
};
#ifndef MK_DYNTAIL
#define MK_DYNTAIL 1
#endif
struct DynDirOrder : DirOrder {
    unsigned* ctr; volatile LAS unsigned* slot; int nfull;
    __device__ __forceinline__ void init_dyn(int M, int N, int G_, int c_, bool rev_, unsigned* ctr_, volatile LAS unsigned* slot_) { init_dir(M, N, G_, c_, rev_); ctr = ctr_; slot = slot_; nfull = MK_DYNTAIL ? nwg / G_ : 0x40000000; }
    __device__ __forceinline__ bool next(int i, pg8::Unit& u) const {
        if (i == nfull - 1 && threadIdx.x == 0) *slot = xb_add(ctr, 1u);
        long L = (long)i * G + c;
        if (i >= nfull) { if (i > nfull) return false; L = (long)nfull * G + (long)__builtin_amdgcn_readfirstlane(*slot); }
        if (L >= nwg) return false;
        const int q = nwg / pg8::NXCD, r = nwg % pg8::NXCD; int wgid = (int)L; const int xcd = wgid % pg8::NXCD, off = wgid / pg8::NXCD;
        const int len = xcd < r ? q + 1 : q, base = xcd < r ? xcd * (q + 1) : r * (q + 1) + (xcd - r) * q;
        wgid = base + (rev ? len - 1 - off : off);
        const int nig = pg8::WGM * nN, gid = wgid / nig, fm = gid * pg8::WGM, gsz = (nM - fm) < pg8::WGM ? (nM - fm) : pg8::WGM;
        u.pm = fm + ((wgid % nig) % gsz); u.pn = (wgid % nig) / gsz; return true;
    }
};
struct RangeOrder : pg8::StaticOrder {
    __device__ __forceinline__ void init_range(int M, int N, int lo, int n, int bx) { const int c_ = (bx >= lo && bx < lo + n) ? bx - lo : 0x40000000; init(M, N, n, c_); }
};

#ifndef MK_SITES
#define MK_SITES 0xFFFFFFFFu
#endif
#define SITE(n) (((MK_SITES) >> (n)) & 1u)
#ifndef MK_DUP
#define MK_DUP 0u
#endif
#define NREP(n) ((((MK_DUP) >> (n)) & 1u) ? 2 : 1)
#define DRY(n) (NREP(n) == 2 && rep == 0)
struct SameTileOrder : pg8::StaticOrder {
    __device__ bool next(int i, pg8::Unit& u) const { const bool r = pg8::StaticOrder::next(i, u); u.pm = 0; u.pn = 0; return r; }
};
#define OPAQUE_WS() unsigned char* wsl = ws; asm volatile("" : "+s"(wsl)); unsigned char* const wl = wsl + WS_W + (size_t)L * WL_SIZE; bf16* const xb = (bf16*)(wsl + ((L & 1) ? WS_XB1 : WS_XB0)); bf16* const xalt = (bf16*)(wsl + ((L & 1) ? WS_XB0 : WS_XB1)); bf16* const Hb = (bf16*)(wsl + WS_H); (void)wl; (void)xb; (void)xalt; (void)Hb
#ifndef MK_DIR
#define MK_DIR 1
#endif
#define PH_REV(k) ((MK_DIR) != 0 && ((k) & 1) != 0)
__global__ void __launch_bounds__(512, 2) mk_fwd(Args args) {
    extern __shared__ __attribute__((aligned(16))) unsigned char lds_raw[];
    LAS unsigned char* lds = (LAS unsigned char*)lds_raw;
    const int tid = threadIdx.x, lane = tid & 63, wave = __builtin_amdgcn_readfirstlane(tid >> 6);
    const int G = gridDim.x, bx = blockIdx.x;
    const int vcu = (G % 8 == 0) ? (bx % 8) * (G / 8) + bx / 8 : bx;
    unsigned char* ws = args.ws;
    volatile LAS unsigned* MISC = (volatile LAS unsigned*)(lds + LDSCTL_OFF);
    for (int u = tid; u < (LDS_BYTES - LDSCTL_OFF) / 4; u += 512) ((LAS unsigned*)(lds + LDSCTL_OFF))[u] = 0u;
    __syncthreads();
    XcdBarrier bar; bar.bar = (unsigned*)(ws + WS_CTL) + CW_BAR; bar.x = 0; bar.st = nullptr;
    if (MK_N_LAUNCHES == 1) bar = xcd_barrier_post((unsigned*)(ws + WS_CTL) + CW_BAR, MISC + 8);
    const int lo = args.ph_lo, hi = args.ph_hi;
#define IN(k) (lo <= (k) && (k) < hi)
    volatile LAS unsigned* pctl = MISC + 16;
#define SEAMT(k, tgt) do { if (IN(k) && IN((k) + 1)) pool_seam(bar, lds, pctl, (tgt), true); } while (0)
#define SEAM(k) SEAMT(pb0 + (k), pool_target(L, (k)))
    pg8::stat_t* stats = (pg8::stat_t*)(ws + WS_STATS); pg8::stat_t* st_dummy = stats + (size_t)17 * T;

    if (IN(0)) {
        CArgs* ap0 = (CArgs*)__builtin_amdgcn_kernarg_segment_ptr(); asm volatile("" : "+s"(ap0));
        for (unsigned it = (unsigned)(vcu * 8 + wave); it < (unsigned)POOL_NA; it += (unsigned)(G * 8)) pool_item(ap0, lds, wave, lane, it);
    }
    if (IN(0) && MK_N_LAUNCHES != 1) pool_seam(bar, lds, pctl, POOL_NTOTAL, false);
    SEAMT(0, (unsigned)POOL_NA);

#pragma unroll 1
    for (int L = 0; L < NLAYER; ++L) {
        const int pb0 = 1 + 8 * L, j = L >> 1; const bool odd = (L & 1) != 0;
        pg8::stat_t* st0 = stats + (size_t)(4 * L + 0) * T; pg8::stat_t* st1 = stats + (size_t)(4 * L + 1) * T; pg8::stat_t* st2 = stats + (size_t)(4 * L + 2) * T; pg8::stat_t* st3 = stats + (size_t)(4 * L + 3) * T; pg8::stat_t* st4 = stats + (size_t)(4 * L + 4) * T;
        { OPAQUE_WS();
#ifdef MK_NULLP
        if (IN(pb0 + 0) && (MK_NULLP & 4)) { pg8::Gemm g{xb, (const bf16*)(wl + WL_F1IN), T, 2 * DFF, DM}; SameTileOrder S; S.init(T, 2 * DFF, G, bx);
            pg8::EpiNull E{(float*)st_dummy}; pg8::gemm_phase<pg8::EpiNull, SameTileOrder, MK_ALIGN, MK_SP2>(lds, g, S, E); }
        if (IN(pb0 + 0) && (MK_NULLP & 1)) { pg8::Gemm g{xb, (const bf16*)(wl + WL_F1IN), T, 2 * DFF, DM}; pg8::StaticOrder S; S.init(T, 2 * DFF, G, bx);
            pg8::EpiNull E{(float*)st_dummy}; pg8::gemm_phase<pg8::EpiNull, pg8::StaticOrder, MK_ALIGN, MK_SP2>(lds, g, S, E); }
        if (IN(pb0 + 1) && (MK_NULLP & 2)) { pg8::Gemm g{(const bf16*)(wsl + WS_H), (const bf16*)(wl + WL_F1OUT), T, DM, DFF}; pg8::StaticOrder S; S.init(T, DM, G, bx);
            pg8::EpiNull E{(float*)st_dummy}; pg8::gemm_phase<pg8::EpiNull, pg8::StaticOrder, MK_ALIGN, MK_SP2>(lds, g, S, E); }
#endif
        if (IN(pb0 + 0) && SITE(1)) for (int rep = 0; rep < NREP(1); ++rep) { pg8::Gemm g{xb, (const bf16*)(wl + WL_F1IN), T, 2 * DFF, DM}; DynDirOrder S; S.init_dyn(T, 2 * DFF, G, bx, PH_REV(0), (unsigned*)(wsl + WS_CTL) + CW_POOL + 128 + 2 * L, MISC + 24);
            pg8::EpiSwiGLU E{Hb, DFF, st0}; pg8::gemm_phase<pg8::EpiSwiGLU, DynDirOrder, MK_ALIGN, MK_SP2>(lds, g, S, E); }
        }
        SEAM(0);
        { OPAQUE_WS();
        if (IN(pb0 + 1) && SITE(2)) for (int rep = 0; rep < NREP(2); ++rep) { pg8::Gemm g{Hb, (const bf16*)(wl + WL_F1OUT), T, DM, DFF}; DirOrder S; S.init_dir(T, DM, G, bx, PH_REV(1));
            pg8::EpiRmw<0> E{xb, xb, nullptr, DRY(2) ? st_dummy : st1, DRY(2) ? 0.0f : 0.5f}; pg8::gemm_phase<pg8::EpiRmw<0>, DirOrder, MK_ALIGN, MK_SP2>(lds, g, S, E); }
        }
        SEAM(1);
        { OPAQUE_WS();
        if (IN(pb0 + 2)) {
            if (!odd) { unsigned char* we = wsl + WS_WE + (size_t)j * WE_SIZE;
                if (SITE(3)) for (int rep = 0; rep < NREP(3); ++rep) { pg8::Gemm g{(const bf16*)(we + WE_WZ), xb, 2048, T, DM}; DirOrder S; S.init_dir(2048, T, G, bx, PH_REV(2));
                  pg8::EpiMT E{(bf16*)(wsl + WS_ZTP), (bf16*)(wsl + WS_ZTS), (bf16*)(wsl + WS_VT), st1, args.in[9] + j * 1024};
                  pg8::gemm_phase<pg8::EpiMT, DirOrder, MK_ALIGN, MK_SP2>(lds, g, S, E); }
                if (SITE(4)) for (int rep = 0; rep < NREP(4); ++rep) { pg8::Gemm g{xb, (const bf16*)(we + WE_WU), T, 1024, DM}; DirOrder S; S.init_dir(T, 1024, G, (bx + G / 2) % G, PH_REV(2));
                  pg8::EpiRowBf16<1> E{(bf16*)(wsl + WS_U), 1024, st1}; pg8::gemm_phase<pg8::EpiRowBf16<1>, DirOrder, MK_ALIGN, MK_SP2>(lds, g, S, E); }
            } else if (SITE(5)) for (int rep = 0; rep < NREP(5); ++rep) { unsigned char* wo = wsl + WS_WOD + (size_t)j * WO_SIZE;
                pg8::Gemm g{xb, (const bf16*)(wo + WO_WC), T, 6144, DM}; DirOrder S; S.init_dir(T, 6144, G, bx, PH_REV(2));
                pg8::EpiOddIn E{(bf16*)(wsl + WS_Z), (bf16*)(wsl + WS_GB), st1}; pg8::gemm_phase<pg8::EpiOddIn, DirOrder, MK_ALIGN, MK_SP2>(lds, g, S, E); }
        }
        }
        SEAM(2);
        { OPAQUE_WS();
        if (IN(pb0 + 3)) {
            if (!odd) { unsigned char* we = wsl + WS_WE + (size_t)j * WE_SIZE;
                const bool tuned = (G == 256); const int s_lo = 0, sp_n = tuned ? 48 : G, sq_lo = tuned ? 48 : 0, sq_n = tuned ? 32 : G, p_lo = tuned ? 80 : 0, p_n = tuned ? 176 : G;
                const bf16* dpc = (const bf16*)(wsl + WS_DP); const bf16* dps = dpc + (size_t)1024 * 2048; const bf16* dsc = (const bf16*)(wsl + WS_DS); const bf16* dss = dsc + (size_t)4096 * 8192;
                if (SITE(7)) for (int rep = 0; rep < NREP(7); ++rep) {
                  { pg8::Gemm g{dsc, (const bf16*)(wsl + WS_ZTS), 4096, 1024, 8192}; DftOrder S; S.init(16, 3, 0, 1, s_lo, sp_n, 0, bx);
                    pg8::EpiDFT E{xalt, TP, 8192, 0.0013810679320049757f, 1.0f, 0, 528}; pg8::gemm_phase<pg8::EpiDFT, DftOrder, MK_ALIGN, MK_SP2>(lds, g, S, E); }
                  { pg8::Gemm g{dss, (const bf16*)(wsl + WS_ZTS), 4096, 1024, 8192}; DftOrder S; S.init(16, 2, 2, 1, sq_lo, sq_n, 0, bx);
                    pg8::EpiDFT E{xalt, TP, 8192, 0.0013810679320049757f, -1.0f, 528, 1024}; pg8::gemm_phase<pg8::EpiDFT, DftOrder, MK_ALIGN, MK_SP2>(lds, g, S, E); } }
                if (SITE(6)) for (int rep = 0; rep < NREP(6); ++rep) {
                  { pg8::Gemm g{dpc, (const bf16*)(wsl + WS_ZTP), 1024, 16 * 1024, 2048}; DftOrder S; S.init(4, 3, 0, 16, p_lo, p_n, 0, bx);
                    pg8::EpiDFT E{xalt, 0, 2048, 0.0027621358640099515f, 1.0f, 0, 528}; pg8::gemm_phase<pg8::EpiDFT, DftOrder, MK_ALIGN, MK_SP2>(lds, g, S, E); }
                  { pg8::Gemm g{dps, (const bf16*)(wsl + WS_ZTP), 1024, 16 * 1024, 2048}; DftOrder S; S.init(4, 2, 2, 16, p_lo, p_n, tuned ? 160 : 0, bx);
                    pg8::EpiDFT E{xalt, 0, 2048, 0.0027621358640099515f, -1.0f, 528, 1024}; pg8::gemm_phase<pg8::EpiDFT, DftOrder, MK_ALIGN, MK_SP2>(lds, g, S, E); } }
                dft_mid_rows((const bf16*)(wsl + WS_ZTP), (const bf16*)(wsl + WS_ZTS), xalt, tuned ? bx : bx, tuned ? 80 : G);
                if (SITE(8)) for (int rep = 0; rep < NREP(8); ++rep) sgu_phase((const bf16*)(we + WE_WS), args.in[11] + j * 2048, (const bf16*)(wsl + WS_VT), (const bf16*)(wsl + WS_U), xalt, bx - p_lo, p_n & ~15);
            } else if (SITE(9)) for (int rep = 0; rep < NREP(9); ++rep) {
                conv_phase((const bf16*)(wsl + WS_Z), (const bf16*)(wsl + WS_GB), args.in[14] + j * 3 * 2048, args.in[15] + j * 2048, xalt, vcu, G);
            }
        }
        }
        SEAM(3);
        { OPAQUE_WS();
        if (IN(pb0 + 4) && SITE(10)) for (int rep = 0; rep < NREP(10); ++rep) { const bf16* wout = odd ? (const bf16*)(wsl + WS_WOD + (size_t)j * WO_SIZE + WO_WOC) : (const bf16*)(wsl + WS_WE + (size_t)j * WE_SIZE + WE_WO);
            pg8::Gemm g{xalt, wout, T, DM, DM}; DirOrder S; S.init_dir(T, DM, G, bx, PH_REV(4));
            pg8::EpiRmw<0> E{xb, xb, nullptr, DRY(10) ? st_dummy : st2, DRY(10) ? 0.0f : 1.0f}; pg8::gemm_phase<pg8::EpiRmw<0>, DirOrder, MK_ALIGN, MK_SP2>(lds, g, S, E); }
        }
        SEAM(4);
        { OPAQUE_WS();
        if (IN(pb0 + 5) && SITE(11)) for (int rep = 0; rep < NREP(11); ++rep) { pg8::Gemm g{xb, (const bf16*)(wl + WL_F2IN), T, 2 * DFF, DM}; DynDirOrder S; S.init_dyn(T, 2 * DFF, G, bx, PH_REV(5), (unsigned*)(wsl + WS_CTL) + CW_POOL + 129 + 2 * L, MISC + 24);
            pg8::EpiSwiGLU E{Hb, DFF, st2}; pg8::gemm_phase<pg8::EpiSwiGLU, DynDirOrder, MK_ALIGN, MK_SP2>(lds, g, S, E); }
        }
        SEAM(5);
        { OPAQUE_WS();
        if (IN(pb0 + 6)) {
            if (SITE(12)) for (int rep = 0; rep < NREP(12); ++rep) { pg8::Gemm g{Hb, (const bf16*)(wl + WL_F2OUT), T, DM, DFF}; DirOrder S; S.init_dir(T, DM, G, bx, PH_REV(6));
              pg8::EpiRmw<0> E{xb, xb, nullptr, DRY(12) ? st_dummy : st3, DRY(12) ? 0.0f : 0.5f}; pg8::gemm_phase<pg8::EpiRmw<0>, DirOrder, MK_ALIGN, MK_SP2>(lds, g, S, E); }
            if (SITE(13)) for (int rep = 0; rep < NREP(13); ++rep) { int kpe = 256; asm volatile("" : "+s"(kpe));
              pg8::Gemm g{(const bf16*)(wsl + WS_PB) + (size_t)L * T * 256, (const bf16*)(wl + WL_WP), T, DM, kpe}; DirOrder S; S.init_dir(T, DM, G, bx, PH_REV(6));
              pg8::EpiRowBf16<0> E{xalt, 2048, nullptr}; pg8::gemm_phase<pg8::EpiRowBf16<0>, DirOrder, MK_ALIGN, MK_SP2>(lds, g, S, E); }
        }
        }
        SEAM(6);
        { OPAQUE_WS();
        if (IN(pb0 + 7) && SITE(14)) for (int rep = 0; rep < NREP(14); ++rep) { pg8::Gemm g{xb, (const bf16*)(wl + WL_WG), T, DM, DM}; DirOrder S; S.init_dir(T, DM, G, bx, PH_REV(7));
            pg8::EpiRmw<1> E{xb, xalt, st3, DRY(14) ? st_dummy : st4, DRY(14) ? 0.0f : 1.0f}; pg8::gemm_phase<pg8::EpiRmw<1>, DirOrder, MK_ALIGN, MK_SP2>(lds, g, S, E); }
        }
        SEAM(7);
    }
    if (IN(33) && SITE(15)) final_phase(args.out, (const bf16*)(ws + WS_XB0), stats + (size_t)16 * T, args.in[23], vcu, G);
#ifdef MK_POOLPROBE
    if (bx == 0 && tid == 0) { const unsigned n = xb_ld((unsigned*)(ws + WS_CTL) + CW_POOL + 64); const unsigned long long t0 = __builtin_amdgcn_s_memrealtime();
        while (__builtin_amdgcn_s_memrealtime() - t0 < (unsigned long long)n * (MK_POOLPROBE)) __builtin_amdgcn_s_sleep(8); }
#endif
#undef IN
#undef SEAM
#undef SEAMT
}

extern "C" void kernel_launch(void* const* d_in, const int* in_sizes, int n_in, void* d_out, int out_size, void* d_ws, size_t ws_size, hipStream_t stream) {
    static int grid = 0;
    if (grid == 0) {
        if (n_in != 24 || out_size != T * DM || ws_size < WS_END) { fprintf(stderr, "kernel_launch: unexpected sizes (n_in %d, out %d, ws %zu, need %zu); nothing launched\n", n_in, out_size, ws_size, (size_t)WS_END); grid = -1; return; }
        int dev = 0, cus = 0, per_cu = 0;
        if (hipGetDevice(&dev) != hipSuccess || hipDeviceGetAttribute(&cus, hipDeviceAttributeMultiprocessorCount, dev) != hipSuccess) { grid = -1; return; }
        if (hipFuncSetAttribute((const void*)mk_fwd, hipFuncAttributeMaxDynamicSharedMemorySize, LDS_BYTES) != hipSuccess) { fprintf(stderr, "kernel_launch: hipFuncSetAttribute failed\n"); grid = -1; return; }
        if (hipOccupancyMaxActiveBlocksPerMultiprocessor(&per_cu, (const void*)mk_fwd, 512, LDS_BYTES) != hipSuccess || per_cu < 1) fprintf(stderr, "kernel_launch: occupancy query reports %d workgroups per CU\n", per_cu);
        (void)hipGetLastError();
        grid = cus;
    }
    if (grid < 0) return;
#ifdef MK_POISON_WS
    if (hipMemsetAsync((char*)d_ws, 0xFF, WS_END, stream) != hipSuccess) return;
#endif
    if (hipMemsetAsync((char*)d_ws + WS_CTL, 0, CTL_BYTES, stream) != hipSuccess) return;
    Args a{};
    for (int i = 0; i < 24; ++i) a.in[i] = (const float*)d_in[i];
    a.out = (float*)d_out; a.ws = (unsigned char*)d_ws;
    if (MK_N_LAUNCHES == 1) { a.ph_lo = 0; a.ph_hi = NPHASE; hipLaunchKernelGGL(mk_fwd, dim3(grid), dim3(512), LDS_BYTES, stream, a); }
    else for (int p = 0; p < NPHASE; ++p) { a.ph_lo = p; a.ph_hi = p + 1; hipLaunchKernelGGL(mk_fwd, dim3(grid), dim3(512), LDS_BYTES, stream, a); }
}
```

```cpp
#include <hip/hip_runtime.h>
#include <cstdio>
#include <cstdint>
#ifndef MK_WGM
#define MK_WGM 4
#endif
#ifndef MK_SP2
#define MK_SP2 true
#endif
#ifndef MK_ALIGN
#define MK_ALIGN true
#endif
namespace pg8 {
#define PG8_LAS __attribute__((address_space(3)))
typedef unsigned short bf16_t;
typedef short bf16x8 __attribute__((ext_vector_type(8)));
typedef float f32x4 __attribute__((ext_vector_type(4)));
typedef unsigned u32x4 __attribute__((ext_vector_type(4)));
constexpr int BM = 256, BK = 64, HALF = 128, HTB = HALF * BK * 2  , STAGE_BYTES = 8 * HTB, NXCD = 8, WGM = MK_WGM;

__host__ __device__ __forceinline__ int lds_byte(int r, int c) { const int st = (r >> 4) * 2 + (c >> 5), rr = r & 15, cc = c & 31, ob = rr * 64 + cc * 2; return st * 1024 + (ob ^ (((ob >> 9) & 1) << 5)); }
__host__ __device__ __forceinline__ void stage_rc(int b, int& R, int& C) { const int st = b / 1024, sb = b % 1024, swz = sb ^ (((sb >> 9) & 1) << 5); R = (st >> 1) * 16 + swz / 64; C = (st & 1) * 32 + (swz % 64) / 2; }
__host__ __device__ __forceinline__ int perm32(int rho) { const int n = rho >> 4, i = rho & 15; return 8 * (i >> 2) + 4 * n + (i & 3); }

struct Unit { int pm, pn; };
struct Gemm { const bf16_t* A; const bf16_t* Bt; int M, N, K; };

struct StaticOrder {
    int nM, nN, nwg, G, c;
    __host__ __device__ __forceinline__ void init(int M, int N, int G_, int c_) { nM = M / BM; nN = N / BM; nwg = nM * nN; G = G_; c = c_; }
    __host__ __device__ __forceinline__ bool next(int i, Unit& u) const {
        const long L = (long)i * G + c; if (L >= nwg) return false;
        int wgid = (int)L; { const int q = nwg / NXCD, r = nwg % NXCD, xcd = wgid % NXCD, off = wgid / NXCD; wgid = (xcd < r ? xcd * (q + 1) : r * (q + 1) + (xcd - r) * q) + off; }
        const int nig = WGM * nN, gid = wgid / nig, fm = gid * WGM, gsz = (nM - fm) < WGM ? (nM - fm) : WGM;
        u.pm = fm + ((wgid % nig) % gsz); u.pn = (wgid % nig) / gsz; return true;
    }
    __device__ __forceinline__ void a_ready(const Unit&) const {}
    __device__ __forceinline__ void done(const Unit&) const {}
};

__device__ __forceinline__ unsigned cvt_pk_bf16(float lo, float hi) { unsigned r; asm volatile("v_cvt_pk_bf16_f32 %0, %1, %2" : "=v"(r) : "v"(lo), "v"(hi)); return r; }
typedef float f32x2 __attribute__((ext_vector_type(2)));
__device__ __forceinline__ f32x2 gelu_pk(f32x2 v) {
    const f32x2 av = __builtin_elementwise_abs(v), d = av * 0.2316418882f + 1.0f;
    f32x2 t; t.x = __builtin_amdgcn_rcpf(d.x); t.y = __builtin_amdgcn_rcpf(d.y);
    f32x2 q = t * 0.5307027145f + (-0.7265760135f); q = q * t + 0.7107068705f; q = q * t + (-0.142248368f); q = q * t + 0.127414796f; q = q * t;
    const f32x2 s = (v * v) * (-0.72134752044f);
    f32x2 e; e.x = __builtin_amdgcn_exp2f(s.x); e.y = __builtin_amdgcn_exp2f(s.y);
    const f32x2 m = v * (q * e), r = v - m;
    f32x2 o; o.x = v.x < 0.f ? m.x : r.x; o.y = v.y < 0.f ? m.y : r.y; return o;
}

template <class Epi, class Sched, bool ALIGN_EPI = false, bool SP2 = false, bool ABLK = false>
__device__ __forceinline__ void gemm_phase(PG8_LAS unsigned char* lds, const Gemm g, const Sched& S, const Epi& E) {
    int tid_o = threadIdx.x; asm volatile("" : "+v"(tid_o));
    const int tid = tid_o, wid = __builtin_amdgcn_readfirstlane(tid >> 6), lane = tid & 63, wr = wid >> 2, wc = wid & 3, fr = lane & 15, fq = lane >> 4;
    const int K = g.K, nt = K / BK;
    unsigned voffA[2], voffB[2];
#pragma unroll
    for (int i = 0; i < 2; ++i) { int R, C; stage_rc(tid * 16 + i * 8192, R, C); const int Rb = Epi::PERM ? ((R & ~31) + perm32(R & 31)) : R;
        voffA[i] = ABLK ? (unsigned)(R * BK + C) * 2u : (unsigned)(R * K + C) * 2u; voffB[i] = (unsigned)(Rb * K + C) * 2u; }
    const unsigned kstep = (unsigned)(BK * 2);
    const unsigned hstep = (unsigned)HALF * (unsigned)K * 2u;
    const unsigned tstep = 2u * hstep;
    const unsigned kstepA = ABLK ? (unsigned)(BM * BK * 2) : kstep, hstepA = ABLK ? (unsigned)(HALF * BK * 2) : hstep, tstepA = ABLK ? (unsigned)nt * (unsigned)(BM * BK * 2) : tstep;
    const unsigned ldsw = (unsigned)wid * 1024u;
    const int aoff = lds_byte(wr * 64 + fr, fq * 8), boff = lds_byte(wc * 32 + fr, fq * 8);
#define PG8_SA(b, h) (((b) * 2 + (h)) * HTB)
#define PG8_SB(b, h) ((4 + (b) * 2 + (h)) * HTB)
    const __amdgpu_buffer_rsrc_t rs_voffA = __builtin_amdgcn_make_buffer_rsrc((void*)g.A, (short)0, -1, 0x00020000);
    const __amdgpu_buffer_rsrc_t rs_voffB = __builtin_amdgcn_make_buffer_rsrc((void*)g.Bt, (short)0, -1, 0x00020000);
#define PG8_STAGE(bufoff, gbase, voff) do { _Pragma("unroll") for (int _i = 0; _i < 2; ++_i) \
        __builtin_amdgcn_raw_ptr_buffer_load_lds(rs_##voff, (PG8_LAS void*)(lds + (bufoff) + ldsw + _i * 8192), 16, (int)(voff)[_i], (int)(gbase), 0, 0); } while (0)
#define PG8_LDA(dst, b, h) do { _Pragma("unroll") for (int m = 0; m < 4; ++m) _Pragma("unroll") for (int k = 0; k < 2; ++k) dst[m][k] = *(const PG8_LAS bf16x8*)(lds + PG8_SA(b, h) + aoff + m * 2048 + k * 1024); } while (0)
#define PG8_LDB(dst, b, h) do { _Pragma("unroll") for (int n = 0; n < 2; ++n) _Pragma("unroll") for (int k = 0; k < 2; ++k) dst[n][k] = *(const PG8_LAS bf16x8*)(lds + PG8_SB(b, h) + boff + n * 2048 + k * 1024); } while (0)
#define PG8_MMA(ai, bj, At, Bt) do { __builtin_amdgcn_s_setprio(1); _Pragma("unroll") for (int m = 0; m < 4; ++m) _Pragma("unroll") for (int n = 0; n < 2; ++n) _Pragma("unroll") for (int k = 0; k < 2; ++k) \
        acc[ai][bj][m][n] = __builtin_amdgcn_mfma_f32_16x16x32_bf16(Bt[n][k], At[m][k], acc[ai][bj][m][n], 0, 0, 0); __builtin_amdgcn_s_setprio(0); } while (0)
#define PG8_WAIT_V(n) asm volatile("s_waitcnt vmcnt(" #n ")" ::: "memory")
#define PG8_WAIT_L(n) asm volatile("s_waitcnt lgkmcnt(" #n ")" ::: "memory")
#define PG8_BAR __builtin_amdgcn_s_barrier()
#define PG8_SCHED __builtin_amdgcn_sched_barrier(0)
    Unit cur, nxt; int ui = 0;
    if (!S.next(0, cur)) return;
    f32x4 acc[2][2][4][2];
#pragma unroll
    for (int a = 0; a < 2; ++a)
#pragma unroll
        for (int b = 0; b < 2; ++b)
#pragma unroll
            for (int m = 0; m < 4; ++m)
#pragma unroll
                for (int n = 0; n < 2; ++n) acc[a][b][m][n] = (f32x4){0.f, 0.f, 0.f, 0.f};
    bf16x8 At[4][2], B0[2][2], B1[2][2];
    unsigned cA = (unsigned)cur.pm * tstepA, cB = (unsigned)cur.pn * tstep;
    S.a_ready(cur);
    if constexpr (SP2) {
        PG8_STAGE(PG8_SB(0, 0), cB, voffB); PG8_STAGE(PG8_SB(0, 1), cB + hstep, voffB); PG8_STAGE(PG8_SA(0, 0), cA, voffA); PG8_STAGE(PG8_SA(0, 1), cA + hstepA, voffA);
        if (wr == 1) PG8_BAR;
        PG8_WAIT_V(2); PG8_BAR;
        PG8_STAGE(PG8_SB(1, 0), cB + kstep, voffB); PG8_STAGE(PG8_SA(1, 0), cA + kstepA, voffA); PG8_STAGE(PG8_SB(1, 1), cB + hstep + kstep, voffB);
        PG8_WAIT_V(6); PG8_BAR;
    } else {
        PG8_STAGE(PG8_SB(0, 0), cB, voffB); PG8_STAGE(PG8_SA(0, 0), cA, voffA); PG8_STAGE(PG8_SB(0, 1), cB + hstep, voffB); PG8_STAGE(PG8_SA(0, 1), cA + hstepA, voffA);
        if (wr == 1) PG8_BAR;
        PG8_WAIT_V(4); PG8_BAR;
        PG8_STAGE(PG8_SB(1, 0), cB + kstep, voffB); PG8_STAGE(PG8_SA(1, 0), cA + kstepA, voffA); PG8_STAGE(PG8_SB(1, 1), cB + hstep + kstep, voffB);
        PG8_WAIT_V(6); PG8_BAR;
    }
    for (;;) {
        const bool has_next = S.next(ui + 1, nxt);
        const unsigned nA = has_next ? (unsigned)nxt.pm * tstepA : cA, nB = has_next ? (unsigned)nxt.pn * tstep : cB;
        for (int t = 0; t < nt; t += 2) {
            const bool last = (t == nt - 2);
            const unsigned a1 = cA + (unsigned)(t + 1) * kstepA;
            const unsigned a2 = last ? nA : cA + (unsigned)(t + 2) * kstepA, b2 = last ? nB : cB + (unsigned)(t + 2) * kstep;
            const unsigned a3 = a2 + kstepA, b3 = b2 + kstep;
            if (last && has_next) S.a_ready(nxt);
            if constexpr (SP2) {
            PG8_LDB(B0, 0, 0); PG8_LDB(B1, 0, 1); PG8_SCHED; PG8_LDA(At, 0, 0); PG8_STAGE(PG8_SA(1, 1), a1 + hstepA, voffA);
            PG8_WAIT_V(8); PG8_WAIT_L(0); PG8_BAR; PG8_MMA(0, 0, At, B0); PG8_MMA(0, 1, At, B1); PG8_BAR; PG8_SCHED;
            PG8_LDA(At, 0, 1); PG8_STAGE(PG8_SB(0, 0), b2, voffB); PG8_STAGE(PG8_SB(0, 1), b2 + hstep, voffB); PG8_STAGE(PG8_SA(0, 0), a2, voffA);
            PG8_WAIT_V(8); PG8_WAIT_L(0); PG8_BAR; PG8_MMA(1, 0, At, B0); PG8_MMA(1, 1, At, B1); PG8_BAR; PG8_SCHED;
            PG8_LDB(B0, 1, 0); PG8_LDB(B1, 1, 1); PG8_SCHED; PG8_LDA(At, 1, 0); PG8_STAGE(PG8_SA(0, 1), a2 + hstepA, voffA);
            PG8_WAIT_V(8); PG8_WAIT_L(0); PG8_BAR; PG8_MMA(0, 0, At, B0); PG8_MMA(0, 1, At, B1); PG8_BAR; PG8_SCHED;
            PG8_LDA(At, 1, 1); PG8_STAGE(PG8_SB(1, 0), b3, voffB); PG8_STAGE(PG8_SB(1, 1), b3 + hstep, voffB); PG8_STAGE(PG8_SA(1, 0), a3, voffA);
            PG8_WAIT_V(8); PG8_WAIT_L(0); PG8_BAR; PG8_MMA(1, 0, At, B0); PG8_MMA(1, 1, At, B1); PG8_BAR; PG8_SCHED;
            } else {
            PG8_LDB(B0, 0, 0); PG8_SCHED; PG8_LDA(At, 0, 0); PG8_STAGE(PG8_SA(1, 1), a1 + hstepA, voffA);
            PG8_WAIT_L(8); PG8_BAR; PG8_WAIT_L(0); PG8_MMA(0, 0, At, B0); PG8_BAR; PG8_SCHED;
            PG8_LDB(B1, 0, 1); PG8_STAGE(PG8_SB(0, 0), b2, voffB);
            PG8_BAR; PG8_WAIT_L(0); PG8_MMA(0, 1, At, B1); PG8_BAR;
            PG8_LDA(At, 0, 1); PG8_STAGE(PG8_SA(0, 0), a2, voffA);
            PG8_BAR; PG8_WAIT_L(0); PG8_MMA(1, 0, At, B0); PG8_BAR; PG8_SCHED;
            PG8_STAGE(PG8_SB(0, 1), b2 + hstep, voffB);
            PG8_WAIT_V(6); PG8_BAR; PG8_MMA(1, 1, At, B1); PG8_BAR;
            PG8_LDB(B0, 1, 0); PG8_SCHED; PG8_LDA(At, 1, 0); PG8_STAGE(PG8_SA(0, 1), a2 + hstepA, voffA);
            PG8_WAIT_L(8); PG8_BAR; PG8_WAIT_L(0); PG8_MMA(0, 0, At, B0); PG8_BAR; PG8_SCHED;
            PG8_LDB(B1, 1, 1); PG8_STAGE(PG8_SB(1, 0), b3, voffB);
            PG8_BAR; PG8_WAIT_L(0); PG8_MMA(0, 1, At, B1); PG8_BAR;
            PG8_LDA(At, 1, 1); PG8_STAGE(PG8_SA(1, 0), a3, voffA);
            PG8_BAR; PG8_WAIT_L(0); PG8_MMA(1, 0, At, B0); PG8_BAR; PG8_SCHED;
            PG8_STAGE(PG8_SB(1, 1), b3 + hstep, voffB);
            PG8_WAIT_V(6); PG8_BAR; PG8_MMA(1, 1, At, B1); PG8_BAR;
            }
        }
        if constexpr (ALIGN_EPI) { if (wr == 0) PG8_BAR; }
        if constexpr (!Epi::AFTER_DRAIN) { E(acc, cur, wr, wc, fr, fq); S.done(cur); }
        if (!has_next) break;
#pragma unroll
        for (int a = 0; a < 2; ++a)
#pragma unroll
            for (int b = 0; b < 2; ++b)
#pragma unroll
                for (int m = 0; m < 4; ++m)
#pragma unroll
                    for (int n = 0; n < 2; ++n) acc[a][b][m][n] = (f32x4){0.f, 0.f, 0.f, 0.f};
        cur = nxt; cA = nA; cB = nB; ++ui;
        if constexpr (ALIGN_EPI) { if (wr == 1) PG8_BAR; }
    }
    PG8_WAIT_V(0);
    if constexpr (!ALIGN_EPI) { if (wr == 0) PG8_BAR; }
    PG8_BAR;
    if constexpr (Epi::AFTER_DRAIN) { E.fused(acc, cur, wr, wc, fr, fq, lds, wid, lane); S.done(cur); }
#undef PG8_SA
#undef PG8_SB
#undef PG8_STAGE
#undef PG8_LDA
#undef PG8_LDB
#undef PG8_MMA
#undef PG8_WAIT_V
#undef PG8_WAIT_L
#undef PG8_BAR
#undef PG8_SCHED
}
}
namespace pg8 {
#define PG8_GAS __attribute__((address_space(1)))
constexpr float RMS_EPS = 1e-6f;
typedef unsigned long long stat_t;
typedef unsigned long long u64x2 __attribute__((ext_vector_type(2)));
constexpr float STAT_SCALE = 1048576.0f;
__device__ __forceinline__ stat_t stat_fix(float ss) { return (stat_t)(ss * STAT_SCALE + 0.5f); }
__device__ __forceinline__ float msq_from(stat_t q) { const float lo = (float)(unsigned)q * (1.0f / (2048.0f * STAT_SCALE)) + RMS_EPS; return (float)(unsigned)(q >> 32) * (4294967296.0f / (2048.0f * STAT_SCALE)) + lo; }
__device__ __forceinline__ float rinv_from(stat_t q) { return __builtin_amdgcn_rsqf(msq_from(q)); }
__device__ __forceinline__ float rinv_of(const stat_t* st, int row) { return rinv_from(st[row]); }
__device__ __forceinline__ float fast_sigmoid(float v) { return __builtin_amdgcn_rcpf(1.0f + __expf(-v)); }
__device__ __forceinline__ float gelu_tanh(float v) { const float y = 1.5957691216f * (v + 0.044715f * v * v * v); return v * fast_sigmoid(y); }
__device__ __forceinline__ u32x4 pack8(const f32x4 a, const f32x4 b) { u32x4 w; w.x = cvt_pk_bf16(a[0], a[1]); w.y = cvt_pk_bf16(a[2], a[3]); w.z = cvt_pk_bf16(b[0], b[1]); w.w = cvt_pk_bf16(b[2], b[3]); return w; }
__device__ __forceinline__ void unpack8(const u32x4 w, f32x4& a, f32x4& b) {
    a[0] = __uint_as_float(w.x << 16); a[1] = __uint_as_float(w.x & 0xffff0000u); a[2] = __uint_as_float(w.y << 16); a[3] = __uint_as_float(w.y & 0xffff0000u);
    b[0] = __uint_as_float(w.z << 16); b[1] = __uint_as_float(w.z & 0xffff0000u); b[2] = __uint_as_float(w.w << 16); b[3] = __uint_as_float(w.w & 0xffff0000u); }
__device__ __forceinline__ float sumsq8(const f32x4 a, const f32x4 b) { return (a[0] * a[0] + a[1] * a[1]) + (a[2] * a[2] + a[3] * a[3]) + (b[0] * b[0] + b[1] * b[1]) + (b[2] * b[2] + b[3] * b[3]); }

#ifndef MK_HBLK
#define MK_HBLK 1
#endif
struct EpiSwiGLU {
    static constexpr bool PERM = true, AFTER_DRAIN = false;
    bf16_t* H; int ldh; const stat_t* st;
    __device__ __forceinline__ void operator()(const f32x4 (&acc)[2][2][4][2], const Unit& u, int wr, int wc, int fr, int fq) const {
        const int rowu = u.pm * BM + wr * 64; const unsigned lo = (unsigned)(fr * ldh + 8 * fq);
        stat_t q[8];
#pragma unroll
        for (int g = 0; g < 8; ++g) q[g] = ((const PG8_GAS stat_t*)(st + rowu + (g >> 2) * HALF + (g & 3) * 16))[fr];
        asm volatile("" ::: "memory");
#pragma unroll
        for (int ai = 0; ai < 2; ++ai)
#pragma unroll
            for (int m = 0; m < 4; ++m) { const int ru = rowu + ai * HALF + m * 16;
                const float v = msq_from(q[ai * 4 + m]), sn = __builtin_amdgcn_rsqf(v) * -1.4426950408889634f;
                f32x4 h[2];
#pragma unroll
                for (int n = 0; n < 2; ++n) { const f32x4 g = acc[ai][0][m][n], up = acc[ai][1][m][n];
#pragma unroll
                    for (int p = 0; p < 2; ++p) { const f32x2 g2 = (f32x2){g[2 * p], g[2 * p + 1]}, u2 = (f32x2){up[2 * p], up[2 * p + 1]}; const f32x2 a2 = g2 * sn;
                        f32x2 e2; e2.x = __builtin_amdgcn_exp2f(a2.x); e2.y = __builtin_amdgcn_exp2f(a2.y);
                        const f32x2 d2 = e2 * v + v; f32x2 r2; r2.x = __builtin_amdgcn_rcpf(d2.x); r2.y = __builtin_amdgcn_rcpf(d2.y);
                        const f32x2 h2 = (g2 * u2) * r2; h[n][2 * p] = h2.x; h[n][2 * p + 1] = h2.y; } }
                if (MK_HBLK) {
                    bf16_t* hp = H + ((size_t)(u.pm * (ldh >> 6) + u.pn * 2 + (wc >> 1)) * 256 + (ru - u.pm * BM)) * 64 + (wc & 1) * 32;
                    *(PG8_GAS u32x4*)(hp + (fr * 64 + 8 * fq)) = pack8(h[0], h[1]);
                } else { bf16_t* hp = H + (size_t)ru * ldh + u.pn * HALF + wc * 32;
                    *(PG8_GAS u32x4*)(hp + lo) = pack8(h[0], h[1]); } }
    }
};
template <int MODE> struct EpiRmw {
    static constexpr bool PERM = true, AFTER_DRAIN = false;
    const bf16_t* XB; bf16_t* XN; const stat_t* st; stat_t* stn; float alpha;
    __device__ __forceinline__ void operator()(const f32x4 (&acc)[2][2][4][2], const Unit& u, int wr, int wc, int fr, int fq) const {
        const int rowu = u.pm * BM + wr * 64, colu = u.pn * BM + wc * 32; const unsigned lo = (unsigned)(fr * 2048 + 8 * fq);
        const bf16_t* const xbase = XB + (size_t)rowu * 2048 + colu; bf16_t* const nbase = XN + (size_t)rowu * 2048 + colu;
        u32x4 xv[2][2][2], pv[2][2][2];
        stat_t rq[2][2];
        float ss[8];
#define RMW_LOAD(k, b) do { _Pragma("unroll") for (int q = 0; q < 2; ++q) { const int g = 2 * (k) + q, ro = ((g >> 2) * HALF + (g & 3) * 16) * 2048; \
            if (MODE == 1) rq[b][q] = ((const PG8_GAS stat_t*)(st + rowu + (g >> 2) * HALF + (g & 3) * 16))[fr]; \
            _Pragma("unroll") for (int bj = 0; bj < 2; ++bj) { xv[b][q][bj] = *(const PG8_GAS u32x4*)(xbase + ro + lo + bj * HALF); \
                if (MODE == 1) pv[b][q][bj] = *(const PG8_GAS u32x4*)(nbase + ro + lo + bj * HALF); } } } while (0)
        RMW_LOAD(0, 0);
        asm volatile("" ::: "memory");
#pragma unroll
        for (int k = 0; k < 4; ++k) { const int b = k & 1; u32x4 ov[2][2];
#pragma unroll
            for (int q = 0; q < 2; ++q) { const int g = 2 * k + q, ai = g >> 2, m = g & 3; float s2 = 0.f; const float rsg = (MODE == 1) ? rinv_from(rq[b][q]) : 0.f;
#pragma unroll
                for (int bj = 0; bj < 2; ++bj) { f32x4 x0, x1; unpack8(xv[b][q][bj], x0, x1);
                    if (MODE == 0) { x0 += acc[ai][bj][m][0] * alpha; x1 += acc[ai][bj][m][1] * alpha; }
                    else { f32x4 p0, p1; unpack8(pv[b][q][bj], p0, p1);
#pragma unroll
                        for (int j = 0; j < 4; ++j) { x0[j] += alpha * fast_sigmoid(acc[ai][bj][m][0][j] * rsg) * p0[j]; x1[j] += alpha * fast_sigmoid(acc[ai][bj][m][1][j] * rsg) * p1[j]; } }
                    s2 += sumsq8(x0, x1); ov[q][bj] = pack8(x0, x1); }
                s2 += __shfl_xor(s2, 16); s2 += __shfl_xor(s2, 32); ss[g] = s2; }
            if (k < 3) { RMW_LOAD(k + 1, b ^ 1); }
            asm volatile("" ::: "memory");
#pragma unroll
            for (int q = 0; q < 2; ++q) { const int g = 2 * k + q, ro = ((g >> 2) * HALF + (g & 3) * 16) * 2048;
#pragma unroll
                for (int bj = 0; bj < 2; ++bj) if (MODE == 0 || alpha != 0.f) *(PG8_GAS u32x4*)(nbase + ro + lo + bj * HALF) = ov[q][bj]; }
            asm volatile("" ::: "memory");
        }
#undef RMW_LOAD
        if (fq == 0) {
#pragma unroll
            for (int g = 0; g < 8; ++g) __hip_atomic_fetch_add((PG8_GAS stat_t*)(stn + rowu + (g >> 2) * HALF + (g & 3) * 16 + fr), stat_fix(ss[g]), __ATOMIC_RELAXED, __HIP_MEMORY_SCOPE_AGENT);
        }
    }
};
template <int MODE> struct EpiRowBf16 {
    static constexpr bool PERM = true, AFTER_DRAIN = false;
    bf16_t* O; int ldc; const stat_t* st;
    __device__ __forceinline__ void operator()(const f32x4 (&acc)[2][2][4][2], const Unit& u, int wr, int wc, int fr, int fq) const {
        const int rowu = u.pm * BM + wr * 64, colu = u.pn * BM + wc * 32; const unsigned lo = (unsigned)(fr * ldc + 8 * fq);
        stat_t q[8];
        if (MODE == 1) {
#pragma unroll
            for (int g = 0; g < 8; ++g) q[g] = ((const PG8_GAS stat_t*)(st + rowu + (g >> 2) * HALF + (g & 3) * 16))[fr];
            asm volatile("" ::: "memory"); }
#pragma unroll
        for (int ai = 0; ai < 2; ++ai)
#pragma unroll
            for (int m = 0; m < 4; ++m) { const int ru = rowu + ai * HALF + m * 16; float s = 1.0f; if (MODE == 1) s = rinv_from(q[ai * 4 + m]);
                bf16_t* op = O + (size_t)ru * ldc + colu;
#pragma unroll
                for (int bj = 0; bj < 2; ++bj) { f32x4 v0 = acc[ai][bj][m][0] * s, v1 = acc[ai][bj][m][1] * s;
                    if (MODE == 1) {
#pragma unroll
                        for (int j = 0; j < 4; ++j) { v0[j] = gelu_tanh(v0[j]); v1[j] = gelu_tanh(v1[j]); } }
                    *(PG8_GAS u32x4*)(op + lo + bj * HALF) = pack8(v0, v1); } }
    }
};
struct EpiOddIn {
    static constexpr bool PERM = true, AFTER_DRAIN = false;
    bf16_t* Z; bf16_t* GB; const stat_t* st;
    __device__ __forceinline__ void operator()(const f32x4 (&acc)[2][2][4][2], const Unit& u, int wr, int wc, int fr, int fq) const {
        const int rowu = u.pm * BM + wr * 64; const unsigned lo = (unsigned)(fr * 2048 + 8 * fq);
        stat_t q[8];
#pragma unroll
        for (int g = 0; g < 8; ++g) q[g] = ((const PG8_GAS stat_t*)(st + rowu + (g >> 2) * HALF + (g & 3) * 16))[fr];
        asm volatile("" ::: "memory");
        if (u.pn < 16) { const int colu = u.pn * HALF + wc * 32;
#pragma unroll
            for (int ai = 0; ai < 2; ++ai)
#pragma unroll
                for (int m = 0; m < 4; ++m) { const int ru = rowu + ai * HALF + m * 16; const float s = rinv_from(q[ai * 4 + m]), s2 = s * s;
                    const f32x4 z0 = acc[ai][0][m][0] * acc[ai][1][m][0] * s2, z1 = acc[ai][0][m][1] * acc[ai][1][m][1] * s2;
                    bf16_t* zp = Z + (size_t)ru * 2048 + colu;
                    *(PG8_GAS u32x4*)(zp + lo) = pack8(z0, z1); }
        } else { const int colu = (u.pn - 16) * BM + wc * 32;
#pragma unroll
            for (int ai = 0; ai < 2; ++ai)
#pragma unroll
                for (int m = 0; m < 4; ++m) { const int ru = rowu + ai * HALF + m * 16; const float s = rinv_from(q[ai * 4 + m]);
                    bf16_t* gp = GB + (size_t)ru * 2048 + colu;
#pragma unroll
                    for (int bj = 0; bj < 2; ++bj) *(PG8_GAS u32x4*)(gp + lo + bj * HALF) = pack8(acc[ai][bj][m][0] * s, acc[ai][bj][m][1] * s); }
        }
    }
};
struct EpiMT {
    static constexpr bool PERM = true, AFTER_DRAIN = false;
    bf16_t* ZTP; bf16_t* ZTS; bf16_t* VT; const stat_t* st; const float* gv;
    __device__ __forceinline__ void operator()(const f32x4 (&acc)[2][2][4][2], const Unit& u, int wr, int wc, int fr, int fq) const {
        const int tu = u.pn * BM + wc * 32;
        f32x4 sc[2][2];
#pragma unroll
        for (int bj = 0; bj < 2; ++bj)
#pragma unroll
            for (int n = 0; n < 2; ++n) { const stat_t* sp = (st + tu + bj * HALF + 4 * n) + 8 * fq; const u64x2 a = *(const PG8_GAS u64x2*)sp, b = *(const PG8_GAS u64x2*)(sp + 2);
                sc[bj][n][0] = rinv_from(a[0]); sc[bj][n][1] = rinv_from(a[1]); sc[bj][n][2] = rinv_from(b[0]); sc[bj][n][3] = rinv_from(b[1]); }
        const int chu = u.pm * BM + wr * 64;
        if (u.pm < 4) {
            bf16_t* base; int S2;
            if (u.pn < 128) { const int tt = u.pn * BM; base = ZTP + (size_t)(tt >> 11) * (1024 * 2048) + (tt & 2047) + wc * 32; S2 = 2048; }
            else { base = ZTS + (u.pn - 128) * BM + wc * 32; S2 = 8192; }
            const unsigned lo = (unsigned)(fr * S2 + 8 * fq);
#pragma unroll
            for (int ai = 0; ai < 2; ++ai)
#pragma unroll
                for (int m = 0; m < 4; ++m) { bf16_t* rp = base + (size_t)(chu + ai * HALF + m * 16) * S2;
#pragma unroll
                    for (int bj = 0; bj < 2; ++bj) *(PG8_GAS u32x4*)(rp + lo + bj * HALF) = pack8(acc[ai][bj][m][0] * sc[bj][0], acc[ai][bj][m][1] * sc[bj][1]); }
        } else {
            const unsigned lo = (unsigned)(fr * 40960 + 8 * fq);
#pragma unroll
            for (int ai = 0; ai < 2; ++ai) {
                f32x4 q[2][2];
#pragma unroll
                for (int bj = 0; bj < 2; ++bj)
#pragma unroll
                    for (int n = 0; n < 2; ++n) { q[bj][n] = (f32x4){0.f, 0.f, 0.f, 0.f};
#pragma unroll
                        for (int m = 0; m < 4; ++m) { const f32x4 v = acc[ai][bj][m][n] * sc[bj][n];
#pragma unroll
                            for (int j = 0; j < 4; ++j) { const float y = gelu_tanh(v[j]); q[bj][n][j] += y * y; } } }
#pragma unroll
                for (int bj = 0; bj < 2; ++bj)
#pragma unroll
                    for (int n = 0; n < 2; ++n)
#pragma unroll
                        for (int j = 0; j < 4; ++j) { float s = q[bj][n][j]; s += __shfl_xor(s, 1); s += __shfl_xor(s, 2); s += __shfl_xor(s, 4); s += __shfl_xor(s, 8);
                            q[bj][n][j] = __builtin_amdgcn_rsqf(s * (1.0f / 64.0f) + RMS_EPS); }
#pragma unroll
                for (int m = 0; m < 4; ++m) { const int cu = chu - 1024 + ai * HALF + m * 16; const float gg = ((const PG8_GAS float*)(gv + cu))[fr]; bf16_t* vp = VT + (size_t)cu * 40960 + tu;
#pragma unroll
                    for (int bj = 0; bj < 2; ++bj) { f32x4 y0 = acc[ai][bj][m][0] * sc[bj][0], y1 = acc[ai][bj][m][1] * sc[bj][1];
#pragma unroll
                        for (int j = 0; j < 4; ++j) { y0[j] = gelu_tanh(y0[j]); y1[j] = gelu_tanh(y1[j]); }
                        *(PG8_GAS u32x4*)(vp + lo + bj * HALF) = pack8(y0 * q[bj][0] * gg, y1 * q[bj][1] * gg); } }
            }
        }
    }
};
struct EpiDFT {
    static constexpr bool PERM = true, AFTER_DRAIN = false;
    bf16_t* Y; int row_base, S; float scale, msign; int col_lo, col_hi;
    __device__ __forceinline__ void operator()(const f32x4 (&acc)[2][2][4][2], const Unit& u, int wr, int wc, int fr, int fq) const {
        const int ku = u.pm * BM + wr * 64, rb = row_base + (u.pn >> 2) * S, colu = (u.pn & 3) * BM + wc * 32;
        const int lo = fr * 2048 + 8 * fq, lom = -fr * 2048 + 8 * fq; const float ms = scale * msign;
#pragma unroll
        for (int bj = 0; bj < 2; ++bj) { const int col = colu + bj * HALF + 8 * fq; if (col >= col_lo && col < col_hi) {
#pragma unroll
            for (int ai = 0; ai < 2; ++ai)
#pragma unroll
                for (int m = 0; m < 4; ++m) { const int k0 = ku + ai * HALF + m * 16;
                    bf16_t* yp = Y + (size_t)(rb + k0) * 2048 + colu + bj * HALF; bf16_t* ym = Y + (size_t)(rb + S - k0) * 2048 + colu + bj * HALF;
                    *(PG8_GAS u32x4*)(yp + lo) = pack8(acc[ai][bj][m][0] * scale, acc[ai][bj][m][1] * scale);
                    if (k0 + fr != 0) *(PG8_GAS u32x4*)(ym + lom) = pack8(acc[ai][bj][m][0] * ms, acc[ai][bj][m][1] * ms); } } }
    }
};
struct EpiNull {
    static constexpr bool PERM = true, AFTER_DRAIN = false;
    float* sink;
    __device__ __forceinline__ void operator()(const f32x4 (&acc)[2][2][4][2], const Unit& u, int wr, int wc, int fr, int fq) const {
        float s = 0.f;
#pragma unroll
        for (int ai = 0; ai < 2; ++ai)
#pragma unroll
            for (int bj = 0; bj < 2; ++bj)
#pragma unroll
                for (int m = 0; m < 4; ++m)
#pragma unroll
                    for (int n = 0; n < 2; ++n) s += acc[ai][bj][m][n][0] + acc[ai][bj][m][n][1] + acc[ai][bj][m][n][2] + acc[ai][bj][m][n][3];
        if (s == 1.2345e-30f) sink[u.pm + fr] = s;
    }
};
}
#ifndef MK_N_LAUNCHES
#define MK_N_LAUNCHES 1
#endif
constexpr int NPHASE = 34;
constexpr int T = 40960, TP = 32768, DM = 2048, DFF = 5632, NLAYER = 4;
typedef unsigned short bf16;
#define GAS __attribute__((address_space(1)))
#define LAS __attribute__((address_space(3)))
typedef unsigned v4u __attribute__((ext_vector_type(4)));
typedef unsigned v2u __attribute__((ext_vector_type(2)));
typedef float f32x4 __attribute__((ext_vector_type(4)));
typedef short bf16x8 __attribute__((ext_vector_type(8)));
typedef GAS unsigned gu32;

constexpr size_t MiB = 1u << 20;
constexpr size_t WS_CTL = 0, CTL_BYTES = 6 * MiB;
constexpr int CW_BAR = 4096;
constexpr size_t WS_STATS = 65536;
constexpr size_t WS_W = 6 * MiB;
constexpr size_t SZ_FIN = (size_t)2 * DFF * DM * 2, SZ_FOUT = (size_t)DM * DFF * 2, SZ_SQ = (size_t)DM * DM * 2, SZ_WP = (size_t)DM * 256 * 2;
constexpr size_t WL_F1IN = 0, WL_F1OUT = SZ_FIN, WL_F2IN = SZ_FIN + SZ_FOUT, WL_F2OUT = 2 * SZ_FIN + SZ_FOUT, WL_WG = 2 * SZ_FIN + 2 * SZ_FOUT, WL_WP = WL_WG + SZ_SQ, WL_SIZE = WL_WP + SZ_WP;
constexpr size_t WS_WE = WS_W + NLAYER * WL_SIZE;
constexpr size_t WE_WZ = 0, WE_WU = (size_t)3072 * DM * 2, WE_WO = WE_WU + (size_t)1024 * DM * 2, WE_WS = WE_WO + SZ_SQ, WE_SIZE = WE_WS + (size_t)16 * 128 * 128 * 2;
constexpr size_t WS_WOD = WS_WE + 2 * WE_SIZE;
constexpr size_t WO_WC = 0, WO_WOC = (size_t)6144 * DM * 2, WO_SIZE = WO_WOC + SZ_SQ;
constexpr size_t WS_DP = WS_WOD + 2 * WO_SIZE, SZ_DP = (size_t)2 * 1024 * 2048 * 2;
constexpr size_t WS_DS = WS_DP + SZ_DP, SZ_DS = (size_t)2 * 4096 * 8192 * 2;
constexpr size_t WS_XB0 = WS_DS + SZ_DS, SZ_XB = (size_t)T * DM * 2;
constexpr size_t WS_XB1 = WS_XB0 + SZ_XB;
constexpr size_t WS_H = WS_XB1 + SZ_XB, SZ_H = (size_t)T * DFF * 2;
constexpr size_t WS_ZTP = WS_H, WS_ZTS = WS_ZTP + (size_t)16 * 1024 * 2048 * 2, WS_VT = WS_ZTS + (size_t)1024 * 8192 * 2, WS_U = WS_VT + (size_t)1024 * T * 2;
constexpr size_t WS_Z = WS_H, WS_GB = WS_H + SZ_XB;
constexpr size_t WS_PB = WS_H + SZ_H, SZ_PB = (size_t)NLAYER * T * 256 * 2;
constexpr size_t WS_END = WS_PB + SZ_PB;
static_assert(WS_U + (size_t)T * 1024 * 2 <= WS_H + SZ_H && WS_GB + SZ_XB <= WS_H + SZ_H, "mixer buffers overlay the FFN hidden buffer");
static_assert(WS_STATS + (size_t)18 * T * 8 <= CTL_BYTES && (CW_BAR + 3456) * 4 <= (int)WS_STATS, "control region");
static_assert(WS_END < 1800000000ull, "d_ws map");

constexpr int LDS_BYTES = 147456;
constexpr int LDSCTL_OFF = 131072;

#define LDS_WAIT() asm volatile("s_waitcnt lgkmcnt(0)" ::: "memory")
__device__ __forceinline__ unsigned f2bf(float f) { unsigned u = __builtin_bit_cast(unsigned, f); return (u + 0x7fffu + ((u >> 16) & 1u)) >> 16; }
__device__ __forceinline__ unsigned pk2(float lo, float hi) { return f2bf(lo) | (f2bf(hi) << 16); }
__device__ __forceinline__ float bflo(unsigned w) { return __uint_as_float(w << 16); }
__device__ __forceinline__ float bfhi(unsigned w) { return __uint_as_float(w & 0xffff0000u); }
__device__ __forceinline__ float wave_sum(float v) {
#pragma unroll
    for (int o = 1; o < 64; o <<= 1) v += __shfl_xor(v, o);
    return v;
}
#define XB_TMO      128
#define XB_XCNT(j)  (256  + 64 * (j))
#define XB_XSUB(j)  (1280 + 64 * (j))
#define XB_XGEN(j)  (2304 + 64 * (j))
#define XB_TOP      3328
#define XB_TOPGEN   3392
#define XCD_BAR_WORDS 3456
#define XB_SPIN_CAP (1u << 18)

__device__ __forceinline__ unsigned xb_ld(unsigned* p)              { return __hip_atomic_load(p, __ATOMIC_RELAXED, __HIP_MEMORY_SCOPE_AGENT); }
__device__ __forceinline__ unsigned xb_add(unsigned* p, unsigned v) { return __hip_atomic_fetch_add(p, v, __ATOMIC_RELAXED, __HIP_MEMORY_SCOPE_AGENT); }
__device__ __forceinline__ unsigned xb_xcc_id() { return (unsigned)__builtin_amdgcn_s_getreg((3 << 11) | 20) & 0xFu; }
#define XB_SPIN(cond, bar) do { unsigned _sp = 0; while (cond) { __builtin_amdgcn_s_sleep(1); \
    if ((++_sp & 255u) == 0u) { if (xb_ld(&(bar)[XB_TMO])) break; if (_sp > XB_SPIN_CAP) { atomicAdd(&(bar)[XB_TMO], 1u); break; } } } } while (0)

struct XcdBarrier {
    unsigned* bar; unsigned x;
    volatile LAS unsigned* st;
};

__device__ __forceinline__ XcdBarrier xcd_barrier_post(unsigned* bar, volatile LAS unsigned* st) {
    XcdBarrier b; b.bar = bar; b.x = xb_xcc_id(); b.st = st;
    if (threadIdx.x == 0) (void)xb_add(&bar[XB_XCNT(b.x)], 1u);
    return b;
}
__device__ __forceinline__ void xcd_barrier_complete(unsigned* bar, unsigned x, unsigned& nloc, unsigned& nx) {
    const unsigned G = gridDim.x * gridDim.y * gridDim.z;
    unsigned sum, cnt, mine, sp = 0u;
    for (;;) {
        sum = 0u; cnt = 0u; mine = 0u;
#pragma unroll
        for (unsigned j = 0; j < 16; ++j) { const unsigned c = xb_ld(&bar[XB_XCNT(j)]); sum += c; cnt += (c > 0u) ? 1u : 0u; mine = (j == x) ? c : mine; }
        if (sum == G) break;
        __builtin_amdgcn_s_sleep(1);
        if ((++sp & 255u) == 0u) { if (xb_ld(&bar[XB_TMO])) break; if (sp > XB_SPIN_CAP) { atomicAdd(&bar[XB_TMO], 1u); break; } }
    }
    nloc = mine > 0u ? mine : 1u; nx = cnt > 0u ? cnt : 1u;
}

__device__ __forceinline__ void xcd_barrier(const XcdBarrier& b) {
    asm volatile("s_waitcnt vmcnt(0)" ::: "memory");
    __syncthreads();
    if (threadIdx.x == 0) {
        unsigned* bar = b.bar;
        __builtin_amdgcn_s_waitcnt(0);
        unsigned nloc = b.st[0], nx = b.st[1];
        if (nloc == 0u) { xcd_barrier_complete(bar, b.x, nloc, nx); b.st[0] = nloc; b.st[1] = nx; }
        const unsigned old = xb_add(&bar[XB_XSUB(b.x)], 1u);
        const unsigned gen = old / nloc;
        if (old + 1u == (gen + 1u) * nloc) {
            __builtin_amdgcn_fence(__ATOMIC_RELEASE, "agent");
            asm volatile("s_waitcnt vmcnt(0)" ::: "memory");
            const unsigned og = xb_add(&bar[XB_TOP], 1u);
            const unsigned tg = og / nx;
            if (og + 1u == (tg + 1u) * nx) xb_add(&bar[XB_TOPGEN], 1u);
            else XB_SPIN(xb_ld(&bar[XB_TOPGEN]) == tg, bar);
            __builtin_amdgcn_fence(__ATOMIC_ACQUIRE, "agent");
            xb_add(&bar[XB_XGEN(b.x)], 1u);
            asm volatile("s_waitcnt vmcnt(0)" ::: "memory");
        } else {
            XB_SPIN(xb_ld(&bar[XB_XGEN(b.x)]) == gen, bar);
            __builtin_amdgcn_fence(__ATOMIC_ACQUIRE, "agent");
            asm volatile("s_waitcnt vmcnt(0)" ::: "memory");
        }
    }
    __syncthreads();
}
#ifndef MK_CVNT
#define MK_CVNT 3
#endif
template<class V> __device__ __forceinline__ V cv_ld(const GAS V* p) { if (MK_CVNT & 1) return __builtin_nontemporal_load(p); else return *p; }
template<class V> __device__ __forceinline__ void cv_st(GAS V* p, V v) { if (MK_CVNT & 2) __builtin_nontemporal_store(v, p); else *p = v; }
__device__ __forceinline__ void tr_item(const float* W, int ldw, int K, const float* g, bf16* WT, int dst_row0, LAS float* scr, int k0, int n0, int lane) {
    {
        f32x4 v[8]; const int kr = lane >> 3, n4 = (lane & 7) * 4;
#pragma unroll
        for (int i = 0; i < 8; ++i) v[i] = cv_ld((const GAS f32x4*)(W + (size_t)(k0 + 8 * i + kr) * ldw + n0 + n4));
        if (g) {
#pragma unroll
            for (int i = 0; i < 8; ++i) v[i] = v[i] * g[k0 + 8 * i + kr]; }
#pragma unroll
        for (int i = 0; i < 8; ++i) { LAS float* d = scr + (8 * i + kr) * 33 + n4; d[0] = v[i][0]; d[1] = v[i][1]; d[2] = v[i][2]; d[3] = v[i][3]; }
    }
    LDS_WAIT(); asm volatile("" ::: "memory");
    const int c = lane & 7;
#pragma unroll
    for (int j = 0; j < 4; ++j) { const int n = (lane >> 3) + 8 * j; const LAS float* s = scr + (8 * c) * 33 + n;
        v4u o; o.x = pk2(s[0 * 33], s[1 * 33]); o.y = pk2(s[2 * 33], s[3 * 33]); o.z = pk2(s[4 * 33], s[5 * 33]); o.w = pk2(s[6 * 33], s[7 * 33]);
        cv_st((GAS v4u*)(WT + (size_t)(dst_row0 + n) * K + k0 + 8 * c), o); }
    LDS_WAIT(); asm volatile("" ::: "memory");
}
__device__ __forceinline__ void hc_rows(int kd, int& r1, int& r2, float& c2) {
    if (kd < 528) { const int h = kd / 33, cp = kd - 33 * h; r1 = 64 * h + cp; if (cp == 0 || cp == 32) { r2 = r1; c2 = 0.f; } else { r2 = 64 * h + 64 - cp; c2 = 1.f; } }
    else { const int q = kd - 528, h = q / 31, cp = 1 + q - 31 * h; r1 = 64 * h + 64 - cp; r2 = 64 * h + cp; c2 = -1.f; }
}
__device__ __forceinline__ void tr_item_wofold(const float* W, bf16* WT, LAS float* scr, int k0, int n0, int lane) {
    {   f32x4 v[8], w[8]; float cc[8]; const int kr = lane >> 3, n4 = (lane & 7) * 4;
#pragma unroll
        for (int i = 0; i < 8; ++i) { int r1, r2; hc_rows(k0 + 8 * i + kr, r1, r2, cc[i]); v[i] = *(const GAS f32x4*)(W + (size_t)r1 * DM + n0 + n4); w[i] = *(const GAS f32x4*)(W + (size_t)r2 * DM + n0 + n4); }
#pragma unroll
        for (int i = 0; i < 8; ++i) { const f32x4 t = v[i] + w[i] * cc[i]; LAS float* d = scr + (8 * i + kr) * 33 + n4; d[0] = t[0]; d[1] = t[1]; d[2] = t[2]; d[3] = t[3]; }
    }
    LDS_WAIT(); asm volatile("" ::: "memory");
    const int c = lane & 7;
#pragma unroll
    for (int j = 0; j < 4; ++j) { const int n = (lane >> 3) + 8 * j; const LAS float* s = scr + (8 * c) * 33 + n;
        v4u o; o.x = pk2(s[0 * 33], s[1 * 33]); o.y = pk2(s[2 * 33], s[3 * 33]); o.z = pk2(s[4 * 33], s[5 * 33]); o.w = pk2(s[6 * 33], s[7 * 33]);
        *(GAS v4u*)(WT + (size_t)(n0 + n) * DM + k0 + 8 * c) = o; }
    LDS_WAIT(); asm volatile("" ::: "memory");
}
__device__ __forceinline__ int map_id(int n) { return n; }
__device__ __forceinline__ int map_glu(int n) { return n < DFF ? 256 * (n >> 7) + (n & 127) : 256 * ((n - DFF) >> 7) + 128 + ((n - DFF) & 127); }
__device__ __forceinline__ int map_oddin(int n) { return n < 2048 ? 4096 + n : (n < 4096 ? 256 * ((n - 2048) >> 7) + ((n - 2048) & 127) : 256 * ((n - 4096) >> 7) + 128 + ((n - 4096) & 127)); }

struct Args { const float* in[24]; float* out; unsigned char* ws; int ph_lo, ph_hi; };

constexpr int CW_POOL = 8192;
constexpr int I_FIN = (DM / 64) * (2 * DFF / 32), I_FOUT = (DFF / 64) * (DM / 32), I_SQ = (DM / 64) * (DM / 32), I_WP = (256 / 64) * (DM / 32);
constexpr int I_EIN = (DM / 64) * (2048 / 32), I_FOLD = 64 * 16, I_OIN = (DM / 64) * (6144 / 32);
constexpr int I_X = T / 4, I_P = T * 256 / 8 / 512, I_WS = 16 * 128 * 128 / 8 / 512, I_DGS = 2 * 4096 * 1024 / 512, I_DGP = 2 * 1024 * 256 / 512, I_DG = I_DGS + I_DGP;
constexpr int POOL_NA = I_X + I_FIN;
__host__ __device__ constexpr int pool_seg(int L, int s) {
    return s == 0 ? I_FOUT : s == 1 ? ((L & 1) ? I_OIN : I_EIN + I_FOLD) : s == 2 ? ((L & 1) ? 0 : (L == 0 ? I_DG + I_WS : I_WS)) : s == 3 ? I_SQ : s == 4 ? I_FIN : s == 5 ? I_FOUT + I_WP + I_P : s == 6 ? I_SQ : (L < NLAYER - 1 ? I_FIN : 0);
}
__host__ __device__ constexpr int pool_blk(int L) { return pool_seg(L, 0) + pool_seg(L, 1) + pool_seg(L, 2) + pool_seg(L, 3) + pool_seg(L, 4) + pool_seg(L, 5) + pool_seg(L, 6) + pool_seg(L, 7); }
constexpr unsigned POOL_NTOTAL = POOL_NA + pool_blk(0) + pool_blk(1) + pool_blk(2) + pool_blk(3);
__device__ __forceinline__ unsigned pool_target(int L, int k) {
    unsigned n = POOL_NA;
#pragma unroll
    for (int l = 0; l < NLAYER; ++l) if (l < L) n += pool_blk(l);
#pragma unroll
    for (int s = 0; s < 8; ++s) if (s <= k) n += pool_seg(L, s);
    return n;
}

__device__ __forceinline__ void cv_x_item(const float* xp, const float* xs, unsigned char* ws, int r, int lane) {
    pg8::stat_t* st0 = (pg8::stat_t*)(ws + WS_STATS); bf16* xb0 = (bf16*)(ws + WS_XB0);
#pragma unroll 1
    for (int i = 0; i < 4; ++i) { const int row = 4 * r + i; const float* src = row < TP ? xp + (size_t)row * DM : xs + (size_t)(row - TP) * DM;
        const GAS f32x4* xr = (const GAS f32x4*)src + lane; f32x4 v[8]; float s = 0.f;
#pragma unroll
        for (int j = 0; j < 8; ++j) { v[j] = cv_ld(xr + 64 * j); s += (v[j][0] * v[j][0] + v[j][1] * v[j][1]) + (v[j][2] * v[j][2] + v[j][3] * v[j][3]); }
        s = wave_sum(s); if (lane == 0) *(GAS pg8::stat_t*)(st0 + row) = pg8::stat_fix(s);
        GAS v2u* brow = (GAS v2u*)(xb0 + (size_t)row * DM) + lane;
#pragma unroll
        for (int j = 0; j < 8; ++j) { v2u w; w.x = pk2(v[j][0], v[j][1]); w.y = pk2(v[j][2], v[j][3]); brow[64 * j] = w; } }
}
__device__ __forceinline__ void cv_p_item(const float* pp, const float* ps, unsigned char* ws, int L, int r, int lane) {
    bf16* pb = (bf16*)(ws + WS_PB) + (size_t)L * T * 256; f32x4 v0[8], v1[8];
#pragma unroll
    for (int i = 0; i < 8; ++i) { const int e = r * 512 + i * 64 + lane, row = e >> 5, c8 = e & 31;
        const float* src = row < TP ? pp + ((size_t)L * TP + row) * 256 + c8 * 8 : ps + ((size_t)L * 8192 + (row - TP)) * 256 + c8 * 8;
        v0[i] = cv_ld((const GAS f32x4*)src); v1[i] = cv_ld((const GAS f32x4*)(src + 4)); }
#pragma unroll
    for (int i = 0; i < 8; ++i) { const int e = r * 512 + i * 64 + lane;
        v4u o; o.x = pk2(v0[i][0], v0[i][1]); o.y = pk2(v0[i][2], v0[i][3]); o.z = pk2(v1[i][0], v1[i][1]); o.w = pk2(v1[i][2], v1[i][3]);
        cv_st((GAS v4u*)(pb + (size_t)e * 8), o); }
}
__device__ __forceinline__ void cv_ws_item(const float* wsrc, unsigned char* ws, int j, int r, int lane) {
    const float* src = wsrc + (size_t)j * 16 * 128 * 128; bf16* dst = (bf16*)(ws + WS_WE + (size_t)j * WE_SIZE + WE_WS); f32x4 v0[8], v1[8];
#pragma unroll
    for (int i = 0; i < 8; ++i) { const int e = r * 512 + i * 64 + lane; v0[i] = *(const GAS f32x4*)(src + (size_t)e * 8); v1[i] = *(const GAS f32x4*)(src + (size_t)e * 8 + 4); }
#pragma unroll
    for (int i = 0; i < 8; ++i) { const int e = r * 512 + i * 64 + lane;
        v4u o; o.x = pk2(v0[i][0], v0[i][1]); o.y = pk2(v0[i][2], v0[i][3]); o.z = pk2(v1[i][0], v1[i][1]); o.w = pk2(v1[i][2], v1[i][3]);
        *(GAS v4u*)(dst + (size_t)e * 8) = o; }
}
__device__ __forceinline__ void cv_dft_item(unsigned char* ws, int r, int lane) {
    const bool smp = r < I_DGS; const int S = smp ? 8192 : 2048, lg = smp ? 13 : 11; bf16* Dm = (bf16*)(ws + (smp ? WS_DS : WS_DP)); const float sc2 = 2.0f / (float)S;
    const int rr = smp ? r : r - I_DGS, per_mat = (S / 2) * (S / 8); const bool sn = rr * 512 >= per_mat;
#pragma unroll 1
    for (int i = 0; i < 8; ++i) { const int e = rr * 512 + i * 64 + lane, e2 = sn ? e - per_mat : e; const int k = e2 >> (lg - 3), s0 = (e2 & (S / 8 - 1)) * 8; float v[8];
        if (!sn) {
#pragma unroll
            for (int q = 0; q < 8; ++q) v[q] = cospif((float)((k * (s0 + q)) & (S - 1)) * sc2);
        } else {
#pragma unroll
            for (int q = 0; q < 8; ++q) v[q] = sinpif((float)((k * (s0 + q)) & (S - 1)) * sc2);
        }
        v4u o; o.x = pk2(v[0], v[1]); o.y = pk2(v[2], v[3]); o.z = pk2(v[4], v[5]); o.w = pk2(v[6], v[7]);
        cv_st((GAS v4u*)(Dm + (size_t)e * 8), o); }
}
__device__ __forceinline__ void cv_fold_item(const float* win, const float* gmix, unsigned char* ws, int j, int r, LAS float* scr, int lane) {
    LAS float* tab = scr + 2200;
    tab[lane] = cospif((float)lane * (1.0f / 32.0f));
    LDS_WAIT(); asm volatile("" ::: "memory");
    const bool isq = lane >= 33; const int cp = isq ? lane - 32 : lane, toff = isq ? 48 : 0;
    const int kb = (r >> 4) & 63, h = r & 15, k0 = kb * 32;
    const float* W = win + (size_t)j * DM * 3072 + h * 64; const float* gm = gmix + (2 * j) * DM; bf16* WZ = (bf16*)(ws + WS_WE + (size_t)j * WE_SIZE + WE_WZ);
    const int zr = isq ? 528 + h * 31 + (lane - 33) : h * 33 + lane;
    for (int kq = 0; kq < 4; ++kq) {
        float ac[8];
#pragma unroll
        for (int q = 0; q < 8; ++q) ac[q] = 0.f;
        for (int cc = 0; cc < 64; ++cc) { const float tv = tab[((cc * cp) + toff) & 63];
#pragma unroll
            for (int q = 0; q < 8; ++q) ac[q] += W[(size_t)(k0 + kq * 8 + q) * 3072 + cc] * tv; }
#pragma unroll
        for (int q = 0; q < 8; ++q) ac[q] *= gm[k0 + kq * 8 + q];
        v4u oc; oc.x = pk2(ac[0], ac[1]); oc.y = pk2(ac[2], ac[3]); oc.z = pk2(ac[4], ac[5]); oc.w = pk2(ac[6], ac[7]);
        *(GAS v4u*)(WZ + (size_t)zr * DM + k0 + kq * 8) = oc; }
    LDS_WAIT(); asm volatile("" ::: "memory");
}

typedef const __attribute__((address_space(4))) Args CArgs;
__device__ __forceinline__ void pool_item(CArgs* ap, LAS unsigned char* lds, int wave, int lane, unsigned it) {
    unsigned char* ws = ap->ws;
    LAS float* scr = (LAS float*)(lds + wave * 16384);
    int r = (int)it;
    if (r < I_X) { cv_x_item(ap->in[0], ap->in[1], ws, r, lane); return; }
    r -= I_X;
    int L = 0, s = 7, Lw = 0;
    if (r >= I_FIN) { r -= I_FIN; s = 0;
#pragma unroll
        for (int l = 0; l < NLAYER - 1; ++l) { const int bs = pool_blk(l); if (L == l && r >= bs) { r -= bs; L = l + 1; } }
#pragma unroll
        for (int q = 0; q < 7; ++q) { const int c = pool_seg(L, q); if (s == q && r >= c) { r -= c; s = q + 1; } }
        Lw = L + 1; }
    const int j = L >> 1; const bool odd = (L & 1) != 0;
    int wi = 0, gi = -1, goff = 0, ldw = DM, K = DM, nblk = 64, mapk = 0; size_t woff = 0, toff = 0;
    const size_t wlo = WS_W + (size_t)(s == 7 ? Lw : L) * WL_SIZE;
    if (s == 7) { wi = 5; woff = (size_t)Lw * DM * 2 * DFF; ldw = 2 * DFF; gi = 4; goff = Lw * DM; toff = wlo + WL_F1IN; nblk = 352; mapk = 1; }
    else if (s == 0) { wi = 6; woff = (size_t)L * DFF * DM; K = DFF; toff = wlo + WL_F1OUT; }
    else if (s == 1) {
        if (odd) { wi = 13; woff = (size_t)j * DM * 6144; ldw = 6144; gi = 7; goff = (2 * j + 1) * DM; toff = WS_WOD + (size_t)j * WO_SIZE + WO_WC; nblk = 192; mapk = 2; }
        else if (r < I_EIN) { wi = 8; woff = (size_t)j * DM * 3072 + 1024; ldw = 3072; gi = 7; goff = (2 * j) * DM;
            toff = WS_WE + (size_t)j * WE_SIZE + (((r & 63) * 32 < 1024) ? WE_WU : WE_WZ); }
        else { cv_fold_item(ap->in[8], ap->in[7], ws, j, r - I_EIN, scr, lane); return; } }
    else if (s == 2) { if (L == 0 && r < I_DG) { cv_dft_item(ws, r, lane); return; } cv_ws_item(ap->in[10], ws, j, L == 0 ? r - I_DG : r, lane); return; }
    else if (s == 3) {
        if (odd) { wi = 16; woff = (size_t)j * DM * DM; toff = WS_WOD + (size_t)j * WO_SIZE + WO_WOC; }
        else { wi = 12; woff = (size_t)j * DM * DM; toff = WS_WE + (size_t)j * WE_SIZE + WE_WO;
            if ((r >> 6) < 16) { tr_item_wofold(ap->in[12] + woff, (bf16*)(ws + toff), scr, (r >> 6) * 64, (r & 63) * 32, lane); return; } } }
    else if (s == 4) { wi = 18; woff = (size_t)L * DM * 2 * DFF; ldw = 2 * DFF; gi = 17; goff = L * DM; toff = wlo + WL_F2IN; nblk = 352; mapk = 1; }
    else if (s == 5) {
        if (r < I_FOUT) { wi = 19; woff = (size_t)L * DFF * DM; K = DFF; toff = wlo + WL_F2OUT; }
        else if (r < I_FOUT + I_WP) { r -= I_FOUT; wi = 22; woff = (size_t)L * 256 * DM; K = 256; toff = wlo + WL_WP; }
        else { cv_p_item(ap->in[2], ap->in[3], ws, L, r - I_FOUT - I_WP, lane); return; } }
    else { wi = 21; woff = (size_t)L * DM * DM; gi = 20; goff = L * DM; toff = wlo + WL_WG; }
    const int kb = nblk == 352 ? r / 352 : (nblk == 192 ? r / 192 : r >> 6), n0 = (r - kb * nblk) * 32;
    const int drow = mapk == 1 ? map_glu(n0) : (mapk == 2 ? map_oddin(n0) : n0);
    const float* W = ap->in[wi] + woff; const float* g = gi >= 0 ? ap->in[gi] + goff : (const float*)nullptr;
    tr_item(W, ldw, K, g, (bf16*)(ws + toff), drow, scr, kb * 64, n0, lane);
}

#ifndef MK_POOLWAIT
#define MK_POOLWAIT 1
#endif
#ifndef MK_POOLWAVES
#define MK_POOLWAVES 3
#endif
__device__ __forceinline__ void pool_seam(const XcdBarrier& b, LAS unsigned char* lds, volatile LAS unsigned* ctl, unsigned target, bool do_barrier) {
    int tid_o = threadIdx.x; asm volatile("" : "+v"(tid_o)); const int lane = tid_o & 63, wave = __builtin_amdgcn_readfirstlane(tid_o >> 6);
    CArgs* ap = (CArgs*)__builtin_amdgcn_kernarg_segment_ptr(); asm volatile("" : "+s"(ap));
    constexpr unsigned EXIT = 0xFFFFFFFFu;
    unsigned slot = 0u;
    asm volatile("s_waitcnt vmcnt(0)" ::: "memory");
    __syncthreads();
    for (;;) {
        if (tid_o == 0) {
            unsigned* pool = (unsigned*)(ap->ws + WS_CTL) + CW_POOL; unsigned* bar = b.bar;
            unsigned bb = EXIT, st = ctl[2]; ctl[1] = 8u;
            if (st == 0u) {
                unsigned seen = ctl[0];
                if (seen < target) { seen = xb_ld(pool); if (seen < target) { bb = xb_add(pool, 8u); seen = bb + 8u;
#ifdef MK_POOLPROBE
                    if (bb >= (unsigned)POOL_NA && bb < POOL_NTOTAL) xb_add(pool + 64, 8u);
#endif
                    } ctl[0] = seen; }
                if (bb == EXIT && do_barrier) {
                    __builtin_amdgcn_s_waitcnt(0);
                    unsigned nloc = b.st[0], nx = b.st[1];
                    if (nloc == 0u) { xcd_barrier_complete(bar, b.x, nloc, nx); b.st[0] = nloc; b.st[1] = nx; }
                    const unsigned old = xb_add(&bar[XB_XSUB(b.x)], 1u);
                    const unsigned gen = old / nloc;
                    if (old + 1u == (gen + 1u) * nloc) {
                        __builtin_amdgcn_fence(__ATOMIC_RELEASE, "agent");
                        asm volatile("s_waitcnt vmcnt(0)" ::: "memory");
                        const unsigned og = xb_add(&bar[XB_TOP], 1u);
                        const unsigned tg = og / nx;
                        if (og + 1u == (tg + 1u) * nx) xb_add(&bar[XB_TOPGEN], 1u);
                        else XB_SPIN(xb_ld(&bar[XB_TOPGEN]) == tg, bar);
                        __builtin_amdgcn_fence(__ATOMIC_ACQUIRE, "agent");
                        xb_add(&bar[XB_XGEN(b.x)], 1u);
                        asm volatile("s_waitcnt vmcnt(0)" ::: "memory");
                    } else { st = gen + 1u; ctl[2] = st; }
                }
            }
            if (st != 0u) {
#ifdef MK_FAKEWAIT
                if (xb_ld(&bar[XB_XGEN(b.x)]) == st - 1u) bb = 0xFFFFFFFEu; else bb = EXIT;
#else
                if (MK_POOLWAIT && ctl[0] < POOL_NTOTAL && xb_ld(&bar[XB_XGEN(b.x)]) == st - 1u) { bb = xb_add(pool, (unsigned)MK_POOLWAVES); ctl[0] = bb + (unsigned)MK_POOLWAVES; ctl[1] = (unsigned)MK_POOLWAVES; }
                else bb = EXIT;
#endif
            }
            ctl[4 + slot] = bb;
        }
        __syncthreads();
        const unsigned bb = __builtin_amdgcn_readfirstlane(ctl[4 + slot]); slot ^= 1u;
        if (bb == EXIT) break;
#ifdef MK_FAKEWAIT
        if (bb == 0xFFFFFFFEu) { for (int q = 0; q < MK_FAKEWAIT; ++q) __builtin_amdgcn_s_sleep(20); }
#endif
        const unsigned it = bb + (unsigned)wave; if (bb < POOL_NTOTAL && it < POOL_NTOTAL && (MK_POOLWAVES == 8 || (unsigned)wave < __builtin_amdgcn_readfirstlane(ctl[1]))) pool_item(ap, lds, wave, lane, it);
        asm volatile("s_waitcnt vmcnt(0)" ::: "memory");
        __syncthreads();
    }
    if (tid_o == 0) { const unsigned st = ctl[2];
        if (st != 0u) {
            XB_SPIN(xb_ld(&b.bar[XB_XGEN(b.x)]) == st - 1u, b.bar);
            __builtin_amdgcn_fence(__ATOMIC_ACQUIRE, "agent");
            asm volatile("s_waitcnt vmcnt(0)" ::: "memory");
            ctl[2] = 0u; } }
    __syncthreads();
}

__device__ __forceinline__ void sgu_phase(const bf16* Wsb, const float* bs, const bf16* VT, const bf16* U, bf16* Y, int idx, int n) {
    int tid_o = threadIdx.x; asm volatile("" : "+v"(tid_o)); const int lane = tid_o & 63, wave = __builtin_amdgcn_readfirstlane(tid_o >> 6);
    const int h = idx & 15, q = idx >> 4, nq = n >> 4, ct = wave & 3, th = wave >> 2, fr = lane & 15, fq = lane >> 4;
    if (idx < 0 || idx >= n || nq == 0) return;
    bf16x8 wf[4][4];
#pragma unroll
    for (int tt = 0; tt < 4; ++tt)
#pragma unroll
        for (int ks = 0; ks < 4; ++ks) wf[tt][ks] = *(const GAS bf16x8*)(Wsb + ((size_t)h * 128 + th * 64 + tt * 16 + fr) * 128 + ks * 32 + fq * 8);
    float bias[4];
#pragma unroll
    for (int tt = 0; tt < 4; ++tt) bias[tt] = bs[h * 128 + th * 64 + tt * 16 + fr];
    for (int ch = q; ch < T / 128; ch += nq) {
        bf16x8 vf[4];
#pragma unroll
        for (int ks = 0; ks < 4; ++ks) vf[ks] = *(const GAS bf16x8*)(VT + (size_t)(h * 64 + ct * 16 + fr) * T + (size_t)ch * 128 + ks * 32 + fq * 8);
#pragma unroll
        for (int tt = 0; tt < 4; ++tt) { f32x4 acc = (f32x4){0.f, 0.f, 0.f, 0.f};
#pragma unroll
            for (int ks = 0; ks < 4; ++ks) acc = __builtin_amdgcn_mfma_f32_16x16x32_bf16(vf[ks], wf[tt][ks], acc, 0, 0, 0);
            const size_t t = (size_t)ch * 128 + th * 64 + tt * 16 + fr; const int c = h * 64 + ct * 16 + fq * 4;
            const v2u uu = *(const GAS v2u*)(U + t * 1024 + c);
            v2u o; o.x = pk2(bflo(uu.x) * (acc[0] + bias[tt]), bfhi(uu.x) * (acc[1] + bias[tt])); o.y = pk2(bflo(uu.y) * (acc[2] + bias[tt]), bfhi(uu.y) * (acc[3] + bias[tt]));
            *(GAS v2u*)(Y + t * 2048 + 1024 + c) = o; }
    }
}
#ifndef MK_CONVR
#define MK_CONVR 8
#endif
__device__ __forceinline__ void conv_phase(const bf16* Z, const bf16* GB, const float* wc, const float* bc, bf16* Y, int vcu, int G) {
    constexpr int R = MK_CONVR;
    int tid_o = threadIdx.x; asm volatile("" : "+v"(tid_o)); const int c0 = (tid_o & 255) * 8, rg = tid_o >> 8;
    float w0[8], w1[8], w2[8], bb[8];
    { const f32x4 a0 = *(const GAS f32x4*)(wc + c0), a1 = *(const GAS f32x4*)(wc + c0 + 4), b0 = *(const GAS f32x4*)(wc + 2048 + c0), b1 = *(const GAS f32x4*)(wc + 2048 + c0 + 4);
      const f32x4 d0 = *(const GAS f32x4*)(wc + 4096 + c0), d1 = *(const GAS f32x4*)(wc + 4096 + c0 + 4), e0 = *(const GAS f32x4*)(bc + c0), e1 = *(const GAS f32x4*)(bc + c0 + 4);
#pragma unroll
      for (int i = 0; i < 4; ++i) { w0[i] = a0[i]; w0[4 + i] = a1[i]; w1[i] = b0[i]; w1[4 + i] = b1[i]; w2[i] = d0[i]; w2[4 + i] = d1[i]; bb[i] = e0[i]; bb[4 + i] = e1[i]; } }
    for (int run = vcu * 2 + rg; run < T / R; run += G * 2) { const int t0 = run * R;
        const int sp0 = t0 < TP ? (t0 & 2047) : (t0 - TP), sl = t0 < TP ? 2048 : 8192;
        const GAS v4u* zp = (const GAS v4u*)(Z + (size_t)t0 * 2048 + c0); const GAS v4u* gp = (const GAS v4u*)(GB + (size_t)t0 * 2048 + c0);
        v4u z[R + 2], g[R];
#pragma unroll
        for (int i = 0; i < R; ++i) { z[i + 1] = zp[i * 256]; g[i] = gp[i * 256]; }
        z[0] = (v4u){0u, 0u, 0u, 0u}; z[R + 1] = (v4u){0u, 0u, 0u, 0u};
        if (sp0 > 0) z[0] = *(zp - 256);
        if (sp0 + R < sl) z[R + 1] = zp[R * 256];
        GAS v4u* yp = (GAS v4u*)(Y + (size_t)t0 * 2048 + c0);
#pragma unroll
        for (int i = 0; i < R; ++i) { float y[8];
#pragma unroll
            for (int p = 0; p < 4; ++p) { const unsigned m = z[i][p], c = z[i + 1][p], n = z[i + 2][p], gg = g[i][p]; const int i0 = 2 * p, i1 = 2 * p + 1;
                y[i0] = bflo(gg) * (w0[i0] * bflo(m) + w1[i0] * bflo(c) + w2[i0] * bflo(n) + bb[i0]);
                y[i1] = bfhi(gg) * (w0[i1] * bfhi(m) + w1[i1] * bfhi(c) + w2[i1] * bfhi(n) + bb[i1]); }
            v4u o; o.x = pk2(y[0], y[1]); o.y = pk2(y[2], y[3]); o.z = pk2(y[4], y[5]); o.w = pk2(y[6], y[7]);
            yp[i * 256] = o; }
    }
}
__device__ __forceinline__ void final_phase(float* out, const bf16* XBf, const pg8::stat_t* st, const float* gf, int vcu, int G) {
    int tid_o = threadIdx.x; asm volatile("" : "+v"(tid_o)); const int lane = tid_o & 63, gw = vcu * 8 + __builtin_amdgcn_readfirstlane(tid_o >> 6), NGW = G * 8;
    f32x4 g[4][2];
#pragma unroll
    for (int j = 0; j < 4; ++j) { g[j][0] = *(const GAS f32x4*)(gf + 512 * j + 8 * lane); g[j][1] = *(const GAS f32x4*)(gf + 512 * j + 8 * lane + 4); }
    for (int row = gw; row < T; row += NGW) { const float r = pg8::rinv_of(st, row); const bf16* xr = XBf + (size_t)row * DM + 8 * lane; float* orow = out + (size_t)row * DM + 8 * lane;
#pragma unroll
        for (int j = 0; j < 4; ++j) { const v4u w = *(const GAS v4u*)(xr + 512 * j); f32x4 a, b; a[0] = bflo(w.x); a[1] = bfhi(w.x); a[2] = bflo(w.y); a[3] = bfhi(w.y); b[0] = bflo(w.z); b[1] = bfhi(w.z); b[2] = bflo(w.w); b[3] = bfhi(w.w);
            __builtin_nontemporal_store(a * r * g[j][0], (GAS f32x4*)(orow + 512 * j)); __builtin_nontemporal_store(b * r * g[j][1], (GAS f32x4*)(orow + 512 * j + 4)); } }
}

__device__ __forceinline__ void dft_mid_rows(const bf16* ZTP, const bf16* ZTS, bf16* Y, int idx, int n) {
    int tid_o = threadIdx.x; asm volatile("" : "+v"(tid_o)); const int lane = tid_o & 63, wave = __builtin_amdgcn_readfirstlane(tid_o >> 6);
    if (idx < 0 || idx >= n) return;
    for (int it = idx * 8 + wave; it < 17 * 529; it += n * 8) { const int b = it / 529, col = it - 529 * b; const int S = b < 16 ? 2048 : 8192; const size_t row = (b < 16 ? (size_t)b * 2048 : (size_t)TP) + S / 2;
        if (col == 528) { unsigned zz = 0u; asm volatile("" : "+v"(zz)); v4u z4; z4.x = zz; z4.y = zz; z4.z = zz; z4.w = zz;
            if (lane < 62) *(GAS v4u*)(Y + row * 2048 + 528 + 8 * lane) = z4; continue; }
        const bf16* z = b < 16 ? ZTP + ((size_t)b * 1024 + col) * 2048 : ZTS + (size_t)col * 8192; float sum = 0.f;
        for (int s0 = lane * 8; s0 < S; s0 += 512) { const v4u w = *(const GAS v4u*)(z + s0);
            sum += (bflo(w.x) - bfhi(w.x)) + (bflo(w.y) - bfhi(w.y)) + (bflo(w.z) - bfhi(w.z)) + (bflo(w.w) - bfhi(w.w)); }
        sum = wave_sum(sum);
        if (lane == 0) Y[row * 2048 + col] = (bf16)f2bf(sum * (b < 16 ? 0.0027621358640099515f : 0.0013810679320049757f)); }
}
struct DftOrder {
    int nM, ntile, tile0, nunits, n, c;
    __device__ __forceinline__ void init(int nM_, int ntile_, int tile0_, int nbatch, int lo, int n_, int rot, int bx) { nM = nM_; ntile = ntile_; tile0 = tile0_; nunits = nM_ * ntile_ * nbatch; n = n_; c = (bx >= lo && bx < lo + n_) ? (bx - lo + rot) % n_ : 0x40000000; }
    __device__ __forceinline__ bool next(int i, pg8::Unit& u) const { const long L = (long)i * n + c; if (L >= nunits) return false; const int l = (int)L, r = l / nM; u.pm = l - r * nM; u.pn = 4 * (r / ntile) + tile0 + r % ntile; return true; }
    __device__ __forceinline__ void a_ready(const pg8::Unit&) const {}
    __device__ __forceinline__ void done(const pg8::Unit&) const {}
};
struct DirOrder : pg8::StaticOrder {
    bool rev;
    __device__ __forceinline__ void init_dir(int M, int N, int G_, int c_, bool rev_) { init(M, N, G_, c_); rev = rev_; }
    __device__ __forceinline__ bool next(int i, pg8::Unit& u) const {
        const long L = (long)i * G + c; if (L >= nwg) return false;
        const int q = nwg / pg8::NXCD, r = nwg % pg8::NXCD; int wgid = (int)L; const int xcd = wgid % pg8::NXCD, off = wgid / pg8::NXCD;
        const int len = xcd < r ? q + 1 : q, base = xcd < r ? xcd * (q + 1) : r * (q + 1) + (xcd - r) * q;
        wgid = base + (rev ? len - 1 - off : off);
        const int nig = pg8::WGM * nN, gid = wgid / nig, fm = gid * pg8::WGM, gsz = (nM - fm) < pg8::WGM ? (nM - fm) : pg8::WGM;
        u.pm = fm + ((wgid % nig) % gsz); u.pn = (wgid % nig) / gsz; return true;
    }
};
#ifndef MK_DYNTAIL
#define MK_DYNTAIL 1
#endif
struct DynDirOrder : DirOrder {
    unsigned* ctr; volatile LAS unsigned* slot; int nfull;
    __device__ __forceinline__ void init_dyn(int M, int N, int G_, int c_, bool rev_, unsigned* ctr_, volatile LAS unsigned* slot_) { init_dir(M, N, G_, c_, rev_); ctr = ctr_; slot = slot_; nfull = MK_DYNTAIL ? nwg / G_ : 0x40000000; }
    __device__ __forceinline__ bool next(int i, pg8::Unit& u) const {
        if (i == nfull - 1 && threadIdx.x == 0) *slot = xb_add(ctr, 1u);
        long L = (long)i * G + c;
        if (i >= nfull) { if (i > nfull) return false; L = (long)nfull * G + (long)__builtin_amdgcn_readfirstlane(*slot); }
        if (L >= nwg) return false;
        const int q = nwg / pg8::NXCD, r = nwg % pg8::NXCD; int wgid = (int)L; const int xcd = wgid % pg8::NXCD, off = wgid / pg8::NXCD;
        const int len = xcd < r ? q + 1 : q, base = xcd < r ? xcd * (q + 1) : r * (q + 1) + (xcd - r) * q;
        wgid = base + (rev ? len - 1 - off : off);
        const int nig = pg8::WGM * nN, gid = wgid / nig, fm = gid * pg8::WGM, gsz = (nM - fm) < pg8::WGM ? (nM - fm) : pg8::WGM;
        u.pm = fm + ((wgid % nig) % gsz); u.pn = (wgid % nig) / gsz; return true;
    }
};
struct RangeOrder : pg8::StaticOrder {
    __device__ __forceinline__ void init_range(int M, int N, int lo, int n, int bx) { const int c_ = (bx >= lo && bx < lo + n) ? bx - lo : 0x40000000; init(M, N, n, c_); }
};

#ifndef MK_SITES
#define MK_SITES 0xFFFFFFFFu
#endif
#define SITE(n) (((MK_SITES) >> (n)) & 1u)
#ifndef MK_DUP
#define MK_DUP 0u
#endif
#define NREP(n) ((((MK_DUP) >> (n)) & 1u) ? 2 : 1)
#define DRY(n) (NREP(n) == 2 && rep == 0)
struct SameTileOrder : pg8::StaticOrder {
    __device__ bool next(int i, pg8::Unit& u) const { const bool r = pg8::StaticOrder::next(i, u); u.pm = 0; u.pn = 0; return r; }
};
#define OPAQUE_WS() unsigned char* wsl = ws; asm volatile("" : "+s"(wsl)); unsigned char* const wl = wsl + WS_W + (size_t)L * WL_SIZE; bf16* const xb = (bf16*)(wsl + ((L & 1) ? WS_XB1 : WS_XB0)); bf16* const xalt = (bf16*)(wsl + ((L & 1) ? WS_XB0 : WS_XB1)); bf16* const Hb = (bf16*)(wsl + WS_H); (void)wl; (void)xb; (void)xalt; (void)Hb
#ifndef MK_DIR
#define MK_DIR 1
#endif
#define PH_REV(k) ((MK_DIR) != 0 && ((k) & 1) != 0)
__global__ void __launch_bounds__(512, 2) mk_fwd(Args args) {
    extern __shared__ __attribute__((aligned(16))) unsigned char lds_raw[];
    LAS unsigned char* lds = (LAS unsigned char*)lds_raw;
    const int tid = threadIdx.x, lane = tid & 63, wave = __builtin_amdgcn_readfirstlane(tid >> 6);
    const int G = gridDim.x, bx = blockIdx.x;
    const int vcu = (G % 8 == 0) ? (bx % 8) * (G / 8) + bx / 8 : bx;
    unsigned char* ws = args.ws;
    volatile LAS unsigned* MISC = (volatile LAS unsigned*)(lds + LDSCTL_OFF);
    for (int u = tid; u < (LDS_BYTES - LDSCTL_OFF) / 4; u += 512) ((LAS unsigned*)(lds + LDSCTL_OFF))[u] = 0u;
    __syncthreads();
    XcdBarrier bar; bar.bar = (unsigned*)(ws + WS_CTL) + CW_BAR; bar.x = 0; bar.st = nullptr;
    if (MK_N_LAUNCHES == 1) bar = xcd_barrier_post((unsigned*)(ws + WS_CTL) + CW_BAR, MISC + 8);
    const int lo = args.ph_lo, hi = args.ph_hi;
#define IN(k) (lo <= (k) && (k) < hi)
    volatile LAS unsigned* pctl = MISC + 16;
#define SEAMT(k, tgt) do { if (IN(k) && IN((k) + 1)) pool_seam(bar, lds, pctl, (tgt), true); } while (0)
#define SEAM(k) SEAMT(pb0 + (k), pool_target(L, (k)))
    pg8::stat_t* stats = (pg8::stat_t*)(ws + WS_STATS); pg8::stat_t* st_dummy = stats + (size_t)17 * T;

    if (IN(0) && MK_N_LAUNCHES != 1) pool_seam(bar, lds, pctl, POOL_NTOTAL, false);
    SEAMT(0, (unsigned)POOL_NA);

#pragma unroll 1
    for (int L = 0; L < NLAYER; ++L) {
        const int pb0 = 1 + 8 * L, j = L >> 1; const bool odd = (L & 1) != 0;
        pg8::stat_t* st0 = stats + (size_t)(4 * L + 0) * T; pg8::stat_t* st1 = stats + (size_t)(4 * L + 1) * T; pg8::stat_t* st2 = stats + (size_t)(4 * L + 2) * T; pg8::stat_t* st3 = stats + (size_t)(4 * L + 3) * T; pg8::stat_t* st4 = stats + (size_t)(4 * L + 4) * T;
        { OPAQUE_WS();
#ifdef MK_NULLP
        if (IN(pb0 + 0) && (MK_NULLP & 4)) { pg8::Gemm g{xb, (const bf16*)(wl + WL_F1IN), T, 2 * DFF, DM}; SameTileOrder S; S.init(T, 2 * DFF, G, bx);
            pg8::EpiNull E{(float*)st_dummy}; pg8::gemm_phase<pg8::EpiNull, SameTileOrder, MK_ALIGN, MK_SP2>(lds, g, S, E); }
        if (IN(pb0 + 0) && (MK_NULLP & 1)) { pg8::Gemm g{xb, (const bf16*)(wl + WL_F1IN), T, 2 * DFF, DM}; pg8::StaticOrder S; S.init(T, 2 * DFF, G, bx);
            pg8::EpiNull E{(float*)st_dummy}; pg8::gemm_phase<pg8::EpiNull, pg8::StaticOrder, MK_ALIGN, MK_SP2>(lds, g, S, E); }
        if (IN(pb0 + 1) && (MK_NULLP & 2)) { pg8::Gemm g{(const bf16*)(wsl + WS_H), (const bf16*)(wl + WL_F1OUT), T, DM, DFF}; pg8::StaticOrder S; S.init(T, DM, G, bx);
            pg8::EpiNull E{(float*)st_dummy}; pg8::gemm_phase<pg8::EpiNull, pg8::StaticOrder, MK_ALIGN, MK_SP2>(lds, g, S, E); }
#endif
        if (IN(pb0 + 0) && SITE(1)) for (int rep = 0; rep < NREP(1); ++rep) { pg8::Gemm g{xb, (const bf16*)(wl + WL_F1IN), T, 2 * DFF, DM}; DynDirOrder S; S.init_dyn(T, 2 * DFF, G, bx, PH_REV(0), (unsigned*)(wsl + WS_CTL) + CW_POOL + 128 + 2 * L, MISC + 24);
            pg8::EpiSwiGLU E{Hb, DFF, st0}; pg8::gemm_phase<pg8::EpiSwiGLU, DynDirOrder, MK_ALIGN, MK_SP2>(lds, g, S, E); }
        }
        SEAM(0);
        { OPAQUE_WS();
        if (IN(pb0 + 1) && SITE(2)) for (int rep = 0; rep < NREP(2); ++rep) { pg8::Gemm g{Hb, (const bf16*)(wl + WL_F1OUT), T, DM, DFF}; DirOrder S; S.init_dir(T, DM, G, bx, PH_REV(1));
            pg8::EpiRmw<0> E{xb, xb, nullptr, DRY(2) ? st_dummy : st1, DRY(2) ? 0.0f : 0.5f}; pg8::gemm_phase<pg8::EpiRmw<0>, DirOrder, MK_ALIGN, MK_SP2, MK_HBLK != 0>(lds, g, S, E); }
        }
        SEAM(1);
        { OPAQUE_WS();
        if (IN(pb0 + 2)) {
            if (!odd) { unsigned char* we = wsl + WS_WE + (size_t)j * WE_SIZE;
                if (SITE(3)) for (int rep = 0; rep < NREP(3); ++rep) { pg8::Gemm g{(const bf16*)(we + WE_WZ), xb, 2048, T, DM}; DirOrder S; S.init_dir(2048, T, G, bx, PH_REV(2));
                  pg8::EpiMT E{(bf16*)(wsl + WS_ZTP), (bf16*)(wsl + WS_ZTS), (bf16*)(wsl + WS_VT), st1, args.in[9] + j * 1024};
                  pg8::gemm_phase<pg8::EpiMT, DirOrder, MK_ALIGN, MK_SP2>(lds, g, S, E); }
                if (SITE(4)) for (int rep = 0; rep < NREP(4); ++rep) { pg8::Gemm g{xb, (const bf16*)(we + WE_WU), T, 1024, DM}; DirOrder S; S.init_dir(T, 1024, G, (bx + G / 2) % G, PH_REV(2));
                  pg8::EpiRowBf16<1> E{(bf16*)(wsl + WS_U), 1024, st1}; pg8::gemm_phase<pg8::EpiRowBf16<1>, DirOrder, MK_ALIGN, MK_SP2>(lds, g, S, E); }
            } else if (SITE(5)) for (int rep = 0; rep < NREP(5); ++rep) { unsigned char* wo = wsl + WS_WOD + (size_t)j * WO_SIZE;
                pg8::Gemm g{xb, (const bf16*)(wo + WO_WC), T, 6144, DM}; DirOrder S; S.init_dir(T, 6144, G, bx, PH_REV(2));
                pg8::EpiOddIn E{(bf16*)(wsl + WS_Z), (bf16*)(wsl + WS_GB), st1}; pg8::gemm_phase<pg8::EpiOddIn, DirOrder, MK_ALIGN, MK_SP2>(lds, g, S, E); }
        }
        }
        SEAM(2);
        { OPAQUE_WS();
        if (IN(pb0 + 3)) {
            if (!odd) { unsigned char* we = wsl + WS_WE + (size_t)j * WE_SIZE;
                const bool tuned = (G == 256); const int s_lo = 0, sp_n = tuned ? 48 : G, sq_lo = tuned ? 48 : 0, sq_n = tuned ? 32 : G, p_lo = tuned ? 80 : 0, p_n = tuned ? 176 : G;
                const bf16* dpc = (const bf16*)(wsl + WS_DP); const bf16* dps = dpc + (size_t)1024 * 2048; const bf16* dsc = (const bf16*)(wsl + WS_DS); const bf16* dss = dsc + (size_t)4096 * 8192;
                if (SITE(7)) for (int rep = 0; rep < NREP(7); ++rep) {
                  { pg8::Gemm g{dsc, (const bf16*)(wsl + WS_ZTS), 4096, 1024, 8192}; DftOrder S; S.init(16, 3, 0, 1, s_lo, sp_n, 0, bx);
                    pg8::EpiDFT E{xalt, TP, 8192, 0.0013810679320049757f, 1.0f, 0, 528}; pg8::gemm_phase<pg8::EpiDFT, DftOrder, MK_ALIGN, MK_SP2>(lds, g, S, E); }
                  { pg8::Gemm g{dss, (const bf16*)(wsl + WS_ZTS), 4096, 1024, 8192}; DftOrder S; S.init(16, 2, 2, 1, sq_lo, sq_n, 0, bx);
                    pg8::EpiDFT E{xalt, TP, 8192, 0.0013810679320049757f, -1.0f, 528, 1024}; pg8::gemm_phase<pg8::EpiDFT, DftOrder, MK_ALIGN, MK_SP2>(lds, g, S, E); } }
                if (SITE(6)) for (int rep = 0; rep < NREP(6); ++rep) {
                  { pg8::Gemm g{dpc, (const bf16*)(wsl + WS_ZTP), 1024, 16 * 1024, 2048}; DftOrder S; S.init(4, 3, 0, 16, p_lo, p_n, 0, bx);
                    pg8::EpiDFT E{xalt, 0, 2048, 0.0027621358640099515f, 1.0f, 0, 528}; pg8::gemm_phase<pg8::EpiDFT, DftOrder, MK_ALIGN, MK_SP2>(lds, g, S, E); }
                  { pg8::Gemm g{dps, (const bf16*)(wsl + WS_ZTP), 1024, 16 * 1024, 2048}; DftOrder S; S.init(4, 2, 2, 16, p_lo, p_n, tuned ? 160 : 0, bx);
                    pg8::EpiDFT E{xalt, 0, 2048, 0.0027621358640099515f, -1.0f, 528, 1024}; pg8::gemm_phase<pg8::EpiDFT, DftOrder, MK_ALIGN, MK_SP2>(lds, g, S, E); } }
                dft_mid_rows((const bf16*)(wsl + WS_ZTP), (const bf16*)(wsl + WS_ZTS), xalt, tuned ? bx : bx, tuned ? 80 : G);
                if (SITE(8)) for (int rep = 0; rep < NREP(8); ++rep) sgu_phase((const bf16*)(we + WE_WS), args.in[11] + j * 2048, (const bf16*)(wsl + WS_VT), (const bf16*)(wsl + WS_U), xalt, bx - p_lo, p_n & ~15);
            } else if (SITE(9)) for (int rep = 0; rep < NREP(9); ++rep) {
                conv_phase((const bf16*)(wsl + WS_Z), (const bf16*)(wsl + WS_GB), args.in[14] + j * 3 * 2048, args.in[15] + j * 2048, xalt, vcu, G);
            }
        }
        }
        SEAM(3);
        { OPAQUE_WS();
        if (IN(pb0 + 4) && SITE(10)) for (int rep = 0; rep < NREP(10); ++rep) { const bf16* wout = odd ? (const bf16*)(wsl + WS_WOD + (size_t)j * WO_SIZE + WO_WOC) : (const bf16*)(wsl + WS_WE + (size_t)j * WE_SIZE + WE_WO);
            pg8::Gemm g{xalt, wout, T, DM, DM}; DirOrder S; S.init_dir(T, DM, G, bx, PH_REV(4));
            pg8::EpiRmw<0> E{xb, xb, nullptr, DRY(10) ? st_dummy : st2, DRY(10) ? 0.0f : 1.0f}; pg8::gemm_phase<pg8::EpiRmw<0>, DirOrder, MK_ALIGN, MK_SP2>(lds, g, S, E); }
        }
        SEAM(4);
        { OPAQUE_WS();
        if (IN(pb0 + 5) && SITE(11)) for (int rep = 0; rep < NREP(11); ++rep) { pg8::Gemm g{xb, (const bf16*)(wl + WL_F2IN), T, 2 * DFF, DM}; DynDirOrder S; S.init_dyn(T, 2 * DFF, G, bx, PH_REV(5), (unsigned*)(wsl + WS_CTL) + CW_POOL + 129 + 2 * L, MISC + 24);
            pg8::EpiSwiGLU E{Hb, DFF, st2}; pg8::gemm_phase<pg8::EpiSwiGLU, DynDirOrder, MK_ALIGN, MK_SP2>(lds, g, S, E); }
        }
        SEAM(5);
        { OPAQUE_WS();
        if (IN(pb0 + 6)) {
            if (SITE(12)) for (int rep = 0; rep < NREP(12); ++rep) { pg8::Gemm g{Hb, (const bf16*)(wl + WL_F2OUT), T, DM, DFF}; DirOrder S; S.init_dir(T, DM, G, bx, PH_REV(6));
              pg8::EpiRmw<0> E{xb, xb, nullptr, DRY(12) ? st_dummy : st3, DRY(12) ? 0.0f : 0.5f}; pg8::gemm_phase<pg8::EpiRmw<0>, DirOrder, MK_ALIGN, MK_SP2, MK_HBLK != 0>(lds, g, S, E); }
            if (SITE(13)) for (int rep = 0; rep < NREP(13); ++rep) { int kpe = 256; asm volatile("" : "+s"(kpe));
              pg8::Gemm g{(const bf16*)(wsl + WS_PB) + (size_t)L * T * 256, (const bf16*)(wl + WL_WP), T, DM, kpe}; DirOrder S; S.init_dir(T, DM, G, bx, PH_REV(6));
              pg8::EpiRowBf16<0> E{xalt, 2048, nullptr}; pg8::gemm_phase<pg8::EpiRowBf16<0>, DirOrder, MK_ALIGN, MK_SP2>(lds, g, S, E); }
        }
        }
        SEAM(6);
        { OPAQUE_WS();
        if (IN(pb0 + 7) && SITE(14)) for (int rep = 0; rep < NREP(14); ++rep) { pg8::Gemm g{xb, (const bf16*)(wl + WL_WG), T, DM, DM}; DirOrder S; S.init_dir(T, DM, G, bx, PH_REV(7));
            pg8::EpiRmw<1> E{xb, xalt, st3, DRY(14) ? st_dummy : st4, DRY(14) ? 0.0f : 1.0f}; pg8::gemm_phase<pg8::EpiRmw<1>, DirOrder, MK_ALIGN, MK_SP2>(lds, g, S, E); }
        }
        SEAM(7);
    }
    if (IN(33) && SITE(15)) final_phase(args.out, (const bf16*)(ws + WS_XB0), stats + (size_t)16 * T, args.in[23], vcu, G);
#ifdef MK_POOLPROBE
    if (bx == 0 && tid == 0) { const unsigned n = xb_ld((unsigned*)(ws + WS_CTL) + CW_POOL + 64); const unsigned long long t0 = __builtin_amdgcn_s_memrealtime();
        while (__builtin_amdgcn_s_memrealtime() - t0 < (unsigned long long)n * (MK_POOLPROBE)) __builtin_amdgcn_s_sleep(8); }
#endif
#undef IN
#undef SEAM
#undef SEAMT
}

extern "C" void kernel_launch(void* const* d_in, const int* in_sizes, int n_in, void* d_out, int out_size, void* d_ws, size_t ws_size, hipStream_t stream) {
    static int grid = 0;
    if (grid == 0) {
        if (n_in != 24 || out_size != T * DM || ws_size < WS_END) { fprintf(stderr, "kernel_launch: unexpected sizes (n_in %d, out %d, ws %zu, need %zu); nothing launched\n", n_in, out_size, ws_size, (size_t)WS_END); grid = -1; return; }
        int dev = 0, cus = 0, per_cu = 0;
        if (hipGetDevice(&dev) != hipSuccess || hipDeviceGetAttribute(&cus, hipDeviceAttributeMultiprocessorCount, dev) != hipSuccess) { grid = -1; return; }
        if (hipFuncSetAttribute((const void*)mk_fwd, hipFuncAttributeMaxDynamicSharedMemorySize, LDS_BYTES) != hipSuccess) { fprintf(stderr, "kernel_launch: hipFuncSetAttribute failed\n"); grid = -1; return; }
        if (hipOccupancyMaxActiveBlocksPerMultiprocessor(&per_cu, (const void*)mk_fwd, 512, LDS_BYTES) != hipSuccess || per_cu < 1) fprintf(stderr, "kernel_launch: occupancy query reports %d workgroups per CU\n", per_cu);
        (void)hipGetLastError();
        grid = cus;
    }
    if (grid < 0) return;
#ifdef MK_POISON_WS
    if (hipMemsetAsync((char*)d_ws, 0xFF, WS_END, stream) != hipSuccess) return;
#endif
    if (hipMemsetAsync((char*)d_ws + WS_CTL, 0, CTL_BYTES, stream) != hipSuccess) return;
    Args a{};
    for (int i = 0; i < 24; ++i) a.in[i] = (const float*)d_in[i];
    a.out = (float*)d_out; a.ws = (unsigned char*)d_ws;
    if (MK_N_LAUNCHES == 1) { a.ph_lo = 0; a.ph_hi = NPHASE; hipLaunchKernelGGL(mk_fwd, dim3(grid), dim3(512), LDS_BYTES, stream, a); }
    else for (int p = 0; p < NPHASE; ++p) { a.ph_lo = p; a.ph_hi = p + 1; hipLaunchKernelGGL(mk_fwd, dim3(grid), dim3(512), LDS_BYTES, stream, a); }
}
```
